# Optimizing an MI355X kernel written in HIP

```python
import math
import jax
import jax.numpy as jnp
from jax import lax
import numpy as np

D_MODEL = 2048
BATCH = 4
SEQ = 2048
DEPTH = 2

HEAD_DIM = 128
N_MIX_HEADS = D_MODEL // HEAD_DIM
NSA_HEADS = N_MIX_HEADS // 4
SWA_HEADS = N_MIX_HEADS // 4
GDN_HEADS = N_MIX_HEADS - NSA_HEADS - SWA_HEADS
SWA_KV_HEADS = max(1, SWA_HEADS // 2)
N_SOFTMAX_HEADS = NSA_HEADS + SWA_HEADS
NSA_WIDTH = NSA_HEADS * HEAD_DIM
GDN_WIDTH = GDN_HEADS * HEAD_DIM
SWA_WIDTH = SWA_HEADS * HEAD_DIM
SWA_KV_WIDTH = SWA_KV_HEADS * HEAD_DIM
MIX_WIDTH = NSA_WIDTH + GDN_WIDTH + SWA_WIDTH

CMP_BLOCK = 32
CMP_STRIDE = 16
CMP_HIDDEN = 2 * HEAD_DIM
SEL_BLOCK = 64
SEL_TOPN = 8
NSA_WINDOW = 512
FORCE_BONUS = 1000.0

GDN_CONV = 4
GDN_CHUNK = 64

SWA_WINDOW = 128
Q_BLOCK = 128

D_FF = 7168
N_EXPERTS = 8
TOP_K = 2
EXPERT_FF = 7168
MOE_BLOCK = 512
N_DENSE = (DEPTH + 1) // 2
N_MOE = DEPTH // 2

NORM_EPS = 1e-6
NEG_INF = -1e30

IN_SPLIT_SIZES = (NSA_WIDTH, HEAD_DIM, HEAD_DIM, HEAD_DIM, HEAD_DIM, HEAD_DIM, HEAD_DIM, 3 * NSA_HEADS,
                  GDN_WIDTH, GDN_WIDTH, GDN_WIDTH, GDN_WIDTH, GDN_HEADS, GDN_HEADS,
                  SWA_WIDTH, SWA_KV_WIDTH, SWA_KV_WIDTH)
D_IN = sum(IN_SPLIT_SIZES)

kernel_name = "hybrid_nsa_gdn_swa_moe_trunk"


def rmsnorm(x, w):
    xf = x.astype(jnp.float32)
    y = xf * lax.rsqrt(jnp.mean(xf * xf, axis=-1, keepdims=True) + NORM_EPS)
    return (y * w.astype(jnp.float32)).astype(x.dtype)


def l2norm(t):
    return t * lax.rsqrt(jnp.sum(t * t, axis=-1, keepdims=True) + NORM_EPS)


def masked_softmax(logits, mask):
    return jax.nn.softmax(jnp.where(mask, logits, NEG_INF), axis=-1)


def alibi_slopes():
    i = jnp.arange(1, N_SOFTMAX_HEADS + 1, dtype=jnp.float32)
    s = 2.0 ** (-8.0 * i / N_SOFTMAX_HEADS)
    return s[SWA_HEADS:], s[:SWA_HEADS]


def split_cols(t, sizes):
    out, start = [], 0
    for s in sizes:
        out.append(t[..., start:start + s])
        start += s
    return out


def swiglu(h, w_gate, w_up, w_down):
    return jnp.dot(jax.nn.silu(jnp.dot(h, w_gate)) * jnp.dot(h, w_up), w_down)


def banded_attention(q, k, v, slopes, window, sinks=None):
    B, S, H, d = q.shape
    G = k.shape[2]
    R = H // G
    nq = S // Q_BLOCK
    n_prev = -(-(window - 1) // Q_BLOCK)

    def band(t):
        tb = t.reshape(B, nq, Q_BLOCK, G, d)
        tb = jnp.pad(tb, ((0, 0), (n_prev, 0), (0, 0), (0, 0), (0, 0)))
        return jnp.concatenate([tb[:, i:i + nq] for i in range(n_prev + 1)], axis=2)

    kb, vb = band(k), band(v)
    qb = q.reshape(B, nq, Q_BLOCK, G, R, d)
    s = jnp.einsum('bnqgrd,bnkgd->bgrnqk', qb, kb).astype(jnp.float32) * (d ** -0.5)
    qpos = jnp.arange(nq)[:, None] * Q_BLOCK + jnp.arange(Q_BLOCK)[None]
    kpos = jnp.arange(nq)[:, None] * Q_BLOCK - n_prev * Q_BLOCK + jnp.arange((n_prev + 1) * Q_BLOCK)[None]
    dist = qpos[:, :, None] - kpos[:, None, :]
    mask = (dist >= 0) & (dist < window) & (kpos[:, None, :] >= 0)
    logits = s - slopes.astype(jnp.float32).reshape(G, R, 1, 1, 1) * dist.astype(jnp.float32)
    logits = jnp.where(mask, logits, NEG_INF)
    if sinks is not None:
        sink = jnp.broadcast_to(sinks.astype(jnp.float32).reshape(G, R, 1, 1, 1), logits.shape[:-1] + (1,))
        p = jax.nn.softmax(jnp.concatenate([logits, sink], axis=-1), axis=-1)[..., :-1]
    else:
        p = jax.nn.softmax(logits, axis=-1)
    o = jnp.einsum('bgrnqk,bnkgd->bnqgrd', p.astype(v.dtype), vb)
    return o.reshape(B, S, H, d)


def nsa_mixer(q, k_cmp, v_cmp, k_slc, v_slc, k_win, v_win, gate_logits,
              pos_k, pos_v, w1_k, w2_k, w1_v, w2_v, slopes):
    B, S, H, d = q.shape
    f32 = jnp.float32
    scale = d ** -0.5
    t_pos = jnp.arange(S)

    n_cmp = (S - CMP_BLOCK) // CMP_STRIDE + 1
    win_idx = jnp.arange(n_cmp)[:, None] * CMP_STRIDE + jnp.arange(CMP_BLOCK)[None]

    def compress(t, pos, w1, w2):
        blocks = (t[:, win_idx] + pos).reshape(B, n_cmp, CMP_BLOCK * d)
        return jnp.dot(jax.nn.silu(jnp.dot(blocks, w1)), w2)

    kc = compress(k_cmp, pos_k, w1_k, w2_k)
    vc = compress(v_cmp, pos_v, w1_v, w2_v)
    c_end = jnp.arange(n_cmp) * CMP_STRIDE + CMP_BLOCK - 1
    c_dist = (t_pos[:, None] - c_end[None]).astype(f32)
    sc = jnp.einsum('bthd,bnd->bhtn', q, kc).astype(f32) * scale - slopes[:, None, None] * c_dist
    p_cmp = masked_softmax(sc, c_dist >= 0) * (t_pos >= CMP_BLOCK - 1).astype(f32)[:, None]
    o_cmp = jnp.einsum('bhtn,bnd->bthd', p_cmp.astype(vc.dtype), vc)

    n_sel = S // SEL_BLOCK
    top_n = min(SEL_TOPN, n_sel)
    c_start = jnp.arange(n_cmp) * CMP_STRIDE
    s_start = jnp.arange(n_sel) * SEL_BLOCK
    overlap = jnp.clip(jnp.minimum(c_start[:, None] + CMP_BLOCK, s_start[None] + SEL_BLOCK)
                       - jnp.maximum(c_start[:, None], s_start[None]), 0).astype(f32) / CMP_BLOCK
    importance = jnp.einsum('bhtn,nj->btj', p_cmp, overlap)
    cur = t_pos // SEL_BLOCK
    blk = jnp.arange(n_sel)
    valid = blk[None] <= cur[:, None]
    forced = (blk[None] == 0) | (blk[None] == cur[:, None]) | (blk[None] == cur[:, None] - 1)
    score = jnp.where(valid, importance + jnp.where(forced, FORCE_BONUS, 0.0), -1.0)
    _, sel = lax.top_k(score, top_n)
    tok = (sel[..., None] * SEL_BLOCK + jnp.arange(SEL_BLOCK)).reshape(B, S, top_n * SEL_BLOCK)

    nq = S // Q_BLOCK
    qb = q.reshape(B, nq, Q_BLOCK, H, d).transpose(1, 0, 2, 3, 4)
    tokb = tok.reshape(B, nq, Q_BLOCK, top_n * SEL_BLOCK).transpose(1, 0, 2, 3)
    posb = t_pos.reshape(nq, Q_BLOCK)
    bidx = jnp.arange(B)[:, None, None]

    def sel_block(args):
        qi, ti, pi = args
        kg = k_slc[bidx, ti]
        vg = v_slc[bidx, ti]
        dist = (pi[None, :, None] - ti).astype(f32)
        s = jnp.einsum('bqhd,bqkd->bhqk', qi, kg).astype(f32) * scale - slopes[None, :, None, None] * dist[:, None]
        p = masked_softmax(s, (dist >= 0)[:, None])
        return jnp.einsum('bhqk,bqkd->bqhd', p.astype(vg.dtype), vg)

    o_slc = lax.map(sel_block, (qb, tokb, posb)).transpose(1, 0, 2, 3, 4).reshape(B, S, H, d)

    o_win = banded_attention(q, k_win[:, :, None], v_win[:, :, None], slopes, NSA_WINDOW)

    g = jax.nn.sigmoid(gate_logits.astype(f32)).reshape(B, S, 3, H)
    o = g[:, :, 0, :, None] * o_cmp + g[:, :, 1, :, None] * o_slc + g[:, :, 2, :, None] * o_win
    return o.astype(q.dtype).reshape(B, S, H * d)


def chunk_gated_delta(q, k, v, beta, g):
    B, H, S, d = q.shape
    C = GDN_CHUNK
    N = S // C
    q, k, v = (t.reshape(B, H, N, C, d) for t in (q, k, v))
    beta = beta.reshape(B, H, N, C)
    gc = jnp.cumsum(g.reshape(B, H, N, C), axis=-1)
    i = jnp.arange(C)
    lower_incl = i[:, None] >= i[None]
    strict = i[:, None] > i[None]
    decay = jnp.exp(jnp.where(lower_incl, gc[..., :, None] - gc[..., None, :], NEG_INF))
    kb = k * beta[..., None]
    L = jnp.where(strict, jnp.einsum('bhncd,bhnjd->bhncj', kb, k) * decay, 0.0)
    a_mat = L + jnp.eye(C, dtype=jnp.float32)
    rhs = jnp.concatenate([v * beta[..., None], kb * jnp.exp(gc)[..., None]], axis=-1)
    sol = lax.linalg.triangular_solve(a_mat, rhs, left_side=True, lower=True, unit_diagonal=True)
    u, w = sol[..., :d], sol[..., d:]
    attn = jnp.where(lower_incl, jnp.einsum('bhncd,bhnjd->bhncj', q, k) * decay, 0.0)
    q_dec = q * jnp.exp(gc)[..., None]
    g_last = gc[..., -1]
    k_dec = k * jnp.exp(g_last[..., None] - gc)[..., None]

    def step(state, inp):
        u_c, w_c, q_c, k_c, a_c, gl = inp
        v_new = u_c - jnp.einsum('bhck,bhkv->bhcv', w_c, state)
        o_c = jnp.einsum('bhck,bhkv->bhcv', q_c, state) + jnp.einsum('bhcj,bhjv->bhcv', a_c, v_new)
        state = state * jnp.exp(gl)[..., None, None] + jnp.einsum('bhck,bhcv->bhkv', k_c, v_new)
        return state, o_c

    xs = tuple(jnp.moveaxis(t, 2, 0) for t in (u, w, q_dec, k_dec, attn, g_last))
    state0 = jnp.zeros((B, H, d, d), jnp.float32)
    _, o = lax.scan(step, state0, xs)
    return jnp.moveaxis(o, 0, 2).reshape(B, H, S, d)


def gdn_mixer(q, k, v, z, a, b, conv_w, a_log, dt_bias, norm_w):
    B, S, _ = q.shape
    H, d = GDN_HEADS, HEAD_DIM
    f32 = jnp.float32
    qkv = jnp.concatenate([q, k, v], axis=-1)
    ch = qkv.shape[-1]
    qkv = lax.conv_general_dilated(qkv, conv_w[:, None, :].astype(qkv.dtype), window_strides=(1,),
                                   padding=[(GDN_CONV - 1, 0)], dimension_numbers=('NWC', 'WIO', 'NWC'),
                                   feature_group_count=ch)
    qkv = jax.nn.silu(qkv).astype(f32)
    qc, kc, vc = jnp.split(qkv, 3, axis=-1)

    def heads(t):
        return t.reshape(B, S, H, d).transpose(0, 2, 1, 3)

    qh = l2norm(heads(qc)) * (d ** -0.5)
    kh = l2norm(heads(kc))
    vh = heads(vc)
    beta = jax.nn.sigmoid(b.astype(f32)).transpose(0, 2, 1)
    g = -(jnp.exp(a_log.astype(f32)) * jax.nn.softplus(a.astype(f32) + dt_bias.astype(f32))).transpose(0, 2, 1)
    o = chunk_gated_delta(qh, kh, vh, beta, g).transpose(0, 2, 1, 3)
    o = o * lax.rsqrt(jnp.mean(o * o, axis=-1, keepdims=True) + NORM_EPS) * norm_w.astype(f32)
    o = o * jax.nn.silu(z.reshape(B, S, H, d).astype(f32))
    return o.reshape(B, S, H * d).astype(z.dtype)


def hybrid_mixer(h, w_in, pos_k, pos_v, w1_k, w2_k, w1_v, w2_v, conv_w, a_log, dt_bias,
                 gdn_norm_w, sinks, w_out, nsa_slopes, swa_slopes):
    B, S, _ = h.shape
    (nsa_q, kc, vc, ksl, vsl, kw, vw, nsa_g, gq, gk, gv, gz, ga, gb, sq, sk, sv) = split_cols(jnp.dot(h, w_in), IN_SPLIT_SIZES)
    o_nsa = nsa_mixer(nsa_q.reshape(B, S, NSA_HEADS, HEAD_DIM), kc, vc, ksl, vsl, kw, vw, nsa_g,
                      pos_k, pos_v, w1_k, w2_k, w1_v, w2_v, nsa_slopes)
    o_gdn = gdn_mixer(gq, gk, gv, gz, ga, gb, conv_w, a_log, dt_bias, gdn_norm_w)
    o_swa = banded_attention(sq.reshape(B, S, SWA_HEADS, HEAD_DIM), sk.reshape(B, S, SWA_KV_HEADS, HEAD_DIM),
                             sv.reshape(B, S, SWA_KV_HEADS, HEAD_DIM), swa_slopes, SWA_WINDOW, sinks).reshape(B, S, SWA_WIDTH)
    return jnp.dot(jnp.concatenate([o_nsa, o_gdn, o_swa], axis=-1), w_out)


def moe_swiglu(h, router, w_gate, w_up, w_down):
    N, D = h.shape
    logits = jnp.dot(h, router).astype(jnp.float32)
    top_logit, top_idx = lax.top_k(logits, TOP_K)
    gate = jax.nn.softmax(top_logit, axis=-1)
    A = N * TOP_K
    e_flat = top_idx.reshape(A)
    tok_flat = jnp.arange(A, dtype=jnp.int32) // TOP_K
    gate_flat = gate.reshape(A)
    order = jnp.argsort(e_flat)
    se, stok, sgate = e_flat[order], tok_flat[order], gate_flat[order]
    counts = jnp.zeros((N_EXPERTS,), jnp.int32).at[e_flat].add(1)
    starts = jnp.cumsum(counts) - counts
    padded = (counts + MOE_BLOCK - 1) // MOE_BLOCK * MOE_BLOCK
    pad_end = jnp.cumsum(padded)
    pad_start = pad_end - padded
    dest = pad_start[se] + jnp.arange(A, dtype=jnp.int32) - starts[se]
    n_blocks = -(-A // MOE_BLOCK) + N_EXPERTS
    P = n_blocks * MOE_BLOCK
    row_tok = jnp.zeros((P,), jnp.int32).at[dest].set(stok)
    row_gate = jnp.zeros((P,), jnp.float32).at[dest].set(sgate)
    blk_expert = jnp.clip(jnp.searchsorted(pad_end, jnp.arange(n_blocks, dtype=jnp.int32) * MOE_BLOCK, side='right'),
                          0, N_EXPERTS - 1)
    xs = h[row_tok].reshape(n_blocks, MOE_BLOCK, D)

    def expert_block(args):
        xb, e = args
        return swiglu(xb, w_gate[e], w_up[e], w_down[e])

    ys = lax.map(expert_block, (xs, blk_expert)).reshape(P, D)
    ys = ys * row_gate[:, None].astype(ys.dtype)
    return jax.ops.segment_sum(ys, row_tok, num_segments=N)


def setup_inputs(seed: int = 0) -> dict:
    key = jax.random.key(seed)
    ks = jax.random.split(key, 24)
    f32 = jnp.float32

    def nrm(k, shape, fan_in):
        return jax.random.normal(k, shape, f32) * (fan_in ** -0.5)

    def gain(k, shape):
        return 1.0 + 0.01 * jax.random.normal(k, shape, f32)

    dt = jnp.exp(jax.random.uniform(ks[11], (DEPTH, GDN_HEADS), f32, math.log(1e-3), math.log(1e-1)))
    return {
        "x": jax.random.normal(ks[0], (BATCH, SEQ, D_MODEL), f32),
        "attn_norm": gain(ks[1], (DEPTH, D_MODEL)),
        "w_in": nrm(ks[2], (DEPTH, D_MODEL, D_IN), D_MODEL),
        "cmp_pos_k": 0.1 * jax.random.normal(ks[3], (DEPTH, CMP_BLOCK, HEAD_DIM), f32),
        "cmp_pos_v": 0.1 * jax.random.normal(ks[4], (DEPTH, CMP_BLOCK, HEAD_DIM), f32),
        "cmp_w1_k": nrm(ks[5], (DEPTH, CMP_BLOCK * HEAD_DIM, CMP_HIDDEN), CMP_BLOCK * HEAD_DIM),
        "cmp_w2_k": nrm(ks[6], (DEPTH, CMP_HIDDEN, HEAD_DIM), CMP_HIDDEN),
        "cmp_w1_v": nrm(ks[7], (DEPTH, CMP_BLOCK * HEAD_DIM, CMP_HIDDEN), CMP_BLOCK * HEAD_DIM),
        "cmp_w2_v": nrm(ks[8], (DEPTH, CMP_HIDDEN, HEAD_DIM), CMP_HIDDEN),
        "gdn_conv_w": nrm(ks[9], (DEPTH, GDN_CONV, 3 * GDN_WIDTH), GDN_CONV),
        "gdn_a_log": jnp.log(jax.random.uniform(ks[10], (DEPTH, GDN_HEADS), f32, 1.0, 16.0)),
        "gdn_dt_bias": dt + jnp.log(-jnp.expm1(-dt)),
        "gdn_norm_w": gain(ks[12], (DEPTH, HEAD_DIM)),
        "swa_sinks": 0.5 * jax.random.normal(ks[13], (DEPTH, SWA_HEADS), f32),
        "w_out": nrm(ks[14], (DEPTH, MIX_WIDTH, D_MODEL), MIX_WIDTH),
        "ffn_norm": gain(ks[15], (DEPTH, D_MODEL)),
        "dense_w_gate": nrm(ks[16], (N_DENSE, D_MODEL, D_FF), D_MODEL),
        "dense_w_up": nrm(ks[17], (N_DENSE, D_MODEL, D_FF), D_MODEL),
        "dense_w_down": nrm(ks[18], (N_DENSE, D_FF, D_MODEL), D_FF),
        "moe_router": nrm(ks[19], (N_MOE, D_MODEL, N_EXPERTS), D_MODEL),
        "moe_w_gate": nrm(ks[20], (N_MOE, N_EXPERTS, D_MODEL, EXPERT_FF), D_MODEL),
        "moe_w_up": nrm(ks[21], (N_MOE, N_EXPERTS, D_MODEL, EXPERT_FF), D_MODEL),
        "moe_w_down": nrm(ks[22], (N_MOE, N_EXPERTS, EXPERT_FF, D_MODEL), EXPERT_FF),
        "final_norm": gain(ks[23], (D_MODEL,)),
    }


def reference(x, attn_norm, w_in, cmp_pos_k, cmp_pos_v, cmp_w1_k, cmp_w2_k, cmp_w1_v, cmp_w2_v,
              gdn_conv_w, gdn_a_log, gdn_dt_bias, gdn_norm_w, swa_sinks, w_out, ffn_norm,
              dense_w_gate, dense_w_up, dense_w_down, moe_router, moe_w_gate, moe_w_up, moe_w_down,
              final_norm):
    nsa_slopes, swa_slopes = alibi_slopes()
    B, S, D = x.shape
    for layer in range(DEPTH):
        h = rmsnorm(x, attn_norm[layer])
        x = x + hybrid_mixer(h, w_in[layer], cmp_pos_k[layer], cmp_pos_v[layer], cmp_w1_k[layer], cmp_w2_k[layer],
                             cmp_w1_v[layer], cmp_w2_v[layer], gdn_conv_w[layer], gdn_a_log[layer],
                             gdn_dt_bias[layer], gdn_norm_w[layer], swa_sinks[layer], w_out[layer],
                             nsa_slopes, swa_slopes)
        h = rmsnorm(x, ffn_norm[layer]).reshape(B * S, D)
        i = layer // 2
        if layer % 2 == 0:
            f = swiglu(h, dense_w_gate[i], dense_w_up[i], dense_w_down[i])
        else:
            f = moe_swiglu(h, moe_router[i], moe_w_gate[i], moe_w_up[i], moe_w_down[i])
        x = x + f.reshape(B, S, D)
    return rmsnorm(x, final_norm)
```

```cpp
#include <hip/hip_runtime.h>
#include <cstdio>
#include <cstdint>

#ifndef MK_PER_PHASE
#define MK_PER_PHASE 1
#endif

#define DI __device__ __forceinline__
#define LAS __attribute__((address_space(3)))
typedef unsigned short bf16_t;
typedef short bf16x8 __attribute__((ext_vector_type(8)));
typedef float f32x4 __attribute__((ext_vector_type(4)));
typedef float f32x2 __attribute__((ext_vector_type(2)));
typedef unsigned u32x4 __attribute__((ext_vector_type(4)));
typedef unsigned u32x2 __attribute__((ext_vector_type(2)));

constexpr int NB = 4, SEQ = 2048, DM = 2048, NTOK = NB * SEQ, HD = 128;
constexpr int DIN = 6428, DINP = 6656;
constexpr int DFF = 7168, NEXP = 8, GU = 2 * DFF;
constexpr int NGH = 8;
constexpr int PMAX = 2 * NTOK + NEXP * 256;
constexpr int C_NQ = 0, C_KC = 512, C_VC = 640, C_KSL = 768, C_VSL = 896, C_KW = 1024, C_VW = 1152, C_GQ = 1280, C_GK = 2304, C_GV = 3328, C_GZ = 4352,
              C_SQ = 5376, C_SK = 5888, C_SV = 6144, C_NG = 6400, C_GA = 6412, C_GB = 6420;
constexpr float EPS = 1e-6f;
constexpr float QSCALE = 0.08838834764831845f;

constexpr size_t MiB = 1u << 20;
constexpr size_t WS_CTL = 0, CTL_BYTES = 1 * MiB;
constexpr size_t SZ_WIN = (size_t)DINP * DM * 2, SZ_WOUT = (size_t)DM * DM * 2, SZ_WGU = (size_t)GU * DM * 2, SZ_WDN = (size_t)DM * DFF * 2;
constexpr size_t WS_WIN = 2 * MiB;
constexpr size_t WS_WOUT = WS_WIN + 2 * SZ_WIN;
constexpr size_t WS_DGU = WS_WOUT + 2 * SZ_WOUT;
constexpr size_t WS_DDN = WS_DGU + SZ_WGU;
constexpr size_t WS_MGU = WS_DDN + SZ_WDN;
constexpr size_t WS_MDN = WS_MGU + NEXP * SZ_WGU;
constexpr size_t WS_HB = WS_MDN + NEXP * SZ_WDN;
constexpr size_t WS_MIX = WS_HB + (size_t)NTOK * DM * 2;
constexpr size_t WS_X = WS_MIX + (size_t)NTOK * DM * 2;
constexpr size_t WS_HPERM = WS_X + (size_t)NTOK * DM * 4;
constexpr size_t WS_Y = WS_HPERM + (size_t)PMAX * DM * 2;
constexpr size_t WS_RT = WS_Y + (size_t)PMAX * DM * 4;
constexpr size_t WS_KC = WS_RT + 1 * MiB;
constexpr size_t WS_OVL = WS_KC + 1 * MiB;
constexpr size_t WS_ACT = WS_OVL;
constexpr size_t WS_PROJ = WS_OVL;
constexpr size_t SZ_G = (size_t)NB * NGH * SEQ * HD * 4;
constexpr size_t WS_GU_ = WS_PROJ + (size_t)NTOK * DINP * 2;
constexpr size_t WS_GW = WS_GU_ + SZ_G, WS_GQ = WS_GW + SZ_G, WS_GK = WS_GQ + SZ_G;
constexpr size_t WS_GAT = WS_GK + SZ_G;
constexpr size_t WS_GO = WS_GAT + 16 * MiB;
constexpr size_t WS_GGL = WS_GO + 32 * MiB;
constexpr size_t OVL_A = (size_t)PMAX * DFF * 2, OVL_B = (WS_GGL + 1 * MiB) - WS_OVL;
constexpr size_t WS_END = WS_OVL + (OVL_A > OVL_B ? OVL_A : OVL_B);
constexpr size_t RT_TOPI = 0, RT_TOPG = 65536, RT_POS = 131072, RT_RGATE = 196608, RT_TEXP = 294912, RT_NTILES = 295936;

constexpr int CW_BAR = 4096;

constexpr int LDS_SCR = 0, LDS_SCR_BYTES = 153600;
constexpr int LDS_MISC = LDS_SCR_BYTES;
constexpr int LDS_BYTES = LDS_SCR_BYTES + 256;

DI float bf2f(unsigned v) { return __uint_as_float(v << 16); }
DI float bflo(unsigned v) { return __uint_as_float(v << 16); }
DI float bfhi(unsigned v) { return __uint_as_float(v & 0xffff0000u); }
DI unsigned f2bf(float f) { unsigned u = __float_as_uint(f); return (u + 0x7fffu + ((u >> 16) & 1u)) >> 16; }
DI unsigned pk2(float lo, float hi) { return f2bf(lo) | (f2bf(hi) << 16); }
DI unsigned cvt_pk_bf16(float lo, float hi) { unsigned r; asm volatile("v_cvt_pk_bf16_f32 %0, %1, %2" : "=v"(r) : "v"(lo), "v"(hi)); return r; }
#define DPPF(x, ctrl) __builtin_bit_cast(float, __builtin_amdgcn_update_dpp(0, __builtin_bit_cast(int, (x)), (ctrl), 0xf, 0xf, true))
DI float wave_sum(float v) {
    v += DPPF(v, 0xB1);
    v += DPPF(v, 0x4E);
    v += DPPF(v, 0x141);
    v += DPPF(v, 0x140);
    v += __builtin_bit_cast(float, __builtin_amdgcn_ds_swizzle(__builtin_bit_cast(int, v), 0x401F));
    return __builtin_bit_cast(float, __builtin_amdgcn_readlane(__builtin_bit_cast(int, v), 0)) + __builtin_bit_cast(float, __builtin_amdgcn_readlane(__builtin_bit_cast(int, v), 32));
}
DI float wave_max(float v) {
    v = fmaxf(v, DPPF(v, 0xB1));
    v = fmaxf(v, DPPF(v, 0x4E));
    v = fmaxf(v, DPPF(v, 0x141));
    v = fmaxf(v, DPPF(v, 0x140));
    v = fmaxf(v, __builtin_bit_cast(float, __builtin_amdgcn_ds_swizzle(__builtin_bit_cast(int, v), 0x401F)));
    return fmaxf(__builtin_bit_cast(float, __builtin_amdgcn_readlane(__builtin_bit_cast(int, v), 0)), __builtin_bit_cast(float, __builtin_amdgcn_readlane(__builtin_bit_cast(int, v), 32)));
}
DI int wave_sum_i(int v) {
    v += __builtin_amdgcn_update_dpp(0, v, 0xB1, 0xf, 0xf, true);
    v += __builtin_amdgcn_update_dpp(0, v, 0x4E, 0xf, 0xf, true);
    v += __builtin_amdgcn_update_dpp(0, v, 0x141, 0xf, 0xf, true);
    v += __builtin_amdgcn_update_dpp(0, v, 0x140, 0xf, 0xf, true);
    v += __builtin_amdgcn_ds_swizzle(v, 0x401F);
    return __builtin_amdgcn_readlane(v, 0) + __builtin_amdgcn_readlane(v, 32);
}
DI float sigmoidf_(float x) { return 1.f / (1.f + __expf(-x)); }
DI float siluf_(float x) { return x / (1.f + __expf(-x)); }
DI float softplusf_(float x) { return x > 20.f ? x : log1pf(__expf(x)); }
#define LDS_WAIT() asm volatile("s_waitcnt lgkmcnt(0)" ::: "memory")

#define XB_TMO      128
#define XB_XCNT(j)  (256  + 64 * (j))
#define XB_XSUB(j)  (1280 + 64 * (j))
#define XB_XGEN(j)  (2304 + 64 * (j))
#define XB_TOP      3328
#define XB_TOPGEN   3392
#define XCD_BAR_WORDS 3456
#define XB_SPIN_CAP (1u << 22)
DI unsigned xb_ld(unsigned* p)              { return __hip_atomic_load(p, __ATOMIC_RELAXED, __HIP_MEMORY_SCOPE_AGENT); }
DI unsigned xb_add(unsigned* p, unsigned v) { return __hip_atomic_fetch_add(p, v, __ATOMIC_RELAXED, __HIP_MEMORY_SCOPE_AGENT); }
DI unsigned xb_xcc_id() { return (unsigned)__builtin_amdgcn_s_getreg((3 << 11) | 20) & 0xFu; }
#define XB_SPIN(cond, bar) do { unsigned _sp = 0; while (cond) { __builtin_amdgcn_s_sleep(1); \
    if ((++_sp & 255u) == 0u) { if (xb_ld(&(bar)[XB_TMO])) break; if (_sp > XB_SPIN_CAP) { atomicAdd(&(bar)[XB_TMO], 1u); break; } } } } while (0)
struct XcdBarrier { unsigned* bar; unsigned x; volatile LAS unsigned* st; };
DI XcdBarrier xcd_barrier_post(unsigned* bar, volatile LAS unsigned* st) {
    XcdBarrier b; b.bar = bar; b.x = xb_xcc_id(); b.st = st;
    if (threadIdx.x == 0) (void)xb_add(&bar[XB_XCNT(b.x)], 1u);
    return b;
}
DI void xcd_barrier_complete(unsigned* bar, unsigned x, unsigned& nloc, unsigned& nx) {
    const unsigned G = gridDim.x * gridDim.y * gridDim.z;
    unsigned sum, cnt, mine, sp = 0u;
    for (;;) {
        sum = 0u; cnt = 0u; mine = 0u;
#pragma unroll
        for (unsigned j = 0; j < 16; ++j) { const unsigned c = xb_ld(&bar[XB_XCNT(j)]); sum += c; cnt += (c > 0u) ? 1u : 0u; mine = (j == x) ? c : mine; }
        if (sum == G) break;
        __builtin_amdgcn_s_sleep(1);
        if ((++sp & 255u) == 0u) { if (xb_ld(&bar[XB_TMO])) break; if (sp > XB_SPIN_CAP) { atomicAdd(&bar[XB_TMO], 1u); break; } }
    }
    nloc = mine > 0u ? mine : 1u; nx = cnt > 0u ? cnt : 1u;
}
DI void xcd_barrier(const XcdBarrier& b) {
    asm volatile("s_waitcnt vmcnt(0)" ::: "memory");
    __syncthreads();
    if (threadIdx.x == 0) {
        unsigned* bar = b.bar;
        __builtin_amdgcn_s_waitcnt(0);
        unsigned nloc = b.st[0], nx = b.st[1];
        if (nloc == 0u) { xcd_barrier_complete(bar, b.x, nloc, nx); b.st[0] = nloc; b.st[1] = nx; }
        const unsigned old = xb_add(&bar[XB_XSUB(b.x)], 1u);
        const unsigned gen = old / nloc;
        if (old + 1u == (gen + 1u) * nloc) {
            __builtin_amdgcn_fence(__ATOMIC_RELEASE, "agent");
            asm volatile("s_waitcnt vmcnt(0)" ::: "memory");
            const unsigned og = xb_add(&bar[XB_TOP], 1u);
            const unsigned tg = og / nx;
            if (og + 1u == (tg + 1u) * nx) xb_add(&bar[XB_TOPGEN], 1u);
            else XB_SPIN(xb_ld(&bar[XB_TOPGEN]) == tg, bar);
            __builtin_amdgcn_fence(__ATOMIC_ACQUIRE, "agent");
            xb_add(&bar[XB_XGEN(b.x)], 1u);
            asm volatile("s_waitcnt vmcnt(0)" ::: "memory");
        } else {
            XB_SPIN(xb_ld(&bar[XB_XGEN(b.x)]) == gen, bar);
            __builtin_amdgcn_fence(__ATOMIC_ACQUIRE, "agent");
            asm volatile("s_waitcnt vmcnt(0)" ::: "memory");
        }
    }
    __syncthreads();
}

namespace pg8 {
constexpr int BM = 256, BK = 64, HALF = 128, HTB = HALF * BK * 2, STAGE_BYTES = 8 * HTB, NXCD = 8, WGM = 8;
__host__ __device__ __forceinline__ int lds_byte(int r, int c) { const int st = (r >> 4) * 2 + (c >> 5), rr = r & 15, cc = c & 31, ob = rr * 64 + cc * 2; return st * 1024 + (ob ^ (((ob >> 9) & 1) << 5)); }
__host__ __device__ __forceinline__ void stage_rc(int b, int& R, int& C) { const int st = b / 1024, sb = b % 1024, swz = sb ^ (((sb >> 9) & 1) << 5); R = (st >> 1) * 16 + swz / 64; C = (st & 1) * 32 + (swz % 64) / 2; }
__host__ __device__ __forceinline__ int perm32(int rho) { const int n = rho >> 4, i = rho & 15; return 8 * (i >> 2) + 4 * n + (i & 3); }
struct Unit { int pm, pn; };
DI bool order_next(int i, int G, int c, int nM, int nN, Unit& u) {
    const int nwg = nM * nN; const long L = (long)i * G + c; if (L >= nwg) return false;
    int wgid = (int)L; { const int q = nwg / NXCD, r = nwg % NXCD, xcd = wgid % NXCD, off = wgid / NXCD; wgid = (xcd < r ? xcd * (q + 1) : r * (q + 1) + (xcd - r) * q) + off; }
    const int nig = WGM * nN, gid = wgid / nig, fm = gid * WGM, gsz = (nM - fm) < WGM ? (nM - fm) : WGM;
    u.pm = fm + ((wgid % nig) % gsz); u.pn = (wgid % nig) / gsz; return true;
}
struct StaticOrder {
    const char* A; const char* Bt; int nM, nN, G, c; size_t a_tstep, b_tstep;
    DI void init(const bf16_t* A_, int lda, const bf16_t* Bt_, int M, int N, int K, int G_, int c_) { A = (const char*)A_; Bt = (const char*)Bt_; nM = M / BM; nN = N / BM; G = G_; c = c_; a_tstep = (size_t)BM * lda * 2; b_tstep = (size_t)BM * K * 2; }
    DI bool next(int i, Unit& u) const { return order_next(i, G, c, nM, nN, u); }
    DI const char* abase(const Unit& u) const { return A + (size_t)u.pm * a_tstep; }
    DI const char* bbase(const Unit& u) const { return Bt + (size_t)u.pn * b_tstep; }
};
struct MoeOrder {
    const char* A; const char* W; const int* texp; int nM, nN, G, c; size_t a_tstep, b_tstep, estride;
    DI void init(const bf16_t* A_, int lda, const bf16_t* W_, size_t estride_bytes, const int* texp_, int ntiles, int N, int K, int G_, int c_) {
        A = (const char*)A_; W = (const char*)W_; texp = texp_; nM = ntiles; nN = N / BM; G = G_; c = c_; a_tstep = (size_t)BM * lda * 2; b_tstep = (size_t)BM * K * 2; estride = estride_bytes; }
    DI bool next(int i, Unit& u) const { return order_next(i, G, c, nM, nN, u); }
    DI const char* abase(const Unit& u) const { return A + (size_t)u.pm * a_tstep; }
    DI const char* bbase(const Unit& u) const { const int e = __builtin_amdgcn_readfirstlane(texp[u.pm]); return W + (size_t)e * estride + (size_t)u.pn * b_tstep; }
};
struct EpiBf16 {
    static constexpr bool PERM = true;
    bf16_t* O; int ldc;
    DI void operator()(const f32x4 (&acc)[2][2][4][2], const Unit& u, int wr, int wc, int fr, int fq) const {
        const int row0 = u.pm * BM + wr * 64 + fr, col0 = u.pn * BM + wc * 32 + 8 * fq;
#pragma unroll
        for (int ai = 0; ai < 2; ++ai)
#pragma unroll
            for (int m = 0; m < 4; ++m) { bf16_t* rowp = O + (size_t)(row0 + ai * HALF + m * 16) * ldc + col0;
#pragma unroll
                for (int bj = 0; bj < 2; ++bj) { const f32x4 v0 = acc[ai][bj][m][0], v1 = acc[ai][bj][m][1];
                    u32x4 w; w.x = cvt_pk_bf16(v0[0], v0[1]); w.y = cvt_pk_bf16(v0[2], v0[3]); w.z = cvt_pk_bf16(v1[0], v1[1]); w.w = cvt_pk_bf16(v1[2], v1[3]);
                    *(u32x4*)(rowp + bj * HALF) = w; } }
    }
};
struct EpiSwiGLU {
    static constexpr bool PERM = true;
    bf16_t* O; int ldc;
    DI void operator()(const f32x4 (&acc)[2][2][4][2], const Unit& u, int wr, int wc, int fr, int fq) const {
        const int row0 = u.pm * BM + wr * 64 + fr, col0 = u.pn * HALF + wc * 32 + 8 * fq;
#pragma unroll
        for (int ai = 0; ai < 2; ++ai)
#pragma unroll
            for (int m = 0; m < 4; ++m) { bf16_t* rowp = O + (size_t)(row0 + ai * HALF + m * 16) * ldc + col0;
                float o[8];
#pragma unroll
                for (int n = 0; n < 2; ++n)
#pragma unroll
                    for (int j = 0; j < 4; ++j) { const float g = acc[ai][0][m][n][j], up = acc[ai][1][m][n][j]; o[n * 4 + j] = g * __builtin_amdgcn_rcpf(1.f + __expf(-g)) * up; }
                u32x4 w; w.x = cvt_pk_bf16(o[0], o[1]); w.y = cvt_pk_bf16(o[2], o[3]); w.z = cvt_pk_bf16(o[4], o[5]); w.w = cvt_pk_bf16(o[6], o[7]);
                *(u32x4*)rowp = w; }
    }
};
struct EpiResid {
    static constexpr bool PERM = false;
    const float* resid; float* out; int ldc;
    DI void operator()(const f32x4 (&acc)[2][2][4][2], const Unit& u, int wr, int wc, int fr, int fq) const {
        const int row0 = u.pm * BM + wr * 64 + fr, col0 = u.pn * BM + wc * 32 + 4 * fq;
#pragma unroll
        for (int ai = 0; ai < 2; ++ai)
#pragma unroll
            for (int m = 0; m < 4; ++m) { const size_t off = (size_t)(row0 + ai * HALF + m * 16) * ldc + col0;
#pragma unroll
                for (int bj = 0; bj < 2; ++bj)
#pragma unroll
                    for (int n = 0; n < 2; ++n) { const f32x4 r = *(const f32x4*)(resid + off + bj * HALF + n * 16); *(f32x4*)(out + off + bj * HALF + n * 16) = r + acc[ai][bj][m][n]; } }
    }
};
struct EpiRowScale {
    static constexpr bool PERM = false;
    const float* rscale; float* out; int ldc;
    DI void operator()(const f32x4 (&acc)[2][2][4][2], const Unit& u, int wr, int wc, int fr, int fq) const {
        const int row0 = u.pm * BM + wr * 64 + fr, col0 = u.pn * BM + wc * 32 + 4 * fq;
#pragma unroll
        for (int ai = 0; ai < 2; ++ai)
#pragma unroll
            for (int m = 0; m < 4; ++m) { const int row = row0 + ai * HALF + m * 16; const float s = rscale[row]; const size_t off = (size_t)row * ldc + col0;
#pragma unroll
                for (int bj = 0; bj < 2; ++bj)
#pragma unroll
                    for (int n = 0; n < 2; ++n) *(f32x4*)(out + off + bj * HALF + n * 16) = acc[ai][bj][m][n] * s; }
    }
};

template <class Epi, class Sched, bool ALIGN_EPI = true, bool SP2 = true>
DI void gemm_phase(LAS unsigned char* lds, const int K, const int lda, const Sched& S, const Epi& E) {
    int tid = threadIdx.x; asm volatile("" : "+v"(tid));
    const int wid = __builtin_amdgcn_readfirstlane(tid >> 6), lane = tid & 63, wr = wid >> 2, wc = wid & 3, fr = lane & 15, fq = lane >> 4;
    const int nt = K / BK;
    unsigned voffA[2], voffB[2];
#pragma unroll
    for (int i = 0; i < 2; ++i) { int R, C; stage_rc(tid * 16 + i * 8192, R, C); const int Rb = Epi::PERM ? ((R & ~31) + perm32(R & 31)) : R;
        voffA[i] = (unsigned)(R * lda + C) * 2u; voffB[i] = (unsigned)(Rb * K + C) * 2u; }
    const size_t kstep = (size_t)(BK * 2);
    const size_t hstepA = (size_t)HALF * lda * 2, hstepB = (size_t)HALF * K * 2;
    const unsigned ldsw = (unsigned)wid * 1024u;
    const int aoff = lds_byte(wr * 64 + fr, fq * 8), boff = lds_byte(wc * 32 + fr, fq * 8);
#define PG8_SA(b, h) (((b) * 2 + (h)) * HTB)
#define PG8_SB(b, h) ((4 + (b) * 2 + (h)) * HTB)
#define PG8_STAGE(bufoff, gbase, voff) do { _Pragma("unroll") for (int _i = 0; _i < 2; ++_i) \
        __builtin_amdgcn_global_load_lds((const unsigned*)((const char*)(gbase) + (voff)[_i]), (LAS unsigned*)(lds + (bufoff) + ldsw + _i * 8192), 16, 0, 0); } while (0)
#define PG8_LDA(dst, b, h) do { _Pragma("unroll") for (int m = 0; m < 4; ++m) _Pragma("unroll") for (int k = 0; k < 2; ++k) dst[m][k] = *(const LAS bf16x8*)(lds + PG8_SA(b, h) + aoff + m * 2048 + k * 1024); } while (0)
#define PG8_LDB(dst, b, h) do { _Pragma("unroll") for (int n = 0; n < 2; ++n) _Pragma("unroll") for (int k = 0; k < 2; ++k) dst[n][k] = *(const LAS bf16x8*)(lds + PG8_SB(b, h) + boff + n * 2048 + k * 1024); } while (0)
#define PG8_MMA(ai, bj, At, Bt) do { __builtin_amdgcn_s_setprio(1); _Pragma("unroll") for (int m = 0; m < 4; ++m) _Pragma("unroll") for (int n = 0; n < 2; ++n) _Pragma("unroll") for (int k = 0; k < 2; ++k) \
        acc[ai][bj][m][n] = __builtin_amdgcn_mfma_f32_16x16x32_bf16(Bt[n][k], At[m][k], acc[ai][bj][m][n], 0, 0, 0); __builtin_amdgcn_s_setprio(0); } while (0)
#define PG8_WAIT_V(n) asm volatile("s_waitcnt vmcnt(" #n ")" ::: "memory")
#define PG8_WAIT_L(n) asm volatile("s_waitcnt lgkmcnt(" #n ")" ::: "memory")
#define PG8_BAR __builtin_amdgcn_s_barrier()
#define PG8_SCHED __builtin_amdgcn_sched_barrier(0)
    Unit cur, nxt; int ui = 0;
    if (!S.next(0, cur)) return;
    f32x4 acc[2][2][4][2];
#pragma unroll
    for (int a = 0; a < 2; ++a)
#pragma unroll
        for (int b = 0; b < 2; ++b)
#pragma unroll
            for (int m = 0; m < 4; ++m)
#pragma unroll
                for (int n = 0; n < 2; ++n) acc[a][b][m][n] = (f32x4){0.f, 0.f, 0.f, 0.f};
    bf16x8 At[4][2], B0[2][2], B1[2][2];
    const char* cA = S.abase(cur); const char* cB = S.bbase(cur);
    static_assert(SP2, "only the SP2 loop is kept");
    PG8_STAGE(PG8_SB(0, 0), cB, voffB); PG8_STAGE(PG8_SB(0, 1), cB + hstepB, voffB); PG8_STAGE(PG8_SA(0, 0), cA, voffA); PG8_STAGE(PG8_SA(0, 1), cA + hstepA, voffA);
    if (wr == 1) PG8_BAR;
    PG8_WAIT_V(2); PG8_BAR;
    PG8_STAGE(PG8_SB(1, 0), cB + kstep, voffB); PG8_STAGE(PG8_SA(1, 0), cA + kstep, voffA); PG8_STAGE(PG8_SB(1, 1), cB + hstepB + kstep, voffB);
    PG8_WAIT_V(6); PG8_BAR;
    for (;;) {
        const bool has_next = S.next(ui + 1, nxt);
        const char* nA = has_next ? S.abase(nxt) : cA; const char* nB = has_next ? S.bbase(nxt) : cB;
        for (int t = 0; t < nt; t += 2) {
            const bool last = (t == nt - 2);
            const char* a1 = cA + (size_t)(t + 1) * kstep;
            const char* a2 = last ? nA : cA + (size_t)(t + 2) * kstep; const char* b2 = last ? nB : cB + (size_t)(t + 2) * kstep;
            const char* a3 = a2 + kstep; const char* b3 = b2 + kstep;
            PG8_LDB(B0, 0, 0); PG8_LDB(B1, 0, 1); PG8_SCHED; PG8_LDA(At, 0, 0); PG8_STAGE(PG8_SA(1, 1), a1 + hstepA, voffA);
            PG8_WAIT_V(8); PG8_WAIT_L(0); PG8_BAR; PG8_MMA(0, 0, At, B0); PG8_MMA(0, 1, At, B1); PG8_BAR; PG8_SCHED;
            PG8_LDA(At, 0, 1); PG8_STAGE(PG8_SB(0, 0), b2, voffB); PG8_STAGE(PG8_SB(0, 1), b2 + hstepB, voffB); PG8_STAGE(PG8_SA(0, 0), a2, voffA);
            PG8_WAIT_V(8); PG8_WAIT_L(0); PG8_BAR; PG8_MMA(1, 0, At, B0); PG8_MMA(1, 1, At, B1); PG8_BAR; PG8_SCHED;
            PG8_LDB(B0, 1, 0); PG8_LDB(B1, 1, 1); PG8_SCHED; PG8_LDA(At, 1, 0); PG8_STAGE(PG8_SA(0, 1), a2 + hstepA, voffA);
            PG8_WAIT_V(8); PG8_WAIT_L(0); PG8_BAR; PG8_MMA(0, 0, At, B0); PG8_MMA(0, 1, At, B1); PG8_BAR; PG8_SCHED;
            PG8_LDA(At, 1, 1); PG8_STAGE(PG8_SB(1, 0), b3, voffB); PG8_STAGE(PG8_SB(1, 1), b3 + hstepB, voffB); PG8_STAGE(PG8_SA(1, 0), a3, voffA);
            PG8_WAIT_V(8); PG8_WAIT_L(0); PG8_BAR; PG8_MMA(1, 0, At, B0); PG8_MMA(1, 1, At, B1); PG8_BAR; PG8_SCHED;
        }
        if constexpr (ALIGN_EPI) { if (wr == 0) PG8_BAR; }
        E(acc, cur, wr, wc, fr, fq);
        if (!has_next) break;
#pragma unroll
        for (int a = 0; a < 2; ++a)
#pragma unroll
            for (int b = 0; b < 2; ++b)
#pragma unroll
                for (int m = 0; m < 4; ++m)
#pragma unroll
                    for (int n = 0; n < 2; ++n) acc[a][b][m][n] = (f32x4){0.f, 0.f, 0.f, 0.f};
        cur = nxt; cA = nA; cB = nB; ++ui;
        if constexpr (ALIGN_EPI) { if (wr == 1) PG8_BAR; }
    }
    PG8_WAIT_V(0);
    if constexpr (!ALIGN_EPI) { if (wr == 0) PG8_BAR; }
    PG8_BAR;
#undef PG8_SA
#undef PG8_SB
#undef PG8_STAGE
#undef PG8_LDA
#undef PG8_LDB
#undef PG8_MMA
#undef PG8_WAIT_V
#undef PG8_WAIT_L
#undef PG8_BAR
#undef PG8_SCHED
}
}

struct Args { const float* in[24]; float* out; unsigned char* ws; int ph_lo, ph_hi; };
enum { I_X = 0, I_ATTN_NORM, I_W_IN, I_POS_K, I_POS_V, I_W1K, I_W2K, I_W1V, I_W2V, I_CONV, I_ALOG, I_DTB, I_GNORM, I_SINKS, I_W_OUT, I_FFN_NORM,
       I_DGATE, I_DUP, I_DDOWN, I_ROUTER, I_MGATE, I_MUP, I_MDOWN, I_FINAL };
struct Frame {
    LAS unsigned char* lds;
    int tid, lane, wave, G, bid;
    float* out; unsigned char* ws;
    DI void refresh() { int t = threadIdx.x; asm volatile("" : "+v"(t)); tid = t; lane = t & 63; wave = __builtin_amdgcn_readfirstlane(t >> 6); }
};

template <class F> DI void tr_item(const float* W, int ldw, int k0, bf16_t* dst, int K, LAS float* scr, int lane, F srccol) {
    const int r = lane & 31; const int sc = srccol(r);
#pragma unroll 8
    for (int i = 0; i < 32; ++i) { const int kk = 2 * i + (lane >> 5); scr[kk * 33 + r] = sc >= 0 ? W[(size_t)(k0 + kk) * ldw + sc] : 0.f; }
    LDS_WAIT();
    const int c = lane & 7;
#pragma unroll
    for (int j = 0; j < 4; ++j) { const int n = (lane >> 3) + 8 * j; const LAS float* s = scr + (8 * c) * 33 + n;
        u32x4 o; o.x = pk2(s[0 * 33], s[1 * 33]); o.y = pk2(s[2 * 33], s[3 * 33]); o.z = pk2(s[4 * 33], s[5 * 33]); o.w = pk2(s[6 * 33], s[7 * 33]);
        *(u32x4*)(dst + (size_t)n * K + k0 + 8 * c) = o; }
    LDS_WAIT();
}
DI int win_srccol(int n) { return n < 1280 ? n : n < 5376 ? n + 12 : n < 6400 ? n + 28 : n < 6412 ? 1280 + (n - 6400) : n < 6428 ? 5388 + (n - 6412) : -1; }
DI void phase_convert(Frame& F, const float* w_in, const float* w_out, const float* dgate, const float* dup, const float* ddown, const float* mgate, const float* mup, const float* mdown) {
    LAS float* scr = (LAS float*)(F.lds + LDS_SCR + F.wave * 16384);
    const int gw = F.bid * 8 + F.wave, NGW = F.G * 8;
    constexpr int I_WIN = 32 * (DINP / 32), I_WOUT = 32 * (DM / 32), I_GUK = 32 * (GU / 32), I_DN = (DFF / 64) * (DM / 32);
    constexpr int T0 = 2 * I_WIN, T1 = T0 + 2 * I_WOUT, T2 = T1 + I_GUK, T3 = T2 + I_DN, T4 = T3 + NEXP * I_GUK, T5 = T4 + NEXP * I_DN;
    for (int it = gw; it < T5; it += NGW) {
        if (it < T0) { const int L = it / I_WIN, r = it % I_WIN, nblk = DINP / 32, kb = r / nblk, nb = r % nblk;
            tr_item(w_in + (size_t)L * DM * DIN, DIN, 64 * kb, (bf16_t*)(F.ws + WS_WIN + L * SZ_WIN) + (size_t)(32 * nb) * DM, DM, scr, F.lane, [&](int rr) { return win_srccol(32 * nb + rr); });
        } else if (it < T1) { const int q = it - T0, L = q / I_WOUT, r = q % I_WOUT, nblk = DM / 32, kb = r / nblk, nb = r % nblk;
            tr_item(w_out + (size_t)L * DM * DM, DM, 64 * kb, (bf16_t*)(F.ws + WS_WOUT + L * SZ_WOUT) + (size_t)(32 * nb) * DM, DM, scr, F.lane, [&](int rr) { return 32 * nb + rr; });
        } else if (it < T2 || (it >= T3 && it < T4)) {
            const bool moe = it >= T3; const int q = moe ? it - T3 : it - T1; const int e = moe ? q / I_GUK : 0, r = q % I_GUK, nblk = GU / 32, kb = r / nblk, nb = r % nblk;
            const int d0 = 32 * nb, j = d0 >> 8, half = (d0 >> 7) & 1, c0 = d0 & 127;
            const float* src = moe ? (half ? mup : mgate) + (size_t)e * DM * DFF : (half ? dup : dgate);
            bf16_t* dst = (bf16_t*)(F.ws + (moe ? WS_MGU + e * SZ_WGU : WS_DGU)) + (size_t)d0 * DM;
            tr_item(src, DFF, 64 * kb, dst, DM, scr, F.lane, [&](int rr) { return 128 * j + c0 + rr; });
        } else { const bool moe = it >= T4; const int q = moe ? it - T4 : it - T2; const int e = moe ? q / I_DN : 0, r = q % I_DN, nblk = DM / 32, kb = r / nblk, nb = r % nblk;
            const float* src = moe ? mdown + (size_t)e * DFF * DM : ddown;
            bf16_t* dst = (bf16_t*)(F.ws + (moe ? WS_MDN + e * SZ_WDN : WS_DDN)) + (size_t)(32 * nb) * DFF;
            tr_item(src, DM, 64 * kb, dst, DFF, scr, F.lane, [&](int rr) { return 32 * nb + rr; });
        }
    }
}

template <bool ROUTER> DI void phase_norm(Frame& F, const float* x, const float* w, bf16_t* hb, const float* router) {
    LAS float* rl = (LAS float*)(F.lds + LDS_SCR);
    if (ROUTER) { for (int i = F.tid; i < DM * NEXP / 4; i += 512) ((LAS f32x4*)rl)[i] = ((const f32x4*)router)[i]; __syncthreads(); }
    int* topi = (int*)(F.ws + WS_RT + RT_TOPI); float* topg = (float*)(F.ws + WS_RT + RT_TOPG);
    const int gw = F.bid * 8 + F.wave, NGW = F.G * 8;
    for (int m = gw; m < NTOK; m += NGW) {
        const f32x4* xr = (const f32x4*)(x + (size_t)m * DM) + F.lane;
        f32x4 v[8]; float s = 0.f;
#pragma unroll
        for (int j = 0; j < 8; ++j) { v[j] = xr[64 * j]; s += (v[j].x * v[j].x + v[j].y * v[j].y) + (v[j].z * v[j].z + v[j].w * v[j].w); }
        const float rs = rsqrtf(wave_sum(s) * (1.f / DM) + EPS);
        float lg[NEXP];
        if (ROUTER) {
#pragma unroll
            for (int e = 0; e < NEXP; ++e) lg[e] = 0.f; }
        u32x2* o8 = (u32x2*)(hb + (size_t)m * DM) + F.lane;
#pragma unroll
        for (int j = 0; j < 8; ++j) { const f32x4 w4 = ((const f32x4*)w)[F.lane + 64 * j]; const f32x4 y = v[j] * rs * w4;
            u32x2 o; o.x = pk2(y.x, y.y); o.y = pk2(y.z, y.w); o8[64 * j] = o;
            if (ROUTER) {
#pragma unroll
                for (int i = 0; i < 4; ++i) { const int k = 4 * (F.lane + 64 * j) + i; const f32x4 r0 = *(const LAS f32x4*)(rl + k * 8), r1 = *(const LAS f32x4*)(rl + k * 8 + 4); const float yy = y[i];
                    lg[0] += yy * r0.x; lg[1] += yy * r0.y; lg[2] += yy * r0.z; lg[3] += yy * r0.w; lg[4] += yy * r1.x; lg[5] += yy * r1.y; lg[6] += yy * r1.z; lg[7] += yy * r1.w; }
                asm volatile("" ::: "memory"); } }
        if (ROUTER) {
#pragma unroll
            for (int e = 0; e < NEXP; ++e) lg[e] = wave_sum(lg[e]);
            int i1 = 0; float l1 = lg[0];
#pragma unroll
            for (int e = 1; e < NEXP; ++e) if (lg[e] > l1) { l1 = lg[e]; i1 = e; }
            int i2 = -1; float l2 = -3.0e38f;
#pragma unroll
            for (int e = 0; e < NEXP; ++e) if (e != i1 && lg[e] > l2) { l2 = lg[e]; i2 = e; }
            const float g1 = 1.f / (1.f + __expf(l2 - l1)), g2 = 1.f - g1;
            if (F.lane == 0) { topi[2 * m] = i1; topi[2 * m + 1] = i2; topg[2 * m] = g1; topg[2 * m + 1] = g2; }
        }
    }
    if (ROUTER) __syncthreads();
}

template <int NH> struct AttState { float m[NH], l[NH], a0[NH], a1[NH]; };
template <int NH> DI void att_init(AttState<NH>& st) {
#pragma unroll
    for (int h = 0; h < NH; ++h) { st.m[h] = -1e30f; st.l[h] = 0.f; st.a0[h] = 0.f; st.a1[h] = 0.f; } }
template <int NH> DI void att_batch(AttState<NH>& st, const LAS float* qs, LAS float* pbuf, const bf16_t* Kb, const bf16_t* Vb, size_t stride, int k0, bool valid, float dist,
                                    const float (&slope)[NH], float (&sraw)[NH], int lane) {
    float s[NH];
#pragma unroll
    for (int h = 0; h < NH; ++h) s[h] = 0.f;
    const bf16_t* krow = Kb + (size_t)(k0 + lane) * stride;
#pragma unroll 4
    for (int d8 = 0; d8 < 16; ++d8) {
        const u32x4 kv = *(const u32x4*)(krow + 8 * d8);
        const float k0f = bflo(kv.x), k1f = bfhi(kv.x), k2f = bflo(kv.y), k3f = bfhi(kv.y), k4f = bflo(kv.z), k5f = bfhi(kv.z), k6f = bflo(kv.w), k7f = bfhi(kv.w);
#pragma unroll
        for (int h = 0; h < NH; ++h) { const f32x4 qa = *(const LAS f32x4*)(qs + h * 128 + 8 * d8), qb = *(const LAS f32x4*)(qs + h * 128 + 8 * d8 + 4);
            s[h] += (k0f * qa.x + k1f * qa.y) + (k2f * qa.z + k3f * qa.w) + (k4f * qb.x + k5f * qb.y) + (k6f * qb.z + k7f * qb.w); }
    }
#pragma unroll
    for (int h = 0; h < NH; ++h) {
        const float sv = valid ? s[h] - slope[h] * dist : -1e30f; sraw[h] = sv;
        const float bm = wave_max(sv), mn = fmaxf(st.m[h], bm);
        const float p = valid ? __expf(sv - mn) : 0.f, sc = __expf(st.m[h] - mn);
        st.l[h] = st.l[h] * sc + wave_sum(p); st.a0[h] *= sc; st.a1[h] *= sc; st.m[h] = mn;
        pbuf[h * 64 + lane] = p;
    }
    LDS_WAIT();
    const bf16_t* vb = Vb + (size_t)k0 * stride + 2 * lane;
#pragma unroll 2
    for (int j = 0; j < 64; j += 4) {
        f32x4 p4[NH];
#pragma unroll
        for (int h = 0; h < NH; ++h) p4[h] = *(const LAS f32x4*)(pbuf + h * 64 + j);
#pragma unroll
        for (int jj = 0; jj < 4; ++jj) { const unsigned vv = *(const unsigned*)(vb + (size_t)(j + jj) * stride); const float v0 = bflo(vv), v1 = bfhi(vv);
#pragma unroll
            for (int h = 0; h < NH; ++h) { st.a0[h] += p4[h][jj] * v0; st.a1[h] += p4[h][jj] * v1; } }
    }
    LDS_WAIT();
}

DI void swa_item(Frame& F, const float* sinks, int b, int t, int g, LAS float* qs, LAS float* pbuf) {
    const bf16_t* proj = (const bf16_t*)(F.ws + WS_PROJ);
    const bf16_t* prow = proj + (size_t)(b * SEQ + t) * DINP;
    int lane = F.lane; asm volatile("" : "+v"(lane));
#pragma unroll
    for (int r = 0; r < 2; ++r) { const unsigned v = *(const unsigned*)(prow + C_SQ + (g * 2 + r) * HD + 2 * lane); qs[r * 128 + 2 * lane] = bflo(v) * QSCALE; qs[r * 128 + 2 * lane + 1] = bfhi(v) * QSCALE; }
    LDS_WAIT();
    float slope[2]; slope[0] = exp2f(-(float)(g * 2 + 1)); slope[1] = exp2f(-(float)(g * 2 + 2));
    AttState<2> st; att_init(st);
    const bf16_t* Kb = proj + (size_t)b * SEQ * DINP + C_SK + g * HD; const bf16_t* Vb = proj + (size_t)b * SEQ * DINP + C_SV + g * HD;
    const int lo = t - 127 > 0 ? t - 127 : 0;
    for (int jb = lo >> 6; jb <= (t >> 6); ++jb) {
        const int key = jb * 64 + lane; const bool valid = key <= t && key >= lo; float sraw[2];
        att_batch<2>(st, qs, pbuf, Kb, Vb, DINP, jb * 64, valid, (float)(t - key), slope, sraw, lane);
    }
    bf16_t* mix = (bf16_t*)(F.ws + WS_MIX) + (size_t)(b * SEQ + t) * DM + 1536;
#pragma unroll
    for (int r = 0; r < 2; ++r) { const float sink = sinks[g * 2 + r]; const float l = st.l[r] + __expf(sink - st.m[r]); const float inv = 1.f / l;
        *(unsigned*)(mix + (g * 2 + r) * HD + 2 * lane) = pk2(st.a0[r] * inv, st.a1[r] * inv); }
}

DI void nsa_token(Frame& F, int b, int t, LAS float* qs, LAS float* pbuf, LAS float* Pbuf) {
    const bf16_t* proj = (const bf16_t*)(F.ws + WS_PROJ);
    const bf16_t* prow = proj + (size_t)(b * SEQ + t) * DINP;
    int lane = F.lane; asm volatile("" : "+v"(lane));
#pragma unroll
    for (int h = 0; h < 4; ++h) { const unsigned v = *(const unsigned*)(prow + C_NQ + h * HD + 2 * lane); qs[h * 128 + 2 * lane] = bflo(v) * QSCALE; qs[h * 128 + 2 * lane + 1] = bfhi(v) * QSCALE; }
    Pbuf[lane] = 0.f; Pbuf[64 + lane] = 0.f;
    LDS_WAIT();
    float slope[4], gate[3][4];
#pragma unroll
    for (int h = 0; h < 4; ++h) slope[h] = exp2f(-(float)(5 + h));
#pragma unroll
    for (int br = 0; br < 3; ++br)
#pragma unroll
        for (int h = 0; h < 4; ++h) gate[br][h] = sigmoidf_(bf2f(prow[C_NG + br * 4 + h]));
    float o0[4], o1[4];
#pragma unroll
    for (int h = 0; h < 4; ++h) { o0[h] = 0.f; o1[h] = 0.f; }
    AttState<4> st;
    if (t >= 31) {
        const int nvalid = (t - 31) / 16 + 1;
        const bf16_t* Kb = (const bf16_t*)(F.ws + WS_KC) + (size_t)b * 128 * HD; const bf16_t* Vb = Kb + (size_t)NB * 128 * HD;
        att_init(st);
        float s0[4], s1[4];
        att_batch<4>(st, qs, pbuf, Kb, Vb, HD, 0, lane < nvalid, (float)(t - (16 * lane + 31)), slope, s0, lane);
        const bool two = nvalid > 64;
        if (two) att_batch<4>(st, qs, pbuf, Kb, Vb, HD, 64, 64 + lane < nvalid, (float)(t - (16 * (64 + lane) + 31)), slope, s1, lane);
        float p0 = 0.f, p1 = 0.f;
#pragma unroll
        for (int h = 0; h < 4; ++h) { const float inv = 1.f / st.l[h];
            if (lane < nvalid) p0 += __expf(s0[h] - st.m[h]) * inv;
            if (two && 64 + lane < nvalid) p1 += __expf(s1[h] - st.m[h]) * inv;
            o0[h] += gate[0][h] * st.a0[h] * inv; o1[h] += gate[0][h] * st.a1[h] * inv; }
        Pbuf[lane] = p0; Pbuf[64 + lane] = p1;
        LDS_WAIT();
    }
    const int cur = t >> 6;
    float score = -2.f;
    if (lane < 32) {
        const int j = lane;
        float imp = Pbuf[4 * j] + Pbuf[4 * j + 1] + Pbuf[4 * j + 2] + 0.5f * Pbuf[4 * j + 3] + (j > 0 ? 0.5f * Pbuf[4 * j - 1] : 0.f);
        const bool forced = (j == 0) || (j == cur) || (j == cur - 1);
        score = (j <= cur) ? imp + (forced ? 1000.f : 0.f) : -1.f;
    }
    unsigned selmask = 0u;
#pragma unroll 1
    for (int r = 0; r < 8; ++r) {
        const float mx = wave_max(score);
        const unsigned long long bal = __ballot(score == mx);
        const int jsel = __ffsll((long long)bal) - 1;
        if (jsel < 32 && jsel <= cur && mx >= 0.f) selmask |= 1u << jsel;
        if (lane == jsel) score = -3.f;
    }
    {
        const bf16_t* Kb = proj + (size_t)b * SEQ * DINP + C_KSL; const bf16_t* Vb = proj + (size_t)b * SEQ * DINP + C_VSL;
        att_init(st);
        unsigned mrem = selmask;
        while (mrem) { const int j = __ffs((int)mrem) - 1; mrem &= mrem - 1u; const int key = 64 * j + lane; float sraw[4];
            att_batch<4>(st, qs, pbuf, Kb, Vb, DINP, 64 * j, key <= t, (float)(t - key), slope, sraw, lane); }
#pragma unroll
        for (int h = 0; h < 4; ++h) { const float inv = 1.f / st.l[h]; o0[h] += gate[1][h] * st.a0[h] * inv; o1[h] += gate[1][h] * st.a1[h] * inv; }
    }
    {
        const bf16_t* Kb = proj + (size_t)b * SEQ * DINP + C_KW; const bf16_t* Vb = proj + (size_t)b * SEQ * DINP + C_VW;
        att_init(st);
        const int lo = t - 511 > 0 ? t - 511 : 0;
        for (int jb = lo >> 6; jb <= (t >> 6); ++jb) { const int key = jb * 64 + lane; float sraw[4];
            att_batch<4>(st, qs, pbuf, Kb, Vb, DINP, jb * 64, key <= t && key >= lo, (float)(t - key), slope, sraw, lane); }
#pragma unroll
        for (int h = 0; h < 4; ++h) { const float inv = 1.f / st.l[h]; o0[h] += gate[2][h] * st.a0[h] * inv; o1[h] += gate[2][h] * st.a1[h] * inv; }
    }
    bf16_t* mix = (bf16_t*)(F.ws + WS_MIX) + (size_t)(b * SEQ + t) * DM;
#pragma unroll
    for (int h = 0; h < 4; ++h) *(unsigned*)(mix + h * HD + 2 * lane) = pk2(o0[h], o1[h]);
}

DI void cmp_unit(Frame& F, int u, const float* posk, const float* posv, const float* w1k, const float* w1v, const float* w2k, const float* w2v) {
    const int kv = u >> 7, n = u & 127;
    int tid_ = F.tid; asm volatile("" : "+v"(tid_));
    bf16_t* outb = (bf16_t*)(F.ws + WS_KC) + (size_t)kv * NB * 128 * HD;
    if (n == 127) { for (int i = tid_; i < NB * HD; i += 512) outb[(size_t)(i >> 7) * 128 * HD + 127 * HD + (i & 127)] = 0; return; }
    const bf16_t* proj = (const bf16_t*)(F.ws + WS_PROJ);
    const float* pos = kv ? posv : posk;
    const float* w1 = kv ? w1v : w1k;
    const float* w2 = kv ? w2v : w2k;
    LAS float* xin = (LAS float*)(F.lds + LDS_SCR);
    LAS float* part = xin + 4 * 4096;
    LAS float* h1 = part + 2 * 4 * 256;
    const int col = kv ? C_VC : C_KC;
    for (int i = tid_; i < 4 * 4096; i += 512) { const int bb = i >> 12, k = i & 4095, j = k >> 7, c = k & 127;
        xin[i] = bf2f(proj[(size_t)(bb * SEQ + 16 * n + j) * DINP + col + c]) + pos[k]; }
    __syncthreads();
    const int o = tid_ & 255, kh = tid_ >> 8;
    float a0 = 0.f, a1 = 0.f, a2 = 0.f, a3 = 0.f;
    const float* wp = w1 + (size_t)(kh * 2048) * 256 + o;
    const LAS float* xp = xin + kh * 2048;
#pragma unroll 4
    for (int k = 0; k < 2048; k += 4) {
        const float w_0 = wp[(size_t)(k + 0) * 256], w_1 = wp[(size_t)(k + 1) * 256], w_2 = wp[(size_t)(k + 2) * 256], w_3 = wp[(size_t)(k + 3) * 256];
        const f32x4 x0 = *(const LAS f32x4*)(xp + k), x1 = *(const LAS f32x4*)(xp + 4096 + k), x2 = *(const LAS f32x4*)(xp + 8192 + k), x3 = *(const LAS f32x4*)(xp + 12288 + k);
        a0 += x0.x * w_0 + x0.y * w_1 + x0.z * w_2 + x0.w * w_3; a1 += x1.x * w_0 + x1.y * w_1 + x1.z * w_2 + x1.w * w_3;
        a2 += x2.x * w_0 + x2.y * w_1 + x2.z * w_2 + x2.w * w_3; a3 += x3.x * w_0 + x3.y * w_1 + x3.z * w_2 + x3.w * w_3;
    }
    part[(kh * 4 + 0) * 256 + o] = a0; part[(kh * 4 + 1) * 256 + o] = a1; part[(kh * 4 + 2) * 256 + o] = a2; part[(kh * 4 + 3) * 256 + o] = a3;
    __syncthreads();
    for (int i = tid_; i < 4 * 256; i += 512) h1[i] = siluf_(part[i] + part[4 * 256 + i]);
    __syncthreads();
    { const int bb = tid_ >> 7, c = tid_ & 127; float a = 0.f;
#pragma unroll 8
        for (int oo = 0; oo < 256; ++oo) a += h1[bb * 256 + oo] * w2[oo * HD + c];
        outb[(size_t)bb * 128 * HD + (size_t)n * HD + c] = (bf16_t)f2bf(a); }
    __syncthreads();
}

DI void gdn_chunk_unit(Frame& F, int u, const float* cw, const float* alog, const float* dtb) {
    const int n = u & 31, h = (u >> 5) & 7, b = u >> 8, bh = b * NGH + h, t0 = n * 64;
    int tid = F.tid; asm volatile("" : "+v"(tid)); const int lane = tid & 63;
    const bf16_t* proj = (const bf16_t*)(F.ws + WS_PROJ) + (size_t)b * SEQ * DINP;
    LAS float* qs = (LAS float*)(F.lds + LDS_SCR);
    LAS float* ks = qs + 64 * 132;
    LAS float* vs = ks + 64 * 132;
    LAS float* Ls = vs + 64 * 132;
    LAS float* As = Ls + 64 * 68;
    LAS float* gcs = As + 64 * 68;
    LAS float* bts = gcs + 64;
    LAS float* egs = bts + 64;
    LAS float* sc1 = egs + 64;
    for (int idx = tid; idx < 64 * 128; idx += 512) { const int i = idx >> 7, d = idx & 127; float aq = 0.f, ak = 0.f, av = 0.f;
#pragma unroll
        for (int j = 0; j < 4; ++j) { const int tt = t0 + i - 3 + j; if (tt >= 0) { const bf16_t* pr = proj + (size_t)tt * DINP;
            aq += bf2f(pr[C_GQ + h * HD + d]) * cw[j * 3072 + h * HD + d]; ak += bf2f(pr[C_GK + h * HD + d]) * cw[j * 3072 + 1024 + h * HD + d]; av += bf2f(pr[C_GV + h * HD + d]) * cw[j * 3072 + 2048 + h * HD + d]; } }
        qs[i * 132 + d] = siluf_(aq); ks[i * 132 + d] = siluf_(ak); vs[i * 132 + d] = siluf_(av); }
    if (tid < 64) {
        const bf16_t* pr = proj + (size_t)(t0 + tid) * DINP;
        const float a = bf2f(pr[C_GA + h]), bb = bf2f(pr[C_GB + h]);
        float g = -__expf(alog[h]) * softplusf_(a + dtb[h]);
        g += DPPF(g, 0x111); g += DPPF(g, 0x112); g += DPPF(g, 0x114); g += DPPF(g, 0x118);
        { const float r0 = __builtin_bit_cast(float, __builtin_amdgcn_readlane(__builtin_bit_cast(int, g), 15)), r1 = __builtin_bit_cast(float, __builtin_amdgcn_readlane(__builtin_bit_cast(int, g), 31)),
                      r2 = __builtin_bit_cast(float, __builtin_amdgcn_readlane(__builtin_bit_cast(int, g), 47));
          g += (lane >= 48) ? (r0 + r1) + r2 : (lane >= 32) ? r0 + r1 : (lane >= 16) ? r0 : 0.f; }
        const float be = sigmoidf_(bb), eg = __expf(g);
        gcs[tid] = g; bts[tid] = be; egs[tid] = eg; sc1[tid] = be * eg;
    }
    __syncthreads();
    for (int rr = 0; rr < 16; ++rr) { const int r = __builtin_amdgcn_readfirstlane(tid >> 6) * 16 + rr; LAS float* p = (r < 64) ? qs + r * 132 : ks + (r - 64) * 132;
        const float v0 = p[lane], v1 = p[lane + 64]; const float ss = wave_sum(v0 * v0 + v1 * v1); const float sc = rsqrtf(ss + EPS) * (r < 64 ? QSCALE : 1.f);
        p[lane] = v0 * sc; p[lane + 64] = v1 * sc; }
    __syncthreads();
    const float gl = gcs[63];
    for (int r = 0; r < 8; ++r) { const int idx = tid + 512 * r, i = idx >> 6, j = idx & 63; float kk = 0.f, qk = 0.f;
#pragma unroll 8
        for (int d4 = 0; d4 < 32; ++d4) { const f32x4 ki = *(const LAS f32x4*)(ks + i * 132 + 4 * d4), kj = *(const LAS f32x4*)(ks + j * 132 + 4 * d4), qi = *(const LAS f32x4*)(qs + i * 132 + 4 * d4);
            kk += (ki.x * kj.x + ki.y * kj.y) + (ki.z * kj.z + ki.w * kj.w); qk += (qi.x * kj.x + qi.y * kj.y) + (qi.z * kj.z + qi.w * kj.w); }
        const float dec = __expf(fminf(gcs[i] - gcs[j], 0.f));
        Ls[i * 68 + j] = (j < i) ? bts[i] * kk * dec : 0.f; As[i * 68 + j] = (j <= i) ? qk * dec : 0.f; }
    __syncthreads();
    float* Qd = (float*)(F.ws + WS_GQ) + ((size_t)bh * SEQ + t0) * HD; float* Kd = (float*)(F.ws + WS_GK) + ((size_t)bh * SEQ + t0) * HD;
    for (int idx = tid; idx < 64 * 128; idx += 512) { const int i = idx >> 7, d = idx & 127; Qd[idx] = qs[i * 132 + d] * egs[i]; Kd[idx] = ks[i * 132 + d] * __expf(gl - gcs[i]); }
    float* AT = (float*)(F.ws + WS_GAT) + ((size_t)bh * 32 + n) * 4096;
    for (int idx = tid; idx < 4096; idx += 512) AT[idx] = As[(idx >> 6) * 68 + (idx & 63)];
    if (tid == 0) ((float*)(F.ws + WS_GGL))[bh * 32 + n] = __expf(gl);
    __syncthreads();
    if (tid < 256) {
        int zoff; asm volatile("v_mov_b32 %0, 0" : "=v"(zoff));
        const LAS float* Lz = Ls + zoff;
        LAS float* src = (tid < 128 ? vs + tid : ks + (tid - 128)); const LAS float* scz = (tid < 128 ? bts : sc1) + zoff;
        float* dst = (float*)(F.ws + (tid < 128 ? WS_GU_ : WS_GW)) + ((size_t)bh * SEQ + t0) * HD + (tid & 127);
#pragma unroll 1
        for (int bk = 0; bk < 4; ++bk) {
            float a[16];
#pragma unroll
            for (int ii = 0; ii < 16; ++ii) a[ii] = scz[16 * bk + ii] * src[(16 * bk + ii) * 132];
#pragma unroll 1
            for (int j4 = 0; j4 < 4 * bk; ++j4) {
                const float x0 = src[(4 * j4 + 0) * 132], x1 = src[(4 * j4 + 1) * 132], x2 = src[(4 * j4 + 2) * 132], x3 = src[(4 * j4 + 3) * 132];
#pragma unroll
                for (int ii = 0; ii < 16; ++ii) { const f32x4 l = *(const LAS f32x4*)(Lz + (16 * bk + ii) * 68 + 4 * j4); a[ii] -= (l.x * x0 + l.y * x1) + (l.z * x2 + l.w * x3); }
            }
#pragma unroll
            for (int ii = 1; ii < 16; ++ii) {
#pragma unroll
                for (int jj = 0; jj < ii; ++jj) a[ii] -= Lz[(16 * bk + ii) * 68 + 16 * bk + jj] * a[jj]; }
#pragma unroll
            for (int ii = 0; ii < 16; ++ii) { src[(16 * bk + ii) * 132] = a[ii]; dst[(size_t)(16 * bk + ii) * HD] = a[ii]; }
        }
    }
    __syncthreads();
}

DI void gdn_scan_unit(Frame& F, int u) {
    const int bh = u >> 3, vs = u & 7, b = bh >> 3, h = bh & 7; int tid = F.tid; asm volatile("" : "+v"(tid));
    LAS float* Ss = (LAS float*)(F.lds + LDS_SCR);
    LAS float* wch = Ss + 128 * 16;
    LAS float* qch = wch + 64 * 132;
    LAS float* kch = qch + 64 * 132;
    LAS float* ach = kch + 64 * 132;
    LAS float* vn = ach + 64 * 68;
    LAS float* uch = vn + 64 * 16;
    const float* Ug = (const float*)(F.ws + WS_GU_) + (size_t)bh * SEQ * HD; const float* Wg = (const float*)(F.ws + WS_GW) + (size_t)bh * SEQ * HD;
    const float* Qg = (const float*)(F.ws + WS_GQ) + (size_t)bh * SEQ * HD; const float* Kg = (const float*)(F.ws + WS_GK) + (size_t)bh * SEQ * HD;
    const float* Ag = (const float*)(F.ws + WS_GAT) + (size_t)bh * 32 * 4096; const float* GL = (const float*)(F.ws + WS_GGL) + bh * 32;
    float* Og = (float*)(F.ws + WS_GO);
    const int c = tid & 15, ib = tid >> 4;
    float Sreg[4] = {0.f, 0.f, 0.f, 0.f};
    for (int i = tid; i < 128 * 16; i += 512) Ss[i] = 0.f;
    __syncthreads();
    for (int n = 0; n < 32; ++n) {
        const int t0 = n * 64;
        for (int i = tid; i < 2048; i += 512) { const int r = i >> 5, c4 = (i & 31) * 4;
            *(LAS f32x4*)(wch + r * 132 + c4) = *(const f32x4*)(Wg + (size_t)(t0 + r) * HD + c4);
            *(LAS f32x4*)(qch + r * 132 + c4) = *(const f32x4*)(Qg + (size_t)(t0 + r) * HD + c4);
            *(LAS f32x4*)(kch + r * 132 + c4) = *(const f32x4*)(Kg + (size_t)(t0 + r) * HD + c4); }
        for (int i = tid; i < 1024; i += 512) { const int r = i >> 4, c4 = (i & 15) * 4; *(LAS f32x4*)(ach + r * 68 + c4) = *(const f32x4*)(Ag + (size_t)n * 4096 + r * 64 + c4); }
        if (tid < 256) { const int r = tid >> 2, c4 = (tid & 3) * 4; *(LAS f32x4*)(uch + r * 16 + c4) = *(const f32x4*)(Ug + (size_t)(t0 + r) * HD + vs * 16 + c4); }
        __syncthreads();
        float a2[2];
#pragma unroll
        for (int rr = 0; rr < 2; ++rr) { const int i = ib + 32 * rr; float a1 = 0.f, aq = 0.f;
#pragma unroll 4
            for (int k4 = 0; k4 < 32; ++k4) { const f32x4 w4 = *(const LAS f32x4*)(wch + i * 132 + 4 * k4), q4 = *(const LAS f32x4*)(qch + i * 132 + 4 * k4);
                const float s0 = Ss[(4 * k4 + 0) * 16 + c], s1 = Ss[(4 * k4 + 1) * 16 + c], s2 = Ss[(4 * k4 + 2) * 16 + c], s3 = Ss[(4 * k4 + 3) * 16 + c];
                a1 += (w4.x * s0 + w4.y * s1) + (w4.z * s2 + w4.w * s3); aq += (q4.x * s0 + q4.y * s1) + (q4.z * s2 + q4.w * s3); }
            vn[i * 16 + c] = uch[i * 16 + c] - a1; a2[rr] = aq; }
        __syncthreads();
#pragma unroll
        for (int rr = 0; rr < 2; ++rr) { const int i = ib + 32 * rr; float o = a2[rr];
#pragma unroll 4
            for (int j4 = 0; j4 < 16; ++j4) { const f32x4 a4 = *(const LAS f32x4*)(ach + i * 68 + 4 * j4);
                o += (a4.x * vn[(4 * j4 + 0) * 16 + c] + a4.y * vn[(4 * j4 + 1) * 16 + c]) + (a4.z * vn[(4 * j4 + 2) * 16 + c] + a4.w * vn[(4 * j4 + 3) * 16 + c]); }
            Og[(size_t)(b * SEQ + t0 + i) * 1024 + h * HD + vs * 16 + c] = o; }
        const float gl = GL[n];
#pragma unroll
        for (int r = 0; r < 4; ++r) { const int k = ib + 32 * r; float s = Sreg[r] * gl;
#pragma unroll 8
            for (int j = 0; j < 64; ++j) s += kch[j * 132 + k] * vn[j * 16 + c];
            Sreg[r] = s; Ss[k * 16 + c] = s; }
        __syncthreads();
    }
}

DI void phase_gdn_out(Frame& F, const float* nw) {
    const bf16_t* proj = (const bf16_t*)(F.ws + WS_PROJ); const float* Og = (const float*)(F.ws + WS_GO); bf16_t* mix = (bf16_t*)(F.ws + WS_MIX);
    const int gw = F.bid * 8 + F.wave, NGW = F.G * 8, lane = F.lane;
    const float w0 = nw[2 * lane], w1 = nw[2 * lane + 1];
    for (int it = gw; it < NTOK * NGH; it += NGW) { const int tok = it >> 3, h = it & 7;
        const f32x2 o = *(const f32x2*)(Og + (size_t)tok * 1024 + h * HD + 2 * lane);
        const float rs = rsqrtf(wave_sum(o.x * o.x + o.y * o.y) * (1.f / HD) + EPS);
        const unsigned zz = *(const unsigned*)(proj + (size_t)tok * DINP + C_GZ + h * HD + 2 * lane);
        *(unsigned*)(mix + (size_t)tok * DM + 512 + h * HD + 2 * lane) = pk2(o.x * rs * w0 * siluf_(bflo(zz)), o.y * rs * w1 * siluf_(bfhi(zz))); }
}

DI void phase_route(Frame& F) {
    const int* topi = (const int*)(F.ws + WS_RT + RT_TOPI); const float* topg = (const float*)(F.ws + WS_RT + RT_TOPG);
    int* pos = (int*)(F.ws + WS_RT + RT_POS); float* rgate = (float*)(F.ws + WS_RT + RT_RGATE); int* texp = (int*)(F.ws + WS_RT + RT_TEXP); int* ntl = (int*)(F.ws + WS_RT + RT_NTILES);
    const bf16_t* hb = (const bf16_t*)(F.ws + WS_HB); bf16_t* hperm = (bf16_t*)(F.ws + WS_HPERM);
    LAS int* tot = (LAS int*)(F.lds + LDS_SCR);
    LAS int* bef = tot + 8;
    LAS int* pst = bef + 8;
    LAS int* dests = pst + 16;
    const int tid = F.tid, lane = F.lane;
    for (int blk = F.bid; blk < NTOK / 32; blk += F.G) {
        if (tid < 16) tot[tid] = 0;
        __syncthreads();
        int ct[NEXP], cb[NEXP];
#pragma unroll
        for (int e = 0; e < NEXP; ++e) { ct[e] = 0; cb[e] = 0; }
        for (int a = tid; a < 2 * NTOK; a += 512) { const int e = topi[a]; const bool before = a < 64 * blk;
#pragma unroll
            for (int q = 0; q < NEXP; ++q) { ct[q] += (e == q); cb[q] += (e == q && before); } }
#pragma unroll
        for (int e = 0; e < NEXP; ++e) { const int v = wave_sum_i(ct[e]), w = wave_sum_i(cb[e]);
            if (lane == 0) { atomicAdd((int*)(tot + e), v); atomicAdd((int*)(bef + e), w); } }
        __syncthreads();
        if (tid == 0) { int s = 0; for (int e = 0; e < NEXP; ++e) { pst[e] = s; s += (tot[e] + 255) / 256 * 256; } pst[NEXP] = s; }
        __syncthreads();
        if (tid < 64) { const int a = 64 * blk + tid, e = topi[a]; int rank = 0;
#pragma unroll
            for (int q = 0; q < NEXP; ++q) { const unsigned long long m = __ballot(e == q); if (e == q) rank = __popcll(m & ((1ull << lane) - 1ull)); }
            const int d = pst[e] + bef[e] + rank; dests[tid] = d; pos[a] = d; rgate[d] = topg[a]; }
        __syncthreads();
        for (int al = F.wave; al < 64; al += 8) { const int d = dests[al], tok = 32 * blk + (al >> 1);
            const u32x4* s = (const u32x4*)(hb + (size_t)tok * DM) + lane; u32x4* dd = (u32x4*)(hperm + (size_t)d * DM) + lane;
#pragma unroll
            for (int j = 0; j < 4; ++j) dd[64 * j] = s[64 * j]; }
        for (int e = 0; e < NEXP; ++e) { const int lo = pst[e] + tot[e], hi = pst[e + 1];
            for (int r = lo + blk; r < hi; r += NTOK / 32) { ((u32x2*)(hperm + (size_t)r * DM))[tid] = (u32x2){0u, 0u}; if (tid == 0) rgate[r] = 0.f; } }
        if (blk == 0) { const int nt = pst[NEXP] / 256; if (tid == 0) *ntl = nt;
            if (tid < nt) { int e = 0;
#pragma unroll
                for (int q = 1; q < NEXP; ++q) if (256 * tid >= pst[q]) e = q;
                texp[tid] = e; } }
        __syncthreads();
    }
}

DI void phase_final(Frame& F, const float* w) {
    const float* x = (const float*)(F.ws + WS_X); const float* y = (const float*)(F.ws + WS_Y); const int* pos = (const int*)(F.ws + WS_RT + RT_POS);
    const int gw = F.bid * 8 + F.wave, NGW = F.G * 8;
    for (int m = gw; m < NTOK; m += NGW) {
        const int p0 = pos[2 * m], p1 = pos[2 * m + 1];
        const f32x4* xr = (const f32x4*)(x + (size_t)m * DM) + F.lane; const f32x4* y0 = (const f32x4*)(y + (size_t)p0 * DM) + F.lane; const f32x4* y1 = (const f32x4*)(y + (size_t)p1 * DM) + F.lane;
        f32x4 v[8]; float s = 0.f;
#pragma unroll
        for (int j = 0; j < 8; ++j) { v[j] = xr[64 * j] + y0[64 * j] + y1[64 * j]; s += (v[j].x * v[j].x + v[j].y * v[j].y) + (v[j].z * v[j].z + v[j].w * v[j].w); }
        const float rs = rsqrtf(wave_sum(s) * (1.f / DM) + EPS);
        f32x4* o = (f32x4*)(F.out + (size_t)m * DM) + F.lane;
#pragma unroll
        for (int j = 0; j < 8; ++j) o[64 * j] = v[j] * rs * ((const f32x4*)w)[F.lane + 64 * j];
    }
}

constexpr int PH_PER_LAYER = 11, N_PHASES = 1 + 2 * PH_PER_LAYER + 1;
#ifndef PHMASK
#define PHMASK 0xFFFF
#endif
#define EN(k) (((PHMASK) >> (k)) & 1)
#define IN(k) (lo <= (k) && (k) < hi && (F.refresh(), true))
#define MARK(name) asm volatile("; MARK " name ::: "memory")
#define SEAM(k) do { if (IN((k) + 1)) xcd_barrier(bar); } while (0)
template <int layer> DI void run_layer(Frame& F, const Args& args, const int lo, const int hi, const XcdBarrier& bar) {
    LAS unsigned char* scr = F.lds + LDS_SCR;
    bf16_t* HB = (bf16_t*)(F.ws + WS_HB); bf16_t* PROJ = (bf16_t*)(F.ws + WS_PROJ); bf16_t* MIX = (bf16_t*)(F.ws + WS_MIX); float* XB = (float*)(F.ws + WS_X);
    bf16_t* ACT = (bf16_t*)(F.ws + WS_ACT); bf16_t* HPERM = (bf16_t*)(F.ws + WS_HPERM); float* YB = (float*)(F.ws + WS_Y);
        const int pb = 1 + layer * PH_PER_LAYER;
        const float* xin = layer == 0 ? args.in[I_X] : XB;
        if (EN(1) && IN(pb + 0)) { phase_norm<false>(F, xin, args.in[I_ATTN_NORM] + layer * DM, HB, nullptr); SEAM(pb + 0); }
        if (EN(2) && IN(pb + 1)) { pg8::StaticOrder S; S.init(HB, DM, (const bf16_t*)(F.ws + WS_WIN + layer * SZ_WIN), NTOK, DINP, DM, F.G, F.bid);
            pg8::EpiBf16 E{PROJ, DINP}; pg8::gemm_phase(scr, DM, DM, S, E); SEAM(pb + 1); }
        if (EN(3) && IN(pb + 2)) {
            for (int u = F.bid; u < 256 + 1024 + 1024; u += F.G) {
#ifndef SUBMASK
#define SUBMASK 7
#endif
                if (u < 256) { if (SUBMASK & 1) cmp_unit(F, u, args.in[I_POS_K] + layer * 32 * HD, args.in[I_POS_V] + layer * 32 * HD, args.in[I_W1K] + (size_t)layer * 4096 * 256, args.in[I_W1V] + (size_t)layer * 4096 * 256, args.in[I_W2K] + layer * 256 * HD, args.in[I_W2V] + layer * 256 * HD); }
                else if (u < 1280) { if (SUBMASK & 2) gdn_chunk_unit(F, u - 256, args.in[I_CONV] + layer * 4 * 3072, args.in[I_ALOG] + layer * NGH, args.in[I_DTB] + layer * NGH); }
                else if (SUBMASK & 4) { const int q = u - 1280; LAS float* qs = (LAS float*)scr + F.wave * 512; LAS float* pbuf = (LAS float*)scr + 8 * 512 + F.wave * 128;
                    for (int r = 0; r < 2; ++r) { const int item = q * 16 + r * 8 + F.wave; const int g = item & 1, tau = item >> 1; swa_item(F, args.in[I_SINKS] + layer * 4, tau & 3, tau >> 2, g, qs, pbuf); } }
            }
            SEAM(pb + 2); }
        if (EN(4) && IN(pb + 3)) {
            for (int u = F.bid; u < 256 + 1024; u += F.G) {
                if (u < 256) gdn_scan_unit(F, u);
                else { const int tau = (u - 256) * 8 + F.wave; LAS float* qs = (LAS float*)scr + F.wave * 1024; LAS float* pbuf = qs + 512; LAS float* Pb = qs + 768;
                    nsa_token(F, tau & 3, tau >> 2, qs, pbuf, Pb); }
            }
            SEAM(pb + 3); }
        if (EN(5) && IN(pb + 4)) { phase_gdn_out(F, args.in[I_GNORM] + layer * HD); SEAM(pb + 4); }
        if (EN(6) && IN(pb + 5)) { pg8::StaticOrder S; S.init(MIX, DM, (const bf16_t*)(F.ws + WS_WOUT + layer * SZ_WOUT), NTOK, DM, DM, F.G, F.bid);
            pg8::EpiResid E{xin, XB, DM}; pg8::gemm_phase(scr, DM, DM, S, E); SEAM(pb + 5); }
        if (layer == 0) {
            if (EN(7) && IN(pb + 6)) { phase_norm<false>(F, XB, args.in[I_FFN_NORM], HB, nullptr); SEAM(pb + 6); }
            if (IN(pb + 7)) { SEAM(pb + 7); }
            if (EN(9) && IN(pb + 8)) { pg8::StaticOrder S; S.init(HB, DM, (const bf16_t*)(F.ws + WS_DGU), NTOK, GU, DM, F.G, F.bid);
                pg8::EpiSwiGLU E{ACT, DFF}; pg8::gemm_phase(scr, DM, DM, S, E); SEAM(pb + 8); }
            if (EN(10) && IN(pb + 9)) { pg8::StaticOrder S; S.init(ACT, DFF, (const bf16_t*)(F.ws + WS_DDN), NTOK, DM, DFF, F.G, F.bid);
                pg8::EpiResid E{XB, XB, DM}; pg8::gemm_phase(scr, DFF, DFF, S, E); SEAM(pb + 9); }
            if (IN(pb + 10)) { SEAM(pb + 10); }
        } else {
            if (EN(7) && IN(pb + 6)) { phase_norm<true>(F, XB, args.in[I_FFN_NORM] + DM, HB, args.in[I_ROUTER]); SEAM(pb + 6); }
            if (EN(8) && IN(pb + 7)) { phase_route(F); SEAM(pb + 7); }
            const int* texp = (const int*)(F.ws + WS_RT + RT_TEXP);
            if (EN(9) && IN(pb + 8)) { const int ntiles = __builtin_amdgcn_readfirstlane(*(const int*)(F.ws + WS_RT + RT_NTILES));
                pg8::MoeOrder S; S.init(HPERM, DM, (const bf16_t*)(F.ws + WS_MGU), SZ_WGU, texp, ntiles, GU, DM, F.G, F.bid);
                pg8::EpiSwiGLU E{ACT, DFF}; pg8::gemm_phase(scr, DM, DM, S, E); SEAM(pb + 8); }
            if (EN(10) && IN(pb + 9)) { const int ntiles = __builtin_amdgcn_readfirstlane(*(const int*)(F.ws + WS_RT + RT_NTILES));
                pg8::MoeOrder S; S.init(ACT, DFF, (const bf16_t*)(F.ws + WS_MDN), SZ_WDN, texp, ntiles, DM, DFF, F.G, F.bid);
                pg8::EpiRowScale E{(const float*)(F.ws + WS_RT + RT_RGATE), YB, DM}; pg8::gemm_phase(scr, DFF, DFF, S, E); SEAM(pb + 9); }
            if (IN(pb + 10)) { SEAM(pb + 10); }
        }
    }
__global__ void __launch_bounds__(512, 2) trunk_fwd(Args args) {
    extern __shared__ __attribute__((aligned(16))) unsigned char lds_raw[];
    Frame F;
    F.lds = (LAS unsigned char*)lds_raw;
    F.tid = threadIdx.x; F.lane = F.tid & 63; F.wave = __builtin_amdgcn_readfirstlane(F.tid >> 6); F.G = gridDim.x; F.bid = blockIdx.x;
    F.out = args.out; F.ws = args.ws;
    volatile LAS unsigned* MISC = (volatile LAS unsigned*)(F.lds + LDS_MISC);
    if (F.tid < 64) MISC[F.tid] = 0u;
    __syncthreads();
    unsigned* ctl = (unsigned*)(F.ws + WS_CTL);
    XcdBarrier bar; bar.bar = ctl + CW_BAR; bar.x = 0; bar.st = nullptr;
    const int lo = args.ph_lo, hi = args.ph_hi;
    if (hi - lo > 1) bar = xcd_barrier_post(ctl + CW_BAR, MISC + 8);
    LAS unsigned char* scr = F.lds + LDS_SCR;
    bf16_t* HB = (bf16_t*)(F.ws + WS_HB); bf16_t* PROJ = (bf16_t*)(F.ws + WS_PROJ); bf16_t* MIX = (bf16_t*)(F.ws + WS_MIX); float* XB = (float*)(F.ws + WS_X);
    bf16_t* ACT = (bf16_t*)(F.ws + WS_ACT); bf16_t* HPERM = (bf16_t*)(F.ws + WS_HPERM); float* YB = (float*)(F.ws + WS_Y);

    if (EN(0) && IN(0)) { phase_convert(F, args.in[I_W_IN], args.in[I_W_OUT], args.in[I_DGATE], args.in[I_DUP], args.in[I_DDOWN], args.in[I_MGATE], args.in[I_MUP], args.in[I_MDOWN]); SEAM(0); }
    run_layer<0>(F, args, lo, hi, bar);
    run_layer<1>(F, args, lo, hi, bar);
    if (EN(11) && IN(N_PHASES - 1)) phase_final(F, args.in[I_FINAL]);
}

extern "C" void kernel_launch(void* const* d_in, const int* in_sizes, int n_in, void* d_out, int out_size, void* d_ws, size_t ws_size, hipStream_t stream) {
    static int grid = 0;
    if (grid == 0) {
        if (n_in != 24 || in_sizes[0] != NTOK * DM || out_size != NTOK * DM || ws_size < WS_END) {
            fprintf(stderr, "kernel_launch: unexpected shapes (n_in %d, in0 %d, out %d, ws %zu < %zu)\n", n_in, n_in > 0 ? in_sizes[0] : -1, out_size, ws_size, (size_t)WS_END); grid = -1; return; }
        int dev = 0, cus = 0, per_cu = 0;
        if (hipGetDevice(&dev) != hipSuccess || hipDeviceGetAttribute(&cus, hipDeviceAttributeMultiprocessorCount, dev) != hipSuccess) { grid = -1; return; }
        if (hipFuncSetAttribute((const void*)trunk_fwd, hipFuncAttributeMaxDynamicSharedMemorySize, LDS_BYTES) != hipSuccess) { fprintf(stderr, "kernel_launch: hipFuncSetAttribute failed\n"); grid = -1; return; }
        if (hipOccupancyMaxActiveBlocksPerMultiprocessor(&per_cu, (const void*)trunk_fwd, 512, LDS_BYTES) != hipSuccess || per_cu < 1) { fprintf(stderr, "kernel_launch: occupancy query says %d\n", per_cu); }
        (void)hipGetLastError();
        grid = cus;
    }
    if (grid < 0) return;
    (void)hipMemsetAsync((char*)d_ws + WS_CTL, 0, CTL_BYTES, stream);
    Args a{};
    for (int i = 0; i < 24; ++i) a.in[i] = (const float*)d_in[i];
    a.out = (float*)d_out; a.ws = (unsigned char*)d_ws;
#if MK_PER_PHASE
    for (int p = 0; p < N_PHASES; ++p) { a.ph_lo = p; a.ph_hi = p + 1; hipLaunchKernelGGL(trunk_fwd, dim3(grid), dim3(512), LDS_BYTES, stream, a); }
#else
    a.ph_lo = 0; a.ph_hi = N_PHASES;
    hipLaunchKernelGGL(trunk_fwd, dim3(grid), dim3(512), LDS_BYTES, stream, a);
#endif
}
```

```cpp
#include <hip/hip_runtime.h>
#include <cstdio>
#include <cstdint>

#ifndef MK_PER_PHASE
#define MK_PER_PHASE 0
#endif

#define DI __device__ __forceinline__
#define LAS __attribute__((address_space(3)))
DI void dma16s(const void* sbase  , unsigned voff, LAS void* l) { const unsigned la = (unsigned)(size_t)l; asm volatile("s_mov_b32 m0, %2\n\ts_nop 0\n\tglobal_load_lds_dwordx4 %0, %1" :: "v"(voff), "s"(sbase), "s"(la) : "memory", "m0"); }
DI void dma16(const void* g, LAS void* l) { const unsigned la = (unsigned)(size_t)l; asm volatile("s_mov_b32 m0, %1\n\ts_nop 0\n\tglobal_load_lds_dwordx4 %0, off" :: "v"(g), "s"(la) : "memory"); }
typedef int i32x4 __attribute__((ext_vector_type(4)));
typedef unsigned short bf16_t;
typedef short bf16x8 __attribute__((ext_vector_type(8)));
typedef float f32x4 __attribute__((ext_vector_type(4)));
typedef float f32x2 __attribute__((ext_vector_type(2)));
typedef unsigned u32x4 __attribute__((ext_vector_type(4)));
typedef unsigned u32x2 __attribute__((ext_vector_type(2)));

constexpr int NB = 4, SEQ = 2048, DM = 2048, NTOK = NB * SEQ, HD = 128;
constexpr int DIN = 6428, DINP = 6656;
constexpr int DFF = 7168, NEXP = 8, GU = 2 * DFF;
constexpr int NGH = 8;
constexpr int PMAX = 2 * NTOK + NEXP * 256;
constexpr int C_NQ = 0, C_KC = 512, C_VC = 640, C_KSL = 768, C_VSL = 896, C_KW = 1024, C_VW = 1152, C_GQ = 1280, C_GK = 2304, C_GV = 3328, C_GZ = 4352,
              C_SQ = 5376, C_SK = 5888, C_SV = 6144, C_NG = 6400, C_GA = 6412, C_GB = 6420;
constexpr float EPS = 1e-6f;
constexpr float QSCALE = 0.08838834764831845f;

constexpr size_t MiB = 1u << 20;
constexpr size_t WS_CTL = 0, CTL_BYTES = 1 * MiB;
constexpr size_t SZ_WIN = (size_t)DINP * DM * 2, SZ_WOUT = (size_t)DM * DM * 2, SZ_WGU = (size_t)GU * DM * 2, SZ_WDN = (size_t)DM * DFF * 2;
constexpr size_t WS_WIN = 2 * MiB;
constexpr size_t WS_WOUT = WS_WIN + 2 * SZ_WIN;
constexpr size_t WS_DGU = WS_WOUT + 2 * SZ_WOUT;
constexpr size_t WS_DDN = WS_DGU + SZ_WGU;
constexpr size_t WS_MGU = WS_DDN + SZ_WDN;
constexpr size_t WS_MDN = WS_MGU + NEXP * SZ_WGU;
constexpr size_t WS_HB = WS_MDN + NEXP * SZ_WDN;
constexpr size_t WS_MIX = WS_HB + (size_t)NTOK * DM * 2;
constexpr size_t WS_X = WS_MIX + (size_t)NTOK * DM * 2;
constexpr size_t WS_HPERM = WS_X + (size_t)NTOK * DM * 4;
constexpr size_t WS_Y = WS_HPERM + (size_t)PMAX * DM * 2;
constexpr size_t WS_RT = WS_Y + (size_t)PMAX * DM * 4;
constexpr size_t WS_KC = WS_RT + 1 * MiB;
constexpr size_t WS_CW1 = WS_KC + 1 * MiB;
constexpr size_t WS_CW2 = WS_CW1 + 8 * MiB;
constexpr size_t WS_OVL = WS_CW2 + 1 * MiB;
constexpr size_t WS_ACT = WS_OVL;
constexpr size_t WS_PROJ = WS_OVL;
constexpr size_t SZ_G = (size_t)NB * NGH * SEQ * HD * 4;
constexpr size_t WS_GU_ = WS_PROJ + (size_t)NTOK * DINP * 2;
constexpr size_t WS_GW = WS_GU_ + SZ_G, WS_GQ = WS_GW + SZ_G, WS_GK = WS_GQ + SZ_G;
constexpr size_t WS_GAT = WS_GK + SZ_G;
constexpr size_t WS_GO = WS_GAT + 16 * MiB;
constexpr size_t WS_GGL = WS_GO + 32 * MiB;
constexpr size_t WS_NSAO = WS_GGL + 1 * MiB;
constexpr size_t OVL_A = (size_t)PMAX * DFF * 2, OVL_B = (WS_NSAO + 16 * MiB) - WS_OVL;
constexpr size_t WS_END = WS_OVL + (OVL_A > OVL_B ? OVL_A : OVL_B);
constexpr size_t RT_RSQ = 524288;
constexpr size_t RT_TOPI = 0, RT_TOPG = 65536, RT_POS = 131072, RT_RGATE = 196608, RT_TEXP = 294912, RT_NTILES = 295936, RT_TAIL = 296960;

constexpr int CW_BAR = 4096;
constexpr int KSPLIT_MAX = 14;
constexpr size_t WS_SLAB = WS_MGU + (size_t)NEXP * GU * DM;
constexpr int MAX_TAIL = 64;
constexpr int CW_QHEAD = 2048;

constexpr int LDS_SCR = 0, LDS_SCR_BYTES = 153600;
constexpr int LDS_MISC = LDS_SCR_BYTES;
constexpr int LDS_BYTES = LDS_SCR_BYTES + 256;

DI float bf2f(unsigned v) { return __uint_as_float(v << 16); }
DI float bflo(unsigned v) { return __uint_as_float(v << 16); }
DI float bfhi(unsigned v) { return __uint_as_float(v & 0xffff0000u); }
DI unsigned f2bf(float f) { unsigned u = __float_as_uint(f); return (u + 0x7fffu + ((u >> 16) & 1u)) >> 16; }
DI unsigned pk2(float lo, float hi) { return f2bf(lo) | (f2bf(hi) << 16); }
typedef __bf16 bf16v2_t __attribute__((ext_vector_type(2)));
DI unsigned cvt_pk_bf16(float lo, float hi) { const f32x2 v = {lo, hi}; return __builtin_bit_cast(unsigned, __builtin_convertvector(v, bf16v2_t)); }
#define DPPF(x, ctrl) __builtin_bit_cast(float, __builtin_amdgcn_update_dpp(0, __builtin_bit_cast(int, (x)), (ctrl), 0xf, 0xf, true))
DI float wave_sum(float v) {
    v += DPPF(v, 0xB1);
    v += DPPF(v, 0x4E);
    v += DPPF(v, 0x141);
    v += DPPF(v, 0x140);
    v += __builtin_bit_cast(float, __builtin_amdgcn_ds_swizzle(__builtin_bit_cast(int, v), 0x401F));
    return __builtin_bit_cast(float, __builtin_amdgcn_readlane(__builtin_bit_cast(int, v), 0)) + __builtin_bit_cast(float, __builtin_amdgcn_readlane(__builtin_bit_cast(int, v), 32));
}
DI float wave_max(float v) {
    v = fmaxf(v, DPPF(v, 0xB1));
    v = fmaxf(v, DPPF(v, 0x4E));
    v = fmaxf(v, DPPF(v, 0x141));
    v = fmaxf(v, DPPF(v, 0x140));
    v = fmaxf(v, __builtin_bit_cast(float, __builtin_amdgcn_ds_swizzle(__builtin_bit_cast(int, v), 0x401F)));
    return fmaxf(__builtin_bit_cast(float, __builtin_amdgcn_readlane(__builtin_bit_cast(int, v), 0)), __builtin_bit_cast(float, __builtin_amdgcn_readlane(__builtin_bit_cast(int, v), 32)));
}
DI int wave_sum_i(int v) {
    v += __builtin_amdgcn_update_dpp(0, v, 0xB1, 0xf, 0xf, true);
    v += __builtin_amdgcn_update_dpp(0, v, 0x4E, 0xf, 0xf, true);
    v += __builtin_amdgcn_update_dpp(0, v, 0x141, 0xf, 0xf, true);
    v += __builtin_amdgcn_update_dpp(0, v, 0x140, 0xf, 0xf, true);
    v += __builtin_amdgcn_ds_swizzle(v, 0x401F);
    return __builtin_amdgcn_readlane(v, 0) + __builtin_amdgcn_readlane(v, 32);
}
DI float sigmoidf_(float x) { return 1.f / (1.f + __expf(-x)); }
DI float siluf_(float x) { return x / (1.f + __expf(-x)); }
DI float softplusf_(float x) { return x > 20.f ? x : log1pf(__expf(x)); }
#define LDS_WAIT() asm volatile("s_waitcnt lgkmcnt(0)" ::: "memory")

#define XB_TMO      128
#define XB_XCNT(j)  (256  + 64 * (j))
#define XB_XSUB(j)  (1280 + 64 * (j))
#define XB_XGEN(j)  (2304 + 64 * (j))
#define XB_TOP      3328
#define XB_TOPGEN   3392
#define XCD_BAR_WORDS 3456
#define XB_SPIN_CAP (1u << 22)
DI unsigned xb_ld(unsigned* p)              { return __hip_atomic_load(p, __ATOMIC_RELAXED, __HIP_MEMORY_SCOPE_AGENT); }
DI unsigned xb_add(unsigned* p, unsigned v) { return __hip_atomic_fetch_add(p, v, __ATOMIC_RELAXED, __HIP_MEMORY_SCOPE_AGENT); }
DI unsigned xb_xcc_id() { return (unsigned)__builtin_amdgcn_s_getreg((3 << 11) | 20) & 0xFu; }
#define XB_SPIN(cond, bar) do { unsigned _sp = 0; while (cond) { __builtin_amdgcn_s_sleep(1); \
    if ((++_sp & 255u) == 0u) { if (xb_ld(&(bar)[XB_TMO])) break; if (_sp > XB_SPIN_CAP) { atomicAdd(&(bar)[XB_TMO], 1u); break; } } } } while (0)
struct XcdBarrier { unsigned* bar; unsigned x; volatile LAS unsigned* st; };
DI XcdBarrier xcd_barrier_post(unsigned* bar, volatile LAS unsigned* st) {
    XcdBarrier b; b.bar = bar; b.x = xb_xcc_id(); b.st = st;
    if (threadIdx.x == 0) (void)xb_add(&bar[XB_XCNT(b.x)], 1u);
    return b;
}
DI void xcd_barrier_complete(unsigned* bar, unsigned x, unsigned& nloc, unsigned& nx) {
    const unsigned G = gridDim.x * gridDim.y * gridDim.z;
    unsigned sum, cnt, mine, sp = 0u;
    for (;;) {
        sum = 0u; cnt = 0u; mine = 0u;
#pragma unroll
        for (unsigned j = 0; j < 16; ++j) { const unsigned c = xb_ld(&bar[XB_XCNT(j)]); sum += c; cnt += (c > 0u) ? 1u : 0u; mine = (j == x) ? c : mine; }
        if (sum == G) break;
        __builtin_amdgcn_s_sleep(1);
        if ((++sp & 255u) == 0u) { if (xb_ld(&bar[XB_TMO])) break; if (sp > XB_SPIN_CAP) { atomicAdd(&bar[XB_TMO], 1u); break; } }
    }
    nloc = mine > 0u ? mine : 1u; nx = cnt > 0u ? cnt : 1u;
}
DI void xcd_barrier(const XcdBarrier& b, const bool leader  ) {
    asm volatile("s_waitcnt vmcnt(0)" ::: "memory");
    __syncthreads();
    if (leader) {
        unsigned* bar = b.bar;
        __builtin_amdgcn_s_waitcnt(0);
        unsigned nloc = b.st[0], nx = b.st[1];
        if (nloc == 0u) { xcd_barrier_complete(bar, b.x, nloc, nx); b.st[0] = nloc; b.st[1] = nx; }
        const unsigned old = xb_add(&bar[XB_XSUB(b.x)], 1u);
        const unsigned gen = old / nloc;
        if (old + 1u == (gen + 1u) * nloc) {
            __builtin_amdgcn_fence(__ATOMIC_RELEASE, "agent");
            asm volatile("s_waitcnt vmcnt(0)" ::: "memory");
            const unsigned og = xb_add(&bar[XB_TOP], 1u);
            const unsigned tg = og / nx;
            if (og + 1u == (tg + 1u) * nx) xb_add(&bar[XB_TOPGEN], 1u);
            else XB_SPIN(xb_ld(&bar[XB_TOPGEN]) == tg, bar);
            __builtin_amdgcn_fence(__ATOMIC_ACQUIRE, "agent");
            xb_add(&bar[XB_XGEN(b.x)], 1u);
            asm volatile("s_waitcnt vmcnt(0)" ::: "memory");
        } else {
            XB_SPIN(xb_ld(&bar[XB_XGEN(b.x)]) == gen, bar);
            __builtin_amdgcn_fence(__ATOMIC_ACQUIRE, "agent");
            asm volatile("s_waitcnt vmcnt(0)" ::: "memory");
        }
    }
    __syncthreads();
}

namespace pg8 {
constexpr int BM = 256, BK = 64, HALF = 128, HTB = HALF * BK * 2, STAGE_BYTES = 8 * HTB, NXCD = 8, WGM = 8;
__host__ __device__ __forceinline__ int lds_byte(int r, int c) { const int st = (r >> 4) * 2 + (c >> 5), rr = r & 15, cc = c & 31, ob = rr * 64 + cc * 2; return st * 1024 + (ob ^ (((ob >> 9) & 1) << 5)); }
__host__ __device__ __forceinline__ void stage_rc(int b, int& R, int& C) { const int st = b / 1024, sb = b % 1024, swz = sb ^ (((sb >> 9) & 1) << 5); R = (st >> 1) * 16 + swz / 64; C = (st & 1) * 32 + (swz % 64) / 2; }
__host__ __device__ __forceinline__ int perm32(int rho) { const int n = rho >> 4, i = rho & 15; return 8 * (i >> 2) + 4 * n + (i & 3); }
struct Unit { int pm, pn, aux; };
DI bool order_next(int i, int G, int c, int nM, int nN, Unit& u) {
    const int nwg = nM * nN; const long L = (long)i * G + c; if (L >= nwg) return false;
    int wgid = (int)L; { const int q = nwg / NXCD, r = nwg % NXCD, xcd = wgid % NXCD, off = wgid / NXCD; wgid = (xcd < r ? xcd * (q + 1) : r * (q + 1) + (xcd - r) * q) + off; }
    const int nig = WGM * nN, gid = wgid / nig, fm = gid * WGM, gsz = (nM - fm) < WGM ? (nM - fm) : WGM;
    u.pm = fm + ((wgid % nig) % gsz); u.pn = (wgid % nig) / gsz; u.aux = 0; return true;
}
struct StaticOrder {
    const char* A; const char* Bt; int nM, nN, G, c; size_t a_tstep, b_tstep;
    DI void init(const void* A_, int ldaB, const void* Bt_, int ldbB, int M, int N, int G_, int c_) { A = (const char*)A_; Bt = (const char*)Bt_; nM = M / BM; nN = N / BM; G = G_; c = c_; a_tstep = (size_t)BM * ldaB; b_tstep = (size_t)BM * ldbB; }
    DI bool next(int i, Unit& u) const { return order_next(i, G, c, nM, nN, u); }
    DI const char* abase(const Unit& u) const { return A + (size_t)u.pm * a_tstep; }
    DI const char* bbase(const Unit& u) const { return Bt + (size_t)u.pn * b_tstep; }
};
struct MoeOrder {
    const char* A; const char* W; const int* texp; int nM, nN, G, c; size_t a_tstep, b_tstep, estride;
    DI void init(const void* A_, int ldaB, const void* W_, int ldbB, size_t estride_bytes, const int* texp_, int ntiles, int N, int G_, int c_) {
        A = (const char*)A_; W = (const char*)W_; texp = texp_; nM = ntiles; nN = N / BM; G = G_; c = c_; a_tstep = (size_t)BM * ldaB; b_tstep = (size_t)BM * ldbB; estride = estride_bytes; }
    int nrounds = 1 << 30;
    DI bool next(int i, Unit& u) const { return i < nrounds && order_next(i, G, c, nM, nN, u); }
    DI const char* abase(const Unit& u) const { return A + (size_t)u.pm * a_tstep; }
    DI const char* bbase(const Unit& u) const { const int e = __builtin_amdgcn_readfirstlane(texp[u.pm]); return W + (size_t)e * estride + (size_t)u.pn * b_tstep; }
};
struct MoeTailOrder {
    MoeOrder M; int L0, R, kbytes, ks;
    DI bool next(int i, Unit& u) const { const int j = i * M.G + M.c; if (j >= R * ks) return false; const int t = j / ks;
        order_next(0, 1 << 30, L0 + t, M.nM, M.nN, u); u.aux = j; return true; }
    DI const char* abase(const Unit& u) const { return M.abase(u) + (size_t)(u.aux % ks) * kbytes; }
    DI const char* bbase(const Unit& u) const { return M.bbase(u) + (size_t)(u.aux % ks) * kbytes; }
};
struct EpiSlab {
    static constexpr bool PERM = false;
    float* slab; int* tailidx; int ks;
    DI void operator()(const f32x4 (&acc)[2][2][4][2], const Unit& u, int wr, int wc, int fr, int fq) const {
        float* base = slab + (size_t)u.aux * 65536; const int row0 = wr * 64 + fr, col0 = wc * 32 + 4 * fq;
        if ((u.aux % ks) == 0 && wr == 0 && wc == 0 && fr == 0 && fq == 0) tailidx[u.pm * 8 + u.pn] = u.aux / ks;
#pragma unroll
        for (int ai = 0; ai < 2; ++ai)
#pragma unroll
            for (int m = 0; m < 4; ++m) { float* rp = base + (size_t)(row0 + ai * HALF + m * 16) * 256 + col0;
#pragma unroll
                for (int bj = 0; bj < 2; ++bj)
#pragma unroll
                    for (int n = 0; n < 2; ++n) *(f32x4*)(rp + bj * HALF + n * 16) = acc[ai][bj][m][n];
                asm volatile("" ::: "memory"); }
    }
};
DI float row_rs(const float* rsq, int row) { float s = 0.f;
#pragma unroll
    for (int p = 0; p < 8; ++p) s += rsq[(size_t)p * NTOK + row];
    return rsqrtf(s * (1.f / DM) + EPS); }
struct EpiBf16 {
    static constexpr bool PERM = true;
    bf16_t* O; int ldc; const float* rsq;
    DI void operator()(const f32x4 (&acc)[2][2][4][2], const Unit& u, int wr, int wc, int fr, int fq) const {
        const int row0 = u.pm * BM + wr * 64 + fr, col0 = u.pn * BM + wc * 32 + 8 * fq;
        float rsv[2][4];
#pragma unroll
        for (int ai = 0; ai < 2; ++ai)
#pragma unroll
            for (int m = 0; m < 4; ++m) rsv[ai][m] = rsq ? row_rs(rsq, row0 + ai * HALF + m * 16) : 1.f;
#pragma unroll
        for (int ai = 0; ai < 2; ++ai)
#pragma unroll
            for (int m = 0; m < 4; ++m) { bf16_t* rowp = O + (size_t)(row0 + ai * HALF + m * 16) * ldc + col0;
#pragma unroll
                for (int bj = 0; bj < 2; ++bj) { const f32x4 v0 = acc[ai][bj][m][0] * rsv[ai][m], v1 = acc[ai][bj][m][1] * rsv[ai][m];
                    u32x4 w; w.x = cvt_pk_bf16(v0[0], v0[1]); w.y = cvt_pk_bf16(v0[2], v0[3]); w.z = cvt_pk_bf16(v1[0], v1[1]); w.w = cvt_pk_bf16(v1[2], v1[3]);
                    *(u32x4*)(rowp + bj * HALF) = w; } }
    }
};
template <bool F8> struct EpiSwiGLUT {
    static constexpr bool PERM = true;
    bf16_t* O; int ldc; const float* rsq;
    DI void operator()(const f32x4 (&acc)[2][2][4][2], const Unit& u, int wr, int wc, int fr, int fq) const {
        const int row0 = u.pm * BM + wr * 64 + fr, col0 = u.pn * HALF + wc * 32 + 8 * fq;
        float rsv[2][4];
#pragma unroll
        for (int ai = 0; ai < 2; ++ai)
#pragma unroll
            for (int m = 0; m < 4; ++m) rsv[ai][m] = (rsq ? row_rs(rsq, row0 + ai * HALF + m * 16) : 1.f) * (F8 ? 0.015625f : 1.f);
#pragma unroll
        for (int ai = 0; ai < 2; ++ai)
#pragma unroll
            for (int m = 0; m < 4; ++m) { bf16_t* rowp = O + (size_t)(row0 + ai * HALF + m * 16) * ldc + col0;
                float o[8];
#pragma unroll
                for (int n = 0; n < 2; ++n)
#pragma unroll
                    for (int j = 0; j < 4; ++j) { const float g = acc[ai][0][m][n][j] * rsv[ai][m], up = acc[ai][1][m][n][j] * rsv[ai][m]; o[n * 4 + j] = g * __builtin_amdgcn_rcpf(1.f + __expf(-g)) * up; }
                if (F8) { int w0 = 0, w1 = 0; w0 = __builtin_amdgcn_cvt_pk_fp8_f32(o[0], o[1], w0, false); w0 = __builtin_amdgcn_cvt_pk_fp8_f32(o[2], o[3], w0, true);
                    w1 = __builtin_amdgcn_cvt_pk_fp8_f32(o[4], o[5], w1, false); w1 = __builtin_amdgcn_cvt_pk_fp8_f32(o[6], o[7], w1, true);
                    *(u32x2*)((unsigned char*)O + (size_t)(row0 + ai * HALF + m * 16) * ldc + col0) = (u32x2){(unsigned)w0, (unsigned)w1}; }
                else { u32x4 w; w.x = cvt_pk_bf16(o[0], o[1]); w.y = cvt_pk_bf16(o[2], o[3]); w.z = cvt_pk_bf16(o[4], o[5]); w.w = cvt_pk_bf16(o[6], o[7]);
                    *(u32x4*)rowp = w; }
                asm volatile("" ::: "memory"); }
    }
};
typedef EpiSwiGLUT<false> EpiSwiGLU;
struct EpiResid {
    static constexpr bool PERM = false;
    const float* resid; float* out; int ldc;
    DI void operator()(const f32x4 (&acc)[2][2][4][2], const Unit& u, int wr, int wc, int fr, int fq) const {
        const int row0 = u.pm * BM + wr * 64 + fr, col0 = u.pn * BM + wc * 32 + 4 * fq;
#pragma unroll
        for (int ai = 0; ai < 2; ++ai)
#pragma unroll
            for (int m = 0; m < 4; ++m) { const size_t off = (size_t)(row0 + ai * HALF + m * 16) * ldc + col0;
#pragma unroll
                for (int bj = 0; bj < 2; ++bj)
#pragma unroll
                    for (int n = 0; n < 2; ++n) { const f32x4 r = *(const f32x4*)(resid + off + bj * HALF + n * 16); *(f32x4*)(out + off + bj * HALF + n * 16) = r + acc[ai][bj][m][n]; } }
    }
};
struct EpiResidN {
    static constexpr bool PERM = false;
    const float* resid; float* out; bf16_t* xb; float* rsq; int ldc; LAS float* P  ; int tid;
    DI void operator()(const f32x4 (&acc)[2][2][4][2], const Unit& u, int wr, int wc, int fr, int fq) const {
        const int row0 = u.pm * BM + wr * 64 + fr, col0 = u.pn * BM + wc * 32 + 4 * fq;
        const int lane = fr + 16 * fq;
#pragma unroll
        for (int ai = 0; ai < 2; ++ai)
#pragma unroll
            for (int m = 0; m < 4; ++m) { const size_t off = (size_t)(row0 + ai * HALF + m * 16) * ldc + col0; float ss = 0.f;
#pragma unroll
                for (int bj = 0; bj < 2; ++bj)
#pragma unroll
                    for (int n = 0; n < 2; ++n) { const f32x4 v = *(const f32x4*)(resid + off + bj * HALF + n * 16) + acc[ai][bj][m][n]; *(f32x4*)(out + off + bj * HALF + n * 16) = v;
                        *(u32x2*)(xb + off + bj * HALF + n * 16) = (u32x2){cvt_pk_bf16(v[0], v[1]), cvt_pk_bf16(v[2], v[3])}; ss += (v[0] * v[0] + v[1] * v[1]) + (v[2] * v[2] + v[3] * v[3]); }
                ss += __builtin_bit_cast(float, __builtin_amdgcn_ds_swizzle(__builtin_bit_cast(int, ss), 0x401F));
                ss += __builtin_bit_cast(float, __builtin_amdgcn_ds_bpermute((lane ^ 32) << 2, __builtin_bit_cast(int, ss)));
                if (fq == 0) P[(wr * 64 + ai * HALF + m * 16 + fr) * 4 + wc] = ss;
                asm volatile("" ::: "memory"); }
        asm volatile("s_waitcnt lgkmcnt(0)" ::: "memory"); __builtin_amdgcn_s_barrier(); asm volatile("" ::: "memory");
        if (tid < 256) { const LAS float* p = P + tid * 4; rsq[(size_t)u.pn * NTOK + u.pm * BM + tid] = (p[0] + p[1]) + (p[2] + p[3]); }
    }
};
struct EpiRowScaleBf {
    static constexpr bool PERM = true;
    const float* rscale; bf16_t* out; int ldc; float mul;
    DI void operator()(const f32x4 (&acc)[2][2][4][2], const Unit& u, int wr, int wc, int fr, int fq) const {
        const int row0 = u.pm * BM + wr * 64 + fr, col0 = u.pn * BM + wc * 32 + 8 * fq;
#pragma unroll
        for (int ai = 0; ai < 2; ++ai)
#pragma unroll
            for (int m = 0; m < 4; ++m) { const int row = row0 + ai * HALF + m * 16; const float s = rscale[row] * mul; bf16_t* rowp = out + (size_t)row * ldc + col0;
#pragma unroll
                for (int bj = 0; bj < 2; ++bj) { const f32x4 v0 = acc[ai][bj][m][0] * s, v1 = acc[ai][bj][m][1] * s;
                    u32x4 w; w.x = cvt_pk_bf16(v0[0], v0[1]); w.y = cvt_pk_bf16(v0[2], v0[3]); w.z = cvt_pk_bf16(v1[0], v1[1]); w.w = cvt_pk_bf16(v1[2], v1[3]);
                    *(u32x4*)(rowp + bj * HALF) = w; }
                asm volatile("" ::: "memory"); }
    }
};
struct EpiRowScale {
    static constexpr bool PERM = false;
    const float* rscale; float* out; int ldc; float mul;
    DI void operator()(const f32x4 (&acc)[2][2][4][2], const Unit& u, int wr, int wc, int fr, int fq) const {
        const int row0 = u.pm * BM + wr * 64 + fr, col0 = u.pn * BM + wc * 32 + 4 * fq;
#pragma unroll
        for (int ai = 0; ai < 2; ++ai)
#pragma unroll
            for (int m = 0; m < 4; ++m) { const int row = row0 + ai * HALF + m * 16; const float s = rscale[row] * mul; const size_t off = (size_t)row * ldc + col0;
#pragma unroll
                for (int bj = 0; bj < 2; ++bj)
#pragma unroll
                    for (int n = 0; n < 2; ++n) *(f32x4*)(out + off + bj * HALF + n * 16) = acc[ai][bj][m][n] * s;
                asm volatile("" ::: "memory"); }
    }
};

typedef int v8i_t __attribute__((ext_vector_type(8)));
template <class Epi, class Sched, bool FP8 = false, bool ALIGN_EPI = true, bool SP2 = true>
DI void gemm_phase(LAS unsigned char* lds, const int nt, const int ldaB, const int ldbB, const Sched& S, const Epi& E, int tid) {
    asm volatile("" : "+v"(tid));
    const int wid = __builtin_amdgcn_readfirstlane(tid >> 6), lane = tid & 63, wr = wid >> 2, wc = wid & 3, fr = lane & 15, fq = lane >> 4;
    unsigned voffA[2], voffB[2];
#pragma unroll
    for (int i = 0; i < 2; ++i) { int R, C; stage_rc(tid * 16 + i * 8192, R, C); const int Rb = Epi::PERM ? ((R & ~31) + perm32(R & 31)) : R;
        voffA[i] = (unsigned)(R * ldaB + C * 2); voffB[i] = (unsigned)(Rb * ldbB + C * 2); }
    const size_t kstep = (size_t)(BK * 2);
    const size_t hstepA = (size_t)HALF * ldaB, hstepB = (size_t)HALF * ldbB;
    const unsigned ldsw = (unsigned)wid * 1024u;
    const int aoff = lds_byte(wr * 64 + fr, fq * 8), boff = lds_byte(wc * 32 + fr, fq * 8);
#define PG8_SA(b, h) (((b) * 2 + (h)) * HTB)
#define PG8_SB(b, h) ((4 + (b) * 2 + (h)) * HTB)
#define PG8_STAGE(bufoff, gbase, voff) do { _Pragma("unroll") for (int _i = 0; _i < 2; ++_i) \
        __builtin_amdgcn_global_load_lds((const unsigned*)((const char*)(gbase) + (voff)[_i]), (LAS unsigned*)(lds + (bufoff) + ldsw + _i * 8192), 16, 0, 0); } while (0)
#define PG8_LDA(dst, b, h) do { _Pragma("unroll") for (int m = 0; m < 4; ++m) _Pragma("unroll") for (int k = 0; k < 2; ++k) dst[m][k] = *(const LAS bf16x8*)(lds + PG8_SA(b, h) + aoff + m * 2048 + k * 1024); } while (0)
#define PG8_LDB(dst, b, h) do { _Pragma("unroll") for (int n = 0; n < 2; ++n) _Pragma("unroll") for (int k = 0; k < 2; ++k) dst[n][k] = *(const LAS bf16x8*)(lds + PG8_SB(b, h) + boff + n * 2048 + k * 1024); } while (0)
#define PG8_CAT(x0, x1) __builtin_shufflevector(__builtin_bit_cast(u32x4, (x0)), __builtin_bit_cast(u32x4, (x1)), 0, 1, 2, 3, 4, 5, 6, 7)
#define PG8_MMA(ai, bj, At, Bt) do { __builtin_amdgcn_s_setprio(1); _Pragma("unroll") for (int m = 0; m < 4; ++m) _Pragma("unroll") for (int n = 0; n < 2; ++n) { \
        if constexpr (FP8) { const v8i_t wa_ = __builtin_bit_cast(v8i_t, PG8_CAT(Bt[n][0], Bt[n][1])), xa_ = __builtin_bit_cast(v8i_t, PG8_CAT(At[m][0], At[m][1])); \
            asm volatile("v_mfma_f32_16x16x128_f8f6f4 %0, %1, %2, %0" : "+v"(acc[ai][bj][m][n]) : "v"(wa_), "v"(xa_)); }   \
        else { _Pragma("unroll") for (int k = 0; k < 2; ++k) acc[ai][bj][m][n] = __builtin_amdgcn_mfma_f32_16x16x32_bf16(Bt[n][k], At[m][k], acc[ai][bj][m][n], 0, 0, 0); } } \
        __builtin_amdgcn_s_setprio(0); } while (0)
#define PG8_WAIT_V(n) asm volatile("s_waitcnt vmcnt(" #n ")" ::: "memory")
#define PG8_WAIT_L(n) asm volatile("s_waitcnt lgkmcnt(" #n ")" ::: "memory")
#define PG8_BAR __builtin_amdgcn_s_barrier()
#define PG8_SCHED __builtin_amdgcn_sched_barrier(0)
    Unit cur, nxt; int ui = 0;
    if (!S.next(0, cur)) return;
    f32x4 acc[2][2][4][2];
#pragma unroll
    for (int a = 0; a < 2; ++a)
#pragma unroll
        for (int b = 0; b < 2; ++b)
#pragma unroll
            for (int m = 0; m < 4; ++m)
#pragma unroll
                for (int n = 0; n < 2; ++n) acc[a][b][m][n] = (f32x4){0.f, 0.f, 0.f, 0.f};
    bf16x8 At[4][2], B0[2][2], B1[2][2];
    const char* cA = S.abase(cur); const char* cB = S.bbase(cur);
    static_assert(SP2, "only the SP2 loop is kept");
    PG8_STAGE(PG8_SB(0, 0), cB, voffB); PG8_STAGE(PG8_SB(0, 1), cB + hstepB, voffB); PG8_STAGE(PG8_SA(0, 0), cA, voffA); PG8_STAGE(PG8_SA(0, 1), cA + hstepA, voffA);
    if (wr == 1) PG8_BAR;
    PG8_WAIT_V(2); PG8_BAR;
    PG8_STAGE(PG8_SB(1, 0), cB + kstep, voffB); PG8_STAGE(PG8_SA(1, 0), cA + kstep, voffA); PG8_STAGE(PG8_SB(1, 1), cB + hstepB + kstep, voffB);
    PG8_WAIT_V(6); PG8_BAR;
    for (;;) {
        const bool has_next = S.next(ui + 1, nxt);
        const char* nA = has_next ? S.abase(nxt) : cA; const char* nB = has_next ? S.bbase(nxt) : cB;
        for (int t = 0; t < nt; t += 2) {
            const bool last = (t == nt - 2);
            const char* a1 = cA + (size_t)(t + 1) * kstep;
            const char* a2 = last ? nA : cA + (size_t)(t + 2) * kstep; const char* b2 = last ? nB : cB + (size_t)(t + 2) * kstep;
            const char* a3 = a2 + kstep; const char* b3 = b2 + kstep;
            PG8_LDB(B0, 0, 0); PG8_LDB(B1, 0, 1); PG8_SCHED; PG8_LDA(At, 0, 0); PG8_STAGE(PG8_SA(1, 1), a1 + hstepA, voffA);
            PG8_WAIT_V(8); PG8_WAIT_L(0); PG8_BAR; PG8_MMA(0, 0, At, B0); PG8_MMA(0, 1, At, B1); PG8_BAR; PG8_SCHED;
            PG8_LDA(At, 0, 1); PG8_STAGE(PG8_SB(0, 0), b2, voffB); PG8_STAGE(PG8_SB(0, 1), b2 + hstepB, voffB); PG8_STAGE(PG8_SA(0, 0), a2, voffA);
            PG8_WAIT_V(8); PG8_WAIT_L(0); PG8_BAR; PG8_MMA(1, 0, At, B0); PG8_MMA(1, 1, At, B1); PG8_BAR; PG8_SCHED;
            PG8_LDB(B0, 1, 0); PG8_LDB(B1, 1, 1); PG8_SCHED; PG8_LDA(At, 1, 0); PG8_STAGE(PG8_SA(0, 1), a2 + hstepA, voffA);
            PG8_WAIT_V(8); PG8_WAIT_L(0); PG8_BAR; PG8_MMA(0, 0, At, B0); PG8_MMA(0, 1, At, B1); PG8_BAR; PG8_SCHED;
            PG8_LDA(At, 1, 1); PG8_STAGE(PG8_SB(1, 0), b3, voffB); PG8_STAGE(PG8_SB(1, 1), b3 + hstepB, voffB); PG8_STAGE(PG8_SA(1, 0), a3, voffA);
            PG8_WAIT_V(8); PG8_WAIT_L(0); PG8_BAR; PG8_MMA(1, 0, At, B0); PG8_MMA(1, 1, At, B1); PG8_BAR; PG8_SCHED;
        }
        if constexpr (ALIGN_EPI) { if (wr == 0) PG8_BAR; }
        if constexpr (FP8) asm volatile("s_nop 15\n\ts_nop 15" ::: "memory");
        E(acc, cur, wr, wc, fr, fq);
        if (!has_next) break;
#pragma unroll
        for (int a = 0; a < 2; ++a)
#pragma unroll
            for (int b = 0; b < 2; ++b)
#pragma unroll
                for (int m = 0; m < 4; ++m)
#pragma unroll
                    for (int n = 0; n < 2; ++n) acc[a][b][m][n] = (f32x4){0.f, 0.f, 0.f, 0.f};
        cur = nxt; cA = nA; cB = nB; ++ui;
        if constexpr (ALIGN_EPI) { if (wr == 1) PG8_BAR; }
    }
    PG8_WAIT_V(0);
    if constexpr (!ALIGN_EPI) { if (wr == 0) PG8_BAR; }
    PG8_BAR;
#undef PG8_SA
#undef PG8_SB
#undef PG8_STAGE
#undef PG8_LDA
#undef PG8_LDB
#undef PG8_MMA
#undef PG8_CAT
#undef PG8_WAIT_V
#undef PG8_WAIT_L
#undef PG8_BAR
#undef PG8_SCHED
}
}

struct Args { const float* in[24]; float* out; unsigned char* ws; int ph_lo, ph_hi; };
enum { I_X = 0, I_ATTN_NORM, I_W_IN, I_POS_K, I_POS_V, I_W1K, I_W2K, I_W1V, I_W2V, I_CONV, I_ALOG, I_DTB, I_GNORM, I_SINKS, I_W_OUT, I_FFN_NORM,
       I_DGATE, I_DUP, I_DDOWN, I_ROUTER, I_MGATE, I_MUP, I_MDOWN, I_FINAL };
struct Frame {
    LAS unsigned char* lds;
    int tid, lane, wave, G, bid;
    float* out; unsigned char* ws;
    int wave0;
    DI void refresh() { int l = __builtin_amdgcn_mbcnt_hi(-1, __builtin_amdgcn_mbcnt_lo(-1, 0)); asm volatile("" : "+v"(l)); lane = l; wave = wave0; tid = wave0 * 64 + l; }
};

template <class F> DI void tr_item(const float* W, int ldw, int k0, bf16_t* dst, int K, LAS float* scr, int lane, F srccol, const float* rowgain = nullptr  ) {
    const int r = lane & 31; const int sc = srccol(r);
#pragma unroll 8
    for (int i = 0; i < 32; ++i) { const int kk = 2 * i + (lane >> 5); scr[kk * 33 + r] = sc >= 0 ? W[(size_t)(k0 + kk) * ldw + sc] * (rowgain ? rowgain[k0 + kk] : 1.f) : 0.f; }
    LDS_WAIT();
    const int c = lane & 7;
#pragma unroll
    for (int j = 0; j < 4; ++j) { const int n = (lane >> 3) + 8 * j; const LAS float* s = scr + (8 * c) * 33 + n;
        u32x4 o; o.x = pk2(s[0 * 33], s[1 * 33]); o.y = pk2(s[2 * 33], s[3 * 33]); o.z = pk2(s[4 * 33], s[5 * 33]); o.w = pk2(s[6 * 33], s[7 * 33]);
        *(u32x4*)(dst + (size_t)n * K + k0 + 8 * c) = o; }
    LDS_WAIT();
}
DI int win_srccol(int n) { return n < 1280 ? n : n < 5376 ? n + 12 : n < 6400 ? n + 28 : n < 6412 ? 1280 + (n - 6400) : n < 6428 ? 5388 + (n - 6412) : -1; }
DI void tr64_load(const float* src, int ldw, int lane, f32x4 (&v)[16]) { const int n4 = lane & 15, kr = lane >> 4;
#pragma unroll
    for (int i = 0; i < 16; ++i) v[i] = *(const f32x4*)(src + (size_t)(4 * i + kr) * ldw + 4 * n4); }
DI void tr64_stepA(f32x4 (&v)[16], LAS float* scr, int lane, const float* rowgain) { const int n4 = lane & 15, kr = lane >> 4;
    if (rowgain) {
#pragma unroll
        for (int i = 0; i < 16; ++i) v[i] *= rowgain[4 * i + kr]; }
#pragma unroll
    for (int i = 0; i < 16; ++i) { const int k = 4 * i + kr; *(LAS f32x4*)(scr + k * 64 + 4 * (n4 ^ ((k >> 3) & 7))) = v[i]; }
    LDS_WAIT(); }
DI void tr64_stepB(bf16_t* dst, int K, LAS float* scr, int lane) { const int c = lane & 7, nb = lane >> 3;
#pragma unroll
    for (int j = 0; j < 8; ++j) { const int n = nb + 8 * j; const LAS float* sp = scr + (8 * c) * 64 + (n ^ (c << 2));
        u32x4 o; o.x = cvt_pk_bf16(sp[0 * 64], sp[1 * 64]); o.y = cvt_pk_bf16(sp[2 * 64], sp[3 * 64]); o.z = cvt_pk_bf16(sp[4 * 64], sp[5 * 64]); o.w = cvt_pk_bf16(sp[6 * 64], sp[7 * 64]);
        *(u32x4*)(dst + (size_t)n * K + 8 * c) = o; }
    LDS_WAIT(); }
DI void tr_item64(const float* src, int ldw, bf16_t* dst, int K, LAS float* scr, int lane, const float* rowgain = nullptr  ) {
    const int n4 = lane & 15, kr = lane >> 4;
    f32x4 v[16];
#pragma unroll
    for (int i = 0; i < 16; ++i) v[i] = *(const f32x4*)(src + (size_t)(4 * i + kr) * ldw + 4 * n4);
    if (rowgain) {
#pragma unroll
        for (int i = 0; i < 16; ++i) v[i] *= rowgain[4 * i + kr]; }
#pragma unroll
    for (int i = 0; i < 16; ++i) { const int k = 4 * i + kr; *(LAS f32x4*)(scr + k * 64 + 4 * (n4 ^ ((k >> 3) & 7))) = v[i]; }
    LDS_WAIT();
    const int c = lane & 7, nb = lane >> 3;
#pragma unroll
    for (int j = 0; j < 8; ++j) { const int n = nb + 8 * j; const LAS float* sp = scr + (8 * c) * 64 + (n ^ (c << 2));
        u32x4 o; o.x = cvt_pk_bf16(sp[0 * 64], sp[1 * 64]); o.y = cvt_pk_bf16(sp[2 * 64], sp[3 * 64]); o.z = cvt_pk_bf16(sp[4 * 64], sp[5 * 64]); o.w = cvt_pk_bf16(sp[6 * 64], sp[7 * 64]);
        *(u32x4*)(dst + (size_t)n * K + 8 * c) = o; }
    LDS_WAIT();
}
constexpr int J_WIN = 32 * 100, J_WOUT = 32 * 32, J_GU = 32 * (GU / 64), J_DN = (DFF / 64) * (DM / 64);
constexpr int Q_TOTAL = NEXP * (J_GU + J_DN);
DI void tr_item64_f8(const float* src, int ldw, unsigned char* dst, int K, LAS float* scr, int lane) {
    const int n4 = lane & 15, kr = lane >> 4;
    f32x4 v[16];
#pragma unroll
    for (int i = 0; i < 16; ++i) v[i] = *(const f32x4*)(src + (size_t)(4 * i + kr) * ldw + 4 * n4);
#pragma unroll
    for (int i = 0; i < 16; ++i) { const int k = 4 * i + kr; *(LAS f32x4*)(scr + k * 64 + 4 * (n4 ^ ((k >> 3) & 7))) = v[i]; }
    LDS_WAIT();
    const int c = lane & 7, nb = lane >> 3;
#pragma unroll
    for (int j = 0; j < 8; ++j) { const int n = nb + 8 * j; const LAS float* sp = scr + (8 * c) * 64 + (n ^ (c << 2));
        int w0 = 0, w1 = 0;
        w0 = __builtin_amdgcn_cvt_pk_fp8_f32(sp[0 * 64] * 64.f, sp[1 * 64] * 64.f, w0, false); w0 = __builtin_amdgcn_cvt_pk_fp8_f32(sp[2 * 64] * 64.f, sp[3 * 64] * 64.f, w0, true);
        w1 = __builtin_amdgcn_cvt_pk_fp8_f32(sp[4 * 64] * 64.f, sp[5 * 64] * 64.f, w1, false); w1 = __builtin_amdgcn_cvt_pk_fp8_f32(sp[6 * 64] * 64.f, sp[7 * 64] * 64.f, w1, true);
        *(u32x2*)(dst + (size_t)n * K + 8 * c) = (u32x2){(unsigned)w0, (unsigned)w1}; }
    LDS_WAIT();
}
struct MoeIt { const float* src; unsigned char* dst; int ldw, K; };
DI MoeIt moe_decode(unsigned char* ws, const float* mgate, const float* mup, const float* mdown, int q) {
    const float* src; unsigned char* dst; int ldw, K;
    if (q < NEXP * J_GU) { const int e = q / J_GU, r = q % J_GU, nblk = GU / 64, pr_ = r >> 1, kb = 2 * (pr_ / nblk) + (r & 1), nb = pr_ % nblk;
        const int d0 = 64 * nb, j = d0 >> 8, half = (d0 >> 7) & 1, c0 = d0 & 127;
        src = (half ? mup : mgate) + (size_t)e * DM * DFF + (size_t)(64 * kb) * DFF + 128 * j + c0; ldw = DFF;
        dst = ws + WS_MGU + (size_t)e * GU * DM + (size_t)d0 * DM + 64 * kb; K = DM;
    } else { const int q2 = q - NEXP * J_GU, e = q2 / J_DN, r = q2 % J_DN, nblk = DM / 64, pr_ = r >> 1, kb = 2 * (pr_ / nblk) + (r & 1), nb = pr_ % nblk;
        src = mdown + (size_t)e * DFF * DM + (size_t)(64 * kb) * DM + 64 * nb; ldw = DM;
        dst = ws + WS_MDN + (size_t)e * DM * DFF + (size_t)(64 * nb) * DFF + 64 * kb; K = DFF; }
    return MoeIt{src, dst, ldw, K};
}
DI void moe_item(unsigned char* ws, const float* mgate, const float* mup, const float* mdown, int q, LAS float* scr, int lane) {
    const MoeIt m = moe_decode(ws, mgate, mup, mdown, q); tr_item64_f8(m.src, m.ldw, m.dst, m.K, scr, lane);
}
DI void tr64_stepB_f8(unsigned char* dst, int K, LAS float* scr, int lane) { const int c = lane & 7, nb = lane >> 3;
#pragma unroll
    for (int j = 0; j < 8; ++j) { const int n = nb + 8 * j; const LAS float* sp = scr + (8 * c) * 64 + (n ^ (c << 2));
        int w0 = 0, w1 = 0;
        w0 = __builtin_amdgcn_cvt_pk_fp8_f32(sp[0 * 64] * 64.f, sp[1 * 64] * 64.f, w0, false); w0 = __builtin_amdgcn_cvt_pk_fp8_f32(sp[2 * 64] * 64.f, sp[3 * 64] * 64.f, w0, true);
        w1 = __builtin_amdgcn_cvt_pk_fp8_f32(sp[4 * 64] * 64.f, sp[5 * 64] * 64.f, w1, false); w1 = __builtin_amdgcn_cvt_pk_fp8_f32(sp[6 * 64] * 64.f, sp[7 * 64] * 64.f, w1, true);
        *(u32x2*)(dst + (size_t)n * K + 8 * c) = (u32x2){(unsigned)w0, (unsigned)w1}; }
    LDS_WAIT(); }
DI void drain_convert(Frame& F, const float* mgate, const float* mup, const float* mdown) {
    volatile LAS int* qs = (volatile LAS int*)(F.lds + LDS_MISC) + 16;
    unsigned* qh = (unsigned*)(F.ws + WS_CTL) + CW_QHEAD;
    LAS float* scr = (LAS float*)(F.lds + LDS_SCR + F.wave * 16384);
    int claim = 0;
    if (F.tid == 0) qs[0] = (int)atomicAdd(qh, 8u);
    __syncthreads();
    const int base = __builtin_amdgcn_readfirstlane(qs[0]);
    __syncthreads();
    if (base >= Q_TOTAL) return;
    if (F.tid == 0) claim = (int)atomicAdd(qh, 8u);
    f32x4 v[16];
    bool cv = base + F.wave < Q_TOTAL; MoeIt cur = moe_decode(F.ws, mgate, mup, mdown, cv ? base + F.wave : 0);
    if (cv) tr64_load(cur.src, cur.ldw, F.lane, v);
#pragma unroll 1
    for (;;) {
        if (cv) tr64_stepA(v, scr, F.lane, nullptr);
        if (F.tid == 0) qs[0] = claim;
        __syncthreads();
        const int nb = __builtin_amdgcn_readfirstlane(qs[0]);
        __syncthreads();
        const bool more = nb < Q_TOTAL;
        if (more && F.tid == 0) claim = (int)atomicAdd(qh, 8u);
        unsigned char* const cdst = cur.dst; const int cK = cur.K;
        const bool nv = more && (nb + F.wave < Q_TOTAL);
        if (nv) { cur = moe_decode(F.ws, mgate, mup, mdown, nb + F.wave); tr64_load(cur.src, cur.ldw, F.lane, v); }
        if (cv) tr64_stepB_f8(cdst, cK, scr, F.lane);
        if (!more) break;
        cv = nv;
    }
}
DI bool steal_convert(Frame& F, const float* mgate, const float* mup, const float* mdown) {
    volatile LAS int* qs = (volatile LAS int*)(F.lds + LDS_MISC) + 16;
    if (F.tid == 0) qs[0] = (int)atomicAdd((unsigned*)(F.ws + WS_CTL) + CW_QHEAD, 8u);
    __syncthreads();
    const int base = __builtin_amdgcn_readfirstlane(qs[0]);
    __syncthreads();
    if (base >= Q_TOTAL) return false;
    const int q = base + F.wave;
    if (q < Q_TOTAL) moe_item(F.ws, mgate, mup, mdown, q, (LAS float*)(F.lds + LDS_SCR + F.wave * 16384), F.lane);
    return true;
}
struct CvItem { const float* src; bf16_t* dst; int ldw, K; const float* gain; };
DI CvItem cv_decode(int it, unsigned char* ws, const float* w_in, const float* w_out, const float* dgate, const float* dup, const float* ddown,
                    const float* w1k, const float* w1v, const float* w2k, const float* w2v, const float* attn_norm1, const float* ffn_norm0) {
    constexpr int T0 = 2 * J_WIN, T1 = T0 + 2 * J_WOUT, T2 = T1 + J_GU, T3 = T2 + J_DN, T6 = T3 + 4 * 256;
        const float* src; bf16_t* dst; int ldw, K; const float* gain = nullptr;
        if (it >= T6) { const int q = it - T6, mi = q >> 3, r = q & 7, kb = r >> 1, nb = r & 1, L = mi >> 1, kv = mi & 1;
            src = (kv ? w2v : w2k) + (size_t)L * 256 * HD + (size_t)(64 * kb) * HD + 64 * nb; ldw = HD; dst = (bf16_t*)(ws + WS_CW2) + (size_t)mi * HD * 256 + (size_t)(64 * nb) * 256 + 64 * kb; K = 256;
        } else if (it >= T3) { const int q = it - T3, mi = q >> 8, r = q & 255, kb = r >> 2, nb = r & 3, L = mi >> 1, kv = mi & 1;
            src = (kv ? w1v : w1k) + (size_t)L * 4096 * 256 + (size_t)(64 * kb) * 256 + 64 * nb; ldw = 256; dst = (bf16_t*)(ws + WS_CW1) + (size_t)mi * 256 * 4096 + (size_t)(64 * nb) * 4096 + 64 * kb; K = 4096;
        } else if (it < T0) { const int L = it / J_WIN, r = it % J_WIN, kb = r / 100, nb = r % 100, nd = 64 * nb, ns = win_srccol(nd);
            src = w_in + (size_t)L * DM * DIN + (size_t)(64 * kb) * DIN + ns; ldw = DIN; dst = (bf16_t*)(ws + WS_WIN + L * SZ_WIN) + (size_t)nd * DM + 64 * kb; K = DM; if (L == 1) gain = attn_norm1 + 64 * kb;
        } else if (it < T1) { const int q = it - T0, L = q / J_WOUT, r = q % J_WOUT, kb = r / 32, nb = r % 32;
            src = w_out + (size_t)L * DM * DM + (size_t)(64 * kb) * DM + 64 * nb; ldw = DM; dst = (bf16_t*)(ws + WS_WOUT + L * SZ_WOUT) + (size_t)(64 * nb) * DM + 64 * kb; K = DM;
        } else if (it < T2) {
            const int r = it - T1, nblk = GU / 64, kb = r / nblk, nb = r % nblk;
            const int d0 = 64 * nb, j = d0 >> 8, half = (d0 >> 7) & 1, c0 = d0 & 127;
            src = (half ? dup : dgate) + (size_t)(64 * kb) * DFF + 128 * j + c0; ldw = DFF;
            dst = (bf16_t*)(ws + WS_DGU) + (size_t)d0 * DM + 64 * kb; K = DM; gain = ffn_norm0 + 64 * kb;
        } else { const int r = it - T2, nblk = DM / 64, kb = r / nblk, nb = r % nblk;
            src = ddown + (size_t)(64 * kb) * DM + 64 * nb; ldw = DM;
            dst = (bf16_t*)(ws + WS_DDN) + (size_t)(64 * nb) * DFF + 64 * kb; K = DFF;
        }
    return CvItem{src, dst, ldw, K, gain};
}
DI void phase_convert(Frame& F, const float* w_in, const float* w_out, const float* dgate, const float* dup, const float* ddown,
                      const float* w1k, const float* w1v, const float* w2k, const float* w2v, const float* attn_norm1, const float* ffn_norm0) {
    LAS float* scr = (LAS float*)(F.lds + LDS_SCR + F.wave * 16384);
    const int gw = F.bid * 8 + F.wave, NGW = F.G * 8;
    constexpr int T0 = 2 * J_WIN, T1 = T0 + 2 * J_WOUT, T2 = T1 + J_GU, T3 = T2 + J_DN, T6 = T3 + 4 * 256, T7 = T6 + 4 * 8;
    if (gw < T7) {
        f32x4 v[16];
        CvItem cur = cv_decode(gw, F.ws, w_in, w_out, dgate, dup, ddown, w1k, w1v, w2k, w2v, attn_norm1, ffn_norm0); tr64_load(cur.src, cur.ldw, F.lane, v);
#pragma unroll 1
        for (int it = gw; it < T7; it += NGW) {
            tr64_stepA(v, scr, F.lane, cur.gain);
            bf16_t* const cdst = cur.dst; const int cK = cur.K;
            if (it + NGW < T7) { cur = cv_decode(it + NGW, F.ws, w_in, w_out, dgate, dup, ddown, w1k, w1v, w2k, w2v, attn_norm1, ffn_norm0); tr64_load(cur.src, cur.ldw, F.lane, v); }
            tr64_stepB(cdst, cK, scr, F.lane);
        }
    }

    for (int it = gw; it < 2 * 32; it += NGW) { const int L = it / 32, kb = it % 32;
        tr_item(w_in + (size_t)L * DM * DIN, DIN, 64 * kb, (bf16_t*)(F.ws + WS_WIN + L * SZ_WIN) + (size_t)6400 * DM, DM, scr, F.lane, [&](int rr) { return win_srccol(6400 + rr); }, L == 1 ? attn_norm1 : nullptr); }
    for (int it = gw; it < 2 * 224; it += NGW) { const int L = it / 224, row = 6432 + it % 224; u32x4* d = (u32x4*)((bf16_t*)(F.ws + WS_WIN + L * SZ_WIN) + (size_t)row * DM);
#pragma unroll
        for (int j = 0; j < 4; ++j) d[F.lane + 64 * j] = (u32x4){0u, 0u, 0u, 0u}; }
}

DI void xcd_barrier_steal(const XcdBarrier& b, const bool leader, Frame& F, bool& qactive, const float* mgate, const float* mup, const float* mdown) {
    asm volatile("s_waitcnt vmcnt(0)" ::: "memory");
    __syncthreads();
    volatile LAS unsigned* fl = b.st + 2;
    if (leader) {
        unsigned* bar = b.bar;
        __builtin_amdgcn_s_waitcnt(0);
        unsigned nloc = b.st[0], nx = b.st[1];
        if (nloc == 0u) { xcd_barrier_complete(bar, b.x, nloc, nx); b.st[0] = nloc; b.st[1] = nx; }
        const unsigned old = xb_add(&bar[XB_XSUB(b.x)], 1u);
        const unsigned gen = old / nloc;
        if (old + 1u == (gen + 1u) * nloc) {
            __builtin_amdgcn_fence(__ATOMIC_RELEASE, "agent");
            asm volatile("s_waitcnt vmcnt(0)" ::: "memory");
            const unsigned og = xb_add(&bar[XB_TOP], 1u);
            const unsigned tg = og / nx;
            if (og + 1u == (tg + 1u) * nx) xb_add(&bar[XB_TOPGEN], 1u);
            else XB_SPIN(xb_ld(&bar[XB_TOPGEN]) == tg, bar);
            __builtin_amdgcn_fence(__ATOMIC_ACQUIRE, "agent");
            xb_add(&bar[XB_XGEN(b.x)], 1u);
            asm volatile("s_waitcnt vmcnt(0)" ::: "memory");
            fl[0] = 1u; fl[1] = 0xFFFFFFFFu;
        } else { fl[0] = 0u; fl[1] = gen; }
    }
    __syncthreads();
    bool released = fl[0] != 0u;
    const bool waited = !released;
    __syncthreads();
    while (!released) {
        bool more = false;
        if (qactive) { more = steal_convert(F, mgate, mup, mdown); if (!more) qactive = false; }
        if (leader) {
            unsigned* bar = b.bar; const unsigned gen = fl[1];
            if (more) { if (xb_ld(&bar[XB_XGEN(b.x)]) != gen || xb_ld(&bar[XB_TMO]) != 0u) fl[0] = 1u; }
            else { XB_SPIN(xb_ld(&bar[XB_XGEN(b.x)]) == gen, bar); fl[0] = 1u; }
        }
        __syncthreads();
        released = fl[0] != 0u;
        __syncthreads();
    }
    if (leader && waited) { asm volatile("s_waitcnt vmcnt(0)" ::: "memory"); __builtin_amdgcn_fence(__ATOMIC_ACQUIRE, "agent"); asm volatile("s_waitcnt vmcnt(0)" ::: "memory"); }
    __syncthreads();
}

template <bool ROUTER> DI void phase_norm(Frame& F, const float* x, const float* w, bf16_t* hb, const float* router) {
    LAS float* rl = (LAS float*)(F.lds + LDS_SCR);
    if (ROUTER) { for (int i = F.tid; i < DM * NEXP / 4; i += 512) ((LAS f32x4*)rl)[i ^ ((i >> 4) & 7)] = ((const f32x4*)router)[i]; __syncthreads(); }
    int* topi = (int*)(F.ws + WS_RT + RT_TOPI); float* topg = (float*)(F.ws + WS_RT + RT_TOPG);
    const int gw = F.bid * 8 + F.wave, NGW = F.G * 8;
    f32x4 vn[8];
    if (gw < NTOK) { const f32x4* xr = (const f32x4*)(x + (size_t)gw * DM) + F.lane;
#pragma unroll
        for (int j = 0; j < 8; ++j) vn[j] = xr[64 * j]; }
    for (int m = gw; m < NTOK; m += NGW) {
        f32x4 v[8]; float s = 0.f;
#pragma unroll
        for (int j = 0; j < 8; ++j) v[j] = vn[j];
        if (m + NGW < NTOK) { const f32x4* xr = (const f32x4*)(x + (size_t)(m + NGW) * DM) + F.lane;
#pragma unroll
            for (int j = 0; j < 8; ++j) vn[j] = xr[64 * j]; }
#pragma unroll
        for (int j = 0; j < 8; ++j) s += (v[j].x * v[j].x + v[j].y * v[j].y) + (v[j].z * v[j].z + v[j].w * v[j].w);
        const float rs = rsqrtf(wave_sum(s) * (1.f / DM) + EPS);
        float lg[NEXP];
        if (ROUTER) {
#pragma unroll
            for (int e = 0; e < NEXP; ++e) lg[e] = 0.f; }
        u32x2* o8 = (u32x2*)(hb + (size_t)m * DM) + F.lane;
#pragma unroll
        for (int j = 0; j < 8; ++j) { const f32x4 w4 = ((const f32x4*)w)[F.lane + 64 * j]; const f32x4 y = v[j] * rs * w4;
            u32x2 o; o.x = pk2(y.x, y.y); o.y = pk2(y.z, y.w); o8[64 * j] = o;
            if (ROUTER) {
#pragma unroll
                for (int i = 0; i < 4; ++i) { const int k = 4 * (F.lane + 64 * j) + i; const int sw = (k >> 3) & 7; const f32x4 r0 = ((const LAS f32x4*)rl)[(2 * k) ^ sw], r1 = ((const LAS f32x4*)rl)[(2 * k + 1) ^ sw]; const float yy = y[i];
                    lg[0] += yy * r0.x; lg[1] += yy * r0.y; lg[2] += yy * r0.z; lg[3] += yy * r0.w; lg[4] += yy * r1.x; lg[5] += yy * r1.y; lg[6] += yy * r1.z; lg[7] += yy * r1.w; }
                asm volatile("" ::: "memory"); } }
        if (ROUTER) {
#pragma unroll
            for (int e = 0; e < NEXP; ++e) lg[e] = wave_sum(lg[e]);
            int i1 = 0; float l1 = lg[0];
#pragma unroll
            for (int e = 1; e < NEXP; ++e) if (lg[e] > l1) { l1 = lg[e]; i1 = e; }
            int i2 = -1; float l2 = -3.0e38f;
#pragma unroll
            for (int e = 0; e < NEXP; ++e) if (e != i1 && lg[e] > l2) { l2 = lg[e]; i2 = e; }
            const float g1 = 1.f / (1.f + __expf(l2 - l1)), g2 = 1.f - g1;
            if (F.lane == 0) { topi[2 * m] = i1; topi[2 * m + 1] = i2; topg[2 * m] = g1; topg[2 * m + 1] = g2; }
        }
    }
    if (ROUTER) __syncthreads();
}

typedef float f32x16 __attribute__((ext_vector_type(16)));
typedef short s16x4 __attribute__((ext_vector_type(4)));
#define MFMA32(a, b, c) __builtin_amdgcn_mfma_f32_32x32x16_bf16((a), (b), (c), 0, 0, 0)
constexpr float LOG2E = 1.4426950408889634f;
DI unsigned off_b(unsigned row, unsigned ch) { return 256u * row + 16u * (ch ^ (((row & 3) << 2) | ((row >> 2) & 3))); }
DI float xhalf_other(float x) { const int l = __builtin_amdgcn_mbcnt_hi(-1, __builtin_amdgcn_mbcnt_lo(-1, 0)); return __builtin_bit_cast(float, __builtin_amdgcn_ds_bpermute((l ^ 32) << 2, __builtin_bit_cast(int, x))); }
DI float xhalf_max(float x) { return fmaxf(x, xhalf_other(x)); }
DI float xhalf_sum(float x) { return x + xhalf_other(x); }
struct FaState { f32x16 acc[4]; float m, l; };
DI void fa_reset(FaState& st) {
#pragma unroll
    for (int d = 0; d < 4; ++d)
#pragma unroll
        for (int i = 0; i < 16; ++i) st.acc[d][i] = 0.f;
    st.m = -1e30f; st.l = 0.f; }
DI void fa_issue(const bf16_t* K, const bf16_t* V, size_t stride, int k0, LAS unsigned char* kb, LAS unsigned char* vb, int wave, int lane) {
#pragma unroll
    for (int i = 0; i < 2; ++i) { const int pos = (wave + 8 * i) * 64 + lane, row = pos >> 4, ch = (pos & 15) ^ (((row & 3) << 2) | ((row >> 2) & 3));
        const size_t o = (size_t)(k0 + row) * stride + ch * 8;
        dma16(K + o, kb + (wave + 8 * i) * 1024);
        dma16(V + o, vb + (wave + 8 * i) * 1024); } }
#define FA_LANDED() do { asm volatile("s_waitcnt vmcnt(0)" ::: "memory"); __syncthreads(); } while (0)
template <int MODE> DI void fa_tile(FaState& st, const LAS unsigned char* qf  , const LAS unsigned char* kb, const LAS unsigned char* vbuf, int kbase, int vb4, int h,
                                    int k0, int ka, int kc, int qp, int window, float sc2, float sl2, bool lanevalid) {
    f32x16 s0, s1;
#pragma unroll
    for (int i = 0; i < 16; ++i) { s0[i] = 0.f; s1[i] = 0.f; }
#pragma unroll
    for (int s = 0; s < 8; ++s) { const bf16x8 a0 = *(const LAS bf16x8*)(kb + (kbase ^ (32 * s))), a1 = *(const LAS bf16x8*)(kb + (kbase ^ (32 * s)) + 8192);
        const bf16x8 qv = *(const LAS bf16x8*)(qf + 1024 * s);
        s0 = MFMA32(a0, qv, s0); s1 = MFMA32(a1, qv, s1);
        }
    float x[32]; float mx = -1e30f;
    const int kp0 = ka * (k0 + 4 * h) + kc;
    const int qw = __builtin_amdgcn_readfirstlane(qp & ~31);
    if (qw >= ka * (k0 + 63) + kc && qw + 31 - (ka * k0 + kc) < window) {
        const float base = lanevalid ? -sl2 * (float)(qp - kp0) : -1e30f, tk = sl2 * (float)ka;
#pragma unroll
        for (int mt = 0; mt < 2; ++mt)
#pragma unroll
            for (int i = 0; i < 16; ++i) { const float sv = mt ? s1[i] : s0[i]; const float xv = __builtin_fmaf((float)(32 * mt + (i & 3) + 8 * (i >> 2)), tk, __builtin_fmaf(sv, sc2, base)); x[mt * 16 + i] = xv; mx = fmaxf(mx, xv); }
    } else {
#pragma unroll
        for (int mt = 0; mt < 2; ++mt)
#pragma unroll
            for (int i = 0; i < 16; ++i) { const int dist = qp - (kp0 + ka * (32 * mt + (i & 3) + 8 * (i >> 2))); const bool ok = lanevalid && dist >= 0 && dist < window;
                const float sv = mt ? s1[i] : s0[i]; const float xv = ok ? sv * sc2 - sl2 * (float)dist : -1e30f; x[mt * 16 + i] = xv; mx = fmaxf(mx, xv); }
    }
    if (MODE == 1) {
#pragma unroll
        for (int mt = 0; mt < 2; ++mt)
#pragma unroll
            for (int g4 = 0; g4 < 4; ++g4) { float pp[4];
#pragma unroll
                for (int e = 0; e < 4; ++e) { const float xv = x[mt * 16 + 4 * g4 + e]; pp[e] = xv > -1e29f ? exp2f(xv - st.m) * st.l : 0.f; }
                const float av = (pp[0] + pp[1]) + (pp[2] + 0.5f * pp[3]), bv = 0.5f * pp[3];
                if (k0 == 0) { st.acc[0][2 * (mt * 4 + g4)] = av; st.acc[0][2 * (mt * 4 + g4) + 1] = bv; } else { st.acc[1][2 * (mt * 4 + g4)] = av; st.acc[1][2 * (mt * 4 + g4) + 1] = bv; } }
        return;
    }
    mx = xhalf_max(mx);
    const float mn = fmaxf(st.m, mx), alpha = __builtin_amdgcn_exp2f(st.m - mn), mne = fmaxf(mn, -1e28f);
    float ls = 0.f;
#pragma unroll
    for (int i = 0; i < 32; ++i) { const float pv = __builtin_amdgcn_exp2f(x[i] - mne); x[i] = pv; ls += pv; }
    const bool moved = __builtin_amdgcn_ballot_w64(mn > st.m) != 0ull;
    st.l = st.l * alpha + ls; st.m = mn;
    if (moved) {
#pragma unroll
        for (int d = 0; d < 4; ++d)
#pragma unroll
            for (int i = 0; i < 16; ++i) st.acc[d][i] *= alpha;
    }
#pragma unroll
    for (int mt = 0; mt < 2; ++mt)
#pragma unroll
        for (int s2 = 0; s2 < 2; ++s2) {
            u32x4 pw; const int o = mt * 16 + 8 * s2;
            pw.x = cvt_pk_bf16(x[o + 0], x[o + 1]); pw.y = cvt_pk_bf16(x[o + 2], x[o + 3]); pw.z = cvt_pk_bf16(x[o + 4], x[o + 5]); pw.w = cvt_pk_bf16(x[o + 6], x[o + 7]);
            const bf16x8 pf = __builtin_bit_cast(bf16x8, pw);
#pragma unroll
            for (int dt = 0; dt < 4; ++dt) {
                const s16x4 t0 = __builtin_amdgcn_ds_read_tr16_b64_v4i16((LAS s16x4*)(vbuf + ((vb4 ^ (64 * dt)) + 8192 * mt + 4096 * s2)));
                const s16x4 t1 = __builtin_amdgcn_ds_read_tr16_b64_v4i16((LAS s16x4*)(vbuf + ((vb4 ^ (64 * dt + 32)) + 8192 * mt + 4096 * s2 + 2048)));
                const bf16x8 vf = {t0[0], t0[1], t0[2], t0[3], t1[0], t1[1], t1[2], t1[3]};
                st.acc[dt] = MFMA32(vf, pf, st.acc[dt]); }
        }
}
struct FaLane { int r, h, kbase, vb4; };
DI FaLane fa_lane(int lane) { FaLane L; L.r = lane & 31; L.h = lane >> 5;
    L.kbase = 256 * L.r + 16 * (L.h ^ (((L.r & 3) << 2) | ((L.r >> 2) & 3)));
    const int q = (lane & 15) >> 2, p = lane & 3, blk = (lane >> 4) & 1, lowx = (2 * blk + (p >> 1)) ^ L.h;
    L.vb4 = 1024 * L.h + 256 * q + 64 * q + 16 * lowx + 8 * (p & 1); return L; }

DI void swa_unit(Frame& F, const float* sinks, int u) {
    const int qt = u & 15, g = (u >> 4) & 1, b = u >> 5;
    int tid = F.tid; asm volatile("" : "+v"(tid)); const int lane = tid & 63, wave = __builtin_amdgcn_readfirstlane(tid >> 6);
    const FaLane L = fa_lane(lane);
    const bf16_t* proj = (const bf16_t*)(F.ws + WS_PROJ) + (size_t)b * SEQ * DINP;
    const int head = g * 2 + (wave >> 2), qp = 128 * qt + 32 * (wave & 3) + L.r;
    LAS unsigned char* buf = F.lds + LDS_SCR;
    LAS unsigned char* qf = F.lds + LDS_SCR + 65536 + wave * 8192 + lane * 16;
    { const bf16_t* qrow = proj + (size_t)qp * DINP + C_SQ + head * HD + 8 * L.h;
#pragma unroll
      for (int s = 0; s < 8; ++s) *(LAS bf16x8*)(qf + 1024 * s) = *(const bf16x8*)(qrow + 16 * s); }
    const float sl2 = exp2f(-(float)(head + 1)) * LOG2E, sc2 = QSCALE * LOG2E;
    const bf16_t* K = proj + C_SK + g * HD; const bf16_t* V = proj + C_SV + g * HD;
    FaState st; fa_reset(st);
    const int t_lo = 2 * qt - 2 > 0 ? 2 * qt - 2 : 0, t_hi = 2 * qt + 1;
    int cur = 0;
    fa_issue(K, V, DINP, 64 * t_hi, buf, buf + 16384, wave, lane);
    for (int t = t_hi; t >= t_lo; --t) {
        FA_LANDED();
        if (t > t_lo) fa_issue(K, V, DINP, 64 * (t - 1), buf + (cur ^ 1) * 32768, buf + (cur ^ 1) * 32768 + 16384, wave, lane);
        fa_tile<0>(st, qf, buf + cur * 32768, buf + cur * 32768 + 16384, L.kbase, L.vb4, L.h, 64 * t, 1, 0, qp, 128, sc2, sl2, true);
        cur ^= 1;
    }
    const float ltot = xhalf_sum(st.l) + exp2f(sinks[head] * LOG2E - st.m); const float inv = 1.f / ltot;
    bf16_t* orow = (bf16_t*)(F.ws + WS_MIX) + (size_t)(b * SEQ + qp) * DM + 1536 + head * HD + 4 * L.h;
#pragma unroll
    for (int dt = 0; dt < 4; ++dt)
#pragma unroll
        for (int g4 = 0; g4 < 4; ++g4) { u32x2 w; w.x = cvt_pk_bf16(st.acc[dt][4 * g4] * inv, st.acc[dt][4 * g4 + 1] * inv); w.y = cvt_pk_bf16(st.acc[dt][4 * g4 + 2] * inv, st.acc[dt][4 * g4 + 3] * inv);
            *(u32x2*)(orow + 32 * dt + 8 * g4) = w; }
    __syncthreads();
}

DI void nsa_unit(Frame& F, int u) {
    const int qt = 31 - (u & 31), b = u >> 5;
    int tid = F.tid; asm volatile("" : "+v"(tid)); const int lane = tid & 63, wave = __builtin_amdgcn_readfirstlane(tid >> 6);
    const FaLane L = fa_lane(lane);
    const bf16_t* proj = (const bf16_t*)(F.ws + WS_PROJ) + (size_t)b * SEQ * DINP;
    const int head = wave >> 1, ql = 32 * (wave & 1) + L.r, qp = 64 * qt + ql;
    LAS unsigned char* buf = F.lds + LDS_SCR;
    LAS unsigned char* qf = F.lds + LDS_SCR + 65536 + wave * 8192 + lane * 16;
    LAS float* imp = (LAS float*)(F.lds + LDS_SCR + 131072);
    LAS unsigned* selm = (LAS unsigned*)(F.lds + LDS_SCR + 131072 + 2 * 64 * 33 * 4);
    if (tid == 0) selm[64] = 0u;
    { const bf16_t* qrow = proj + (size_t)qp * DINP + C_NQ + head * HD + 8 * L.h;
#pragma unroll
      for (int s = 0; s < 8; ++s) *(LAS bf16x8*)(qf + 1024 * s) = *(const bf16x8*)(qrow + 16 * s); }
    const float sl2 = exp2f(-(float)(5 + head)) * LOG2E, sc2 = QSCALE * LOG2E;
    float* orow = (float*)(F.ws + WS_NSAO) + (size_t)(b * SEQ + qp) * 512 + head * HD + 4 * L.h;
    LAS float* impA = imp + (head * 64 + ql) * 33; LAS float* impB = impA + 4 * 64 * 33;
    FaState st; fa_reset(st);
    unsigned mysel = 0u; int cur = 0;
    const bf16_t gr0 = proj[(size_t)qp * DINP + C_NG + head], gr1 = proj[(size_t)qp * DINP + C_NG + 4 + head], gr2 = proj[(size_t)qp * DINP + C_NG + 8 + head];
    __syncthreads();
#pragma unroll 1
    for (int br = 0; br < 4; ++br) {
        const bool cmpb = br < 2;
        const bf16_t* K = cmpb ? (const bf16_t*)(F.ws + WS_KC) + (size_t)b * 128 * HD : proj + (br == 2 ? C_KSL : C_KW);
        const bf16_t* V = cmpb ? (const bf16_t*)(F.ws + WS_KC) + (size_t)(NB + b) * 128 * HD : proj + (br == 2 ? C_VSL : C_VW);
        const size_t stride = cmpb ? HD : DINP;
        const int ka = cmpb ? 16 : 1, kc = cmpb ? 31 : 0, window = br == 3 ? 512 : (1 << 30);
        unsigned tmask;
        if (cmpb) tmask = (4 * qt + 3 > 64) ? 3u : 1u;
        else if (br == 2) tmask = selm[64];
        else { const int lo = qt - 8 > 0 ? qt - 8 : 0; tmask = (qt == 31 ? 0xFFFFFFFFu : ((1u << (qt + 1)) - 1u)) & ~((1u << lo) - 1u); }
        tmask = __builtin_amdgcn_readfirstlane(tmask);
        if (tmask) fa_issue(K, V, stride, 64 * (31 - __builtin_clz(tmask)), buf + cur * 32768, buf + cur * 32768 + 16384, wave, lane);
        while (tmask) {
            const int j = 31 - __builtin_clz(tmask); tmask &= ~(1u << j);
            FA_LANDED();
            if (tmask) fa_issue(K, V, stride, 64 * (31 - __builtin_clz(tmask)), buf + (cur ^ 1) * 32768, buf + (cur ^ 1) * 32768 + 16384, wave, lane);
            const bool lv = br == 2 ? ((mysel >> j) & 1u) != 0u : true;
            if (br == 1) fa_tile<1>(st, qf, buf + cur * 32768, buf + cur * 32768 + 16384, L.kbase, L.vb4, L.h, 64 * j, ka, kc, qp, window, sc2, sl2, lv);
            else fa_tile<0>(st, qf, buf + cur * 32768, buf + cur * 32768 + 16384, L.kbase, L.vb4, L.h, 64 * j, ka, kc, qp, window, sc2, sl2, lv);
            cur ^= 1;
        }
        if (br == 1) {
#pragma unroll 1
            for (int hd = 0; hd < 4; ++hd) {
                if (head == hd) { LAS float* ia = imp + ql * 33; LAS float* ib = ia + 64 * 33;
#pragma unroll
                    for (int tl = 0; tl < 2; ++tl)
#pragma unroll
                        for (int g = 0; g < 8; ++g) { const int j = 16 * tl + 2 * g + L.h; const float av = st.acc[tl][2 * g], bv = st.acc[tl][2 * g + 1];
                            if (hd == 0) { ia[j] = av; ib[j + 1] = bv; } else { ia[j] += av; ib[j + 1] += bv; } }
                    if (hd == 0 && L.h == 0) ib[0] = 0.f; }
                __syncthreads();
            }
            if (tid < 64) {
                float sc[32];
                int qv = qt; asm volatile("" : "+v"(qv));
#pragma unroll
                for (int j = 0; j < 32; ++j) { float a = 0.f;
                    a = imp[tid * 33 + j] + imp[64 * 33 + tid * 33 + j];
                    const bool forced = (j == 0) || (j == qv) || (j == qv - 1);
                    sc[j] = (j <= qv) ? a + (forced ? 1000.f : 0.f) : -1.f; }
                unsigned m = 0u;
#pragma unroll 1
                for (int r = 0; r < 8; ++r) { float best = sc[0]; int bi = 0;
#pragma unroll
                    for (int j = 1; j < 32; ++j) if (sc[j] > best) { best = sc[j]; bi = j; }
                    if (best >= 0.f) m |= 1u << bi;
#pragma unroll
                    for (int j = 0; j < 32; ++j) sc[j] = (j == bi) ? -3.f : sc[j]; }
                selm[tid] = m; atomicOr((unsigned*)(selm + 64), m);
            }
            __syncthreads();
            mysel = selm[ql];
            fa_reset(st);
            continue;
        }
        const float ltot = xhalf_sum(st.l); const float inv = ltot > 0.f ? 1.f / ltot : 0.f;
        const int gi = br == 0 ? 0 : br - 1;
        const float gate = sigmoidf_(bf2f(gi == 0 ? gr0 : gi == 1 ? gr1 : gr2)) * inv;
        if (br == 0) {
#pragma unroll
            for (int dt = 0; dt < 4; ++dt)
#pragma unroll
                for (int g4 = 0; g4 < 4; ++g4) { f32x4 o; o.x = st.acc[dt][4 * g4] * gate; o.y = st.acc[dt][4 * g4 + 1] * gate; o.z = st.acc[dt][4 * g4 + 2] * gate; o.w = st.acc[dt][4 * g4 + 3] * gate;
                    *(f32x4*)(orow + 32 * dt + 8 * g4) = o; }
            st.l = inv;
#pragma unroll
            for (int d = 0; d < 4; ++d)
#pragma unroll
                for (int i = 0; i < 16; ++i) st.acc[d][i] = 0.f;
        } else if (br == 2) {
#pragma unroll
            for (int dt = 0; dt < 4; ++dt)
#pragma unroll
                for (int g4 = 0; g4 < 4; ++g4) { f32x4 o = *(const f32x4*)(orow + 32 * dt + 8 * g4); o.x += st.acc[dt][4 * g4] * gate; o.y += st.acc[dt][4 * g4 + 1] * gate; o.z += st.acc[dt][4 * g4 + 2] * gate; o.w += st.acc[dt][4 * g4 + 3] * gate;
                    *(f32x4*)(orow + 32 * dt + 8 * g4) = o; }
            fa_reset(st);
        } else {
            bf16_t* mrow = (bf16_t*)(F.ws + WS_MIX) + (size_t)(b * SEQ + qp) * DM + head * HD + 4 * L.h;
#pragma unroll
            for (int dt = 0; dt < 4; ++dt)
#pragma unroll
                for (int g4 = 0; g4 < 4; ++g4) { const f32x4 o = *(const f32x4*)(orow + 32 * dt + 8 * g4);
                    u32x2 w; w.x = cvt_pk_bf16(o.x + st.acc[dt][4 * g4] * gate, o.y + st.acc[dt][4 * g4 + 1] * gate); w.y = cvt_pk_bf16(o.z + st.acc[dt][4 * g4 + 2] * gate, o.w + st.acc[dt][4 * g4 + 3] * gate);
                    *(u32x2*)(mrow + 32 * dt + 8 * g4) = w; }
        }
    }
    __syncthreads();
}

DI void cmp_unit_mfma(Frame& F, int u, int layer, const float* posk, const float* posv) {
    const int mt = u & 3, b = (u >> 2) & 3, kv = u >> 4;
    int tid = F.tid; asm volatile("" : "+v"(tid)); const int lane = tid & 63, wave = __builtin_amdgcn_readfirstlane(tid >> 6), r = lane & 31, hh = lane >> 5;
    const bf16_t* proj = (const bf16_t*)(F.ws + WS_PROJ) + (size_t)b * SEQ * DINP + (kv ? C_VC : C_KC);
    const bf16_t* w1t = (const bf16_t*)(F.ws + WS_CW1) + (size_t)(layer * 2 + kv) * 256 * 4096;
    const bf16_t* w2t = (const bf16_t*)(F.ws + WS_CW2) + (size_t)(layer * 2 + kv) * HD * 256;
    const float* pos = kv ? posv : posk;
    LAS unsigned char* bufs = F.lds + LDS_SCR;
    const int srow = tid >> 4, sch = tid & 15;
    const int tokb = 16 * (32 * mt + srow);
    const unsigned sslot = (unsigned)srow * 256u + (unsigned)((sch ^ (srow & 15)) * 16);
    u32x4 pa;
#define CMP_LOADA(j) do { const int tk_ = tokb + (j) < SEQ ? tokb + (j) : SEQ - 1; pa = *(const u32x4*)(proj + (size_t)tk_ * DINP + 8 * sch); } while (0)
#define CMP_ISSUEB(j, bb_) do { _Pragma("unroll") for (int i_ = 0; i_ < 8; ++i_) { const int pc_ = wave + 8 * i_, row_ = 4 * pc_ + (lane >> 4), ch_ = (lane & 15) ^ (row_ & 15); \
        dma16(w1t + (size_t)row_ * 4096 + (j) * 128 + 8 * ch_, (bb_) + pc_ * 1024); } } while (0)
    CMP_LOADA(0); CMP_ISSUEB(0, bufs + 8192);
    f32x16 acc;
#pragma unroll
    for (int i = 0; i < 16; ++i) acc[i] = 0.f;
#pragma unroll 1
    for (int j = 0; j < 32; ++j) {
        LAS unsigned char* ab = bufs + (j & 1) * 73728; LAS unsigned char* bb = ab + 8192;
        { const f32x4 p0 = *(const f32x4*)(pos + j * 128 + 8 * sch), p1 = *(const f32x4*)(pos + j * 128 + 8 * sch + 4);
          u32x4 aw; aw.x = cvt_pk_bf16(bflo(pa.x) + p0.x, bfhi(pa.x) + p0.y); aw.y = cvt_pk_bf16(bflo(pa.y) + p0.z, bfhi(pa.y) + p0.w);
          aw.z = cvt_pk_bf16(bflo(pa.z) + p1.x, bfhi(pa.z) + p1.y); aw.w = cvt_pk_bf16(bflo(pa.w) + p1.z, bfhi(pa.w) + p1.w);
          *(LAS u32x4*)(ab + sslot) = aw; }
        FA_LANDED();
        if (j < 31) { CMP_LOADA(j + 1); CMP_ISSUEB(j + 1, bufs + ((j + 1) & 1) * 73728 + 8192); }
#pragma unroll
        for (int s = 0; s < 8; ++s) { const bf16x8 a = *(const LAS bf16x8*)(ab + r * 256 + (((2 * s + hh) ^ (r & 15)) * 16)); const bf16x8 bw = *(const LAS bf16x8*)(bb + (32 * wave + r) * 256 + (((2 * s + hh) ^ (r & 15)) * 16));
            acc = MFMA32(a, bw, acc); }
    }
#undef CMP_LOADA
#undef CMP_ISSUEB
    __syncthreads();
    LAS unsigned char* h1 = bufs;
    { const int o = 32 * wave + r;
#pragma unroll
      for (int i = 0; i < 16; ++i) { const int nl = (i & 3) + 8 * (i >> 2) + 4 * hh; *(LAS bf16_t*)(h1 + nl * 512 + (((o >> 3) ^ (nl & 15)) * 16) + (o & 7) * 2) = (bf16_t)f2bf(siluf_(acc[i])); } }
    __syncthreads();
    if (wave < 4) {
        f32x16 a2;
#pragma unroll
        for (int i = 0; i < 16; ++i) a2[i] = 0.f;
        const bf16_t* b2 = w2t + (size_t)(32 * wave + r) * 256 + 8 * hh;
#pragma unroll
        for (int s = 0; s < 16; ++s) { const bf16x8 a = *(const LAS bf16x8*)(h1 + r * 512 + (((2 * s + hh) ^ (r & 15)) * 16)); const bf16x8 bb2 = *(const bf16x8*)(b2 + 16 * s); a2 = MFMA32(a, bb2, a2); }
        bf16_t* outb = (bf16_t*)(F.ws + WS_KC) + ((size_t)(kv * NB + b) * 128) * HD + 32 * wave + r;
#pragma unroll
        for (int i = 0; i < 16; ++i) { const int n = 32 * mt + (i & 3) + 8 * (i >> 2) + 4 * hh; outb[(size_t)n * HD] = (bf16_t)(n < 127 ? f2bf(a2[i]) : 0u); }
    }
    __syncthreads();
}

#define MFMA16(a, b, c) __builtin_amdgcn_mfma_f32_16x16x32_bf16((a), (b), (c), 0, 0, 0)
DI float row16_sum(float v) { v += DPPF(v, 0xB1); v += DPPF(v, 0x4E); v += DPPF(v, 0x141); v += DPPF(v, 0x140); return v; }
DI void gdn_chunk_mfma(Frame& F, int u, const float* cw, const float* alog, const float* dtb) {
    const int n = u & 31, h = (u >> 5) & 7, b = u >> 8, bh = b * NGH + h, t0 = n * 64;
    int tid = F.tid; asm volatile("" : "+v"(tid)); const int lane = tid & 63, wave = __builtin_amdgcn_readfirstlane(tid >> 6);
    const bf16_t* proj = (const bf16_t*)(F.ws + WS_PROJ) + (size_t)b * SEQ * DINP;
    LAS float* kf = (LAS float*)(F.lds + LDS_SCR);
    LAS float* vf = kf + 64 * 132;
    LAS float* Ls = vf + 64 * 132;
    LAS unsigned char* qb = (LAS unsigned char*)(Ls + 64 * 68);
    LAS unsigned char* kb = qb + 16384;
    LAS float* gcs = (LAS float*)(kb + 16384);
    LAS float* bts = gcs + 64;
    LAS float* egs = bts + 64;
    LAS float* sc1 = egs + 64;
    const size_t cidx = (size_t)bh * 32 + n;
    unsigned char* gW = F.ws + WS_GW + cidx * 57344; unsigned char* gQ = gW + 16384; unsigned char* gK = gW + 32768; unsigned char* gA = gW + 49152;
    float* gU = (float*)(F.ws + WS_GU_) + cidx * 8192;
    const int ch = tid & 15, sg = (tid >> 4) & 7, mat = tid >> 7;
    float w[4][8]; u32x4 rows[8], rp[3] = {{0u, 0u, 0u, 0u}, {0u, 0u, 0u, 0u}, {0u, 0u, 0u, 0u}};
    if (tid < 384) {
        const int col = (mat == 0 ? C_GQ : mat == 1 ? C_GK : C_GV) + h * HD + 8 * ch;
#pragma unroll
        for (int j = 0; j < 4; ++j) { const f32x4 a = *(const f32x4*)(cw + j * 3072 + mat * 1024 + h * HD + 8 * ch), c = *(const f32x4*)(cw + j * 3072 + mat * 1024 + h * HD + 8 * ch + 4);
            w[j][0] = a.x; w[j][1] = a.y; w[j][2] = a.z; w[j][3] = a.w; w[j][4] = c.x; w[j][5] = c.y; w[j][6] = c.z; w[j][7] = c.w; }
        const int tb = t0 + 8 * sg;
        if (tb - 3 >= 0) rp[0] = *(const u32x4*)(proj + (size_t)(tb - 3) * DINP + col);
        if (tb - 2 >= 0) rp[1] = *(const u32x4*)(proj + (size_t)(tb - 2) * DINP + col);
        if (tb - 1 >= 0) rp[2] = *(const u32x4*)(proj + (size_t)(tb - 1) * DINP + col);
#pragma unroll
        for (int ii = 0; ii < 8; ++ii) rows[ii] = *(const u32x4*)(proj + (size_t)(tb + ii) * DINP + col);
    }
    if (tid < 64) {
        const bf16_t* pr = proj + (size_t)(t0 + tid) * DINP;
        const float a = bf2f(pr[C_GA + h]), bb = bf2f(pr[C_GB + h]);
        float g = -__expf(alog[h]) * softplusf_(a + dtb[h]);
        g += DPPF(g, 0x111); g += DPPF(g, 0x112); g += DPPF(g, 0x114); g += DPPF(g, 0x118);
        { const float r0 = __builtin_bit_cast(float, __builtin_amdgcn_readlane(__builtin_bit_cast(int, g), 15)), r1 = __builtin_bit_cast(float, __builtin_amdgcn_readlane(__builtin_bit_cast(int, g), 31)),
                      r2 = __builtin_bit_cast(float, __builtin_amdgcn_readlane(__builtin_bit_cast(int, g), 47));
          g += (lane >= 48) ? (r0 + r1) + r2 : (lane >= 32) ? r0 + r1 : (lane >= 16) ? r0 : 0.f; }
        const float be = sigmoidf_(bb), eg = __expf(g);
        gcs[tid] = g; bts[tid] = be; egs[tid] = eg; sc1[tid] = be * eg;
    }
    __syncthreads();
    const float gl = gcs[63];
    if (tid < 384) {
        float x0[8] = {bflo(rp[0].x), bfhi(rp[0].x), bflo(rp[0].y), bfhi(rp[0].y), bflo(rp[0].z), bfhi(rp[0].z), bflo(rp[0].w), bfhi(rp[0].w)};
        float x1[8] = {bflo(rp[1].x), bfhi(rp[1].x), bflo(rp[1].y), bfhi(rp[1].y), bflo(rp[1].z), bfhi(rp[1].z), bflo(rp[1].w), bfhi(rp[1].w)};
        float x2[8] = {bflo(rp[2].x), bfhi(rp[2].x), bflo(rp[2].y), bfhi(rp[2].y), bflo(rp[2].z), bfhi(rp[2].z), bflo(rp[2].w), bfhi(rp[2].w)};
#pragma unroll
        for (int ii = 0; ii < 8; ++ii) {
            const int i = 8 * sg + ii;
            const u32x4 r = rows[ii];
            float x3[8] = {bflo(r.x), bfhi(r.x), bflo(r.y), bfhi(r.y), bflo(r.z), bfhi(r.z), bflo(r.w), bfhi(r.w)};
            float y[8]; float ss = 0.f;
#pragma unroll
            for (int e = 0; e < 8; ++e) { y[e] = siluf_(x0[e] * w[0][e] + x1[e] * w[1][e] + x2[e] * w[2][e] + x3[e] * w[3][e]); ss += y[e] * y[e]; x0[e] = x1[e]; x1[e] = x2[e]; x2[e] = x3[e]; }
            ss = row16_sum(ss);
            const unsigned slot = (unsigned)i * 256u + (unsigned)((ch ^ (i & 15)) * 16);
            if (mat == 0) { const float sc = rsqrtf(ss + EPS) * QSCALE, eg = egs[i];
                u32x4 o, od; o.x = cvt_pk_bf16(y[0] * sc, y[1] * sc); o.y = cvt_pk_bf16(y[2] * sc, y[3] * sc); o.z = cvt_pk_bf16(y[4] * sc, y[5] * sc); o.w = cvt_pk_bf16(y[6] * sc, y[7] * sc);
                const float s2 = sc * eg; od.x = cvt_pk_bf16(y[0] * s2, y[1] * s2); od.y = cvt_pk_bf16(y[2] * s2, y[3] * s2); od.z = cvt_pk_bf16(y[4] * s2, y[5] * s2); od.w = cvt_pk_bf16(y[6] * s2, y[7] * s2);
                *(LAS u32x4*)(qb + slot) = o;
                { const int dc = 4 * (ch >> 2) + 2 * (ch & 1), hb = 8 * ((ch & 3) >> 1);
                  *(u32x2*)(gQ + (unsigned)i * 256u + (unsigned)(((dc) ^ (i & 15)) * 16 + hb)) = (u32x2){od.x, od.y}; *(u32x2*)(gQ + (unsigned)i * 256u + (unsigned)(((dc + 1) ^ (i & 15)) * 16 + hb)) = (u32x2){od.z, od.w}; }
            } else if (mat == 1) { const float sc = rsqrtf(ss + EPS);
                u32x4 o; o.x = cvt_pk_bf16(y[0] * sc, y[1] * sc); o.y = cvt_pk_bf16(y[2] * sc, y[3] * sc); o.z = cvt_pk_bf16(y[4] * sc, y[5] * sc); o.w = cvt_pk_bf16(y[6] * sc, y[7] * sc);
                *(LAS u32x4*)(kb + slot) = o;
                *(LAS f32x4*)(kf + i * 132 + 8 * ch) = (f32x4){y[0] * sc, y[1] * sc, y[2] * sc, y[3] * sc}; *(LAS f32x4*)(kf + i * 132 + 8 * ch + 4) = (f32x4){y[4] * sc, y[5] * sc, y[6] * sc, y[7] * sc};
            } else {
                *(LAS f32x4*)(vf + i * 132 + 8 * ch) = (f32x4){y[0], y[1], y[2], y[3]}; *(LAS f32x4*)(vf + i * 132 + 8 * ch + 4) = (f32x4){y[4], y[5], y[6], y[7]}; }
        }
    }
    __syncthreads();
    {
        const int ti = (wave >> 1) & 1, tj = wave & 1, r = lane & 31, hh = lane >> 5;
        const LAS unsigned char* ab = (wave < 4) ? kb : qb;
        f32x16 c;
#pragma unroll
        for (int i = 0; i < 16; ++i) c[i] = 0.f;
        const int ra = 32 * ti + r, rb = 32 * tj + r;
#pragma unroll
        for (int s = 0; s < 8; ++s) { const bf16x8 a = *(const LAS bf16x8*)(ab + ra * 256 + (((2 * s + hh) ^ (ra & 15)) * 16)), bb = *(const LAS bf16x8*)(kb + rb * 256 + (((2 * s + hh) ^ (rb & 15)) * 16));
            c = MFMA32(a, bb, c); }
        const int j = 32 * tj + r; const float gcj = gcs[j];
#pragma unroll
        for (int rg = 0; rg < 16; ++rg) { const int i = 32 * ti + (rg & 3) + 8 * (rg >> 2) + 4 * hh; const float dec = __expf(fminf(gcs[i] - gcj, 0.f));
            if (wave < 4) Ls[i * 68 + j] = (j < i) ? bts[i] * c[rg] * dec : 0.f;
            else { const float av = (j <= i) ? c[rg] * dec : 0.f; const int jp = (j & 32) + 8 * ((j >> 2) & 3) + 4 * ((j >> 4) & 1) + (j & 3);
                *(bf16_t*)(gA + (size_t)(i * 8 + ((jp >> 3) ^ ((i >> 1) & 7))) * 16 + (jp & 7) * 2) = (bf16_t)f2bf(av); } }
    }
    for (int x = tid; x < 1024; x += 512) { const int k = x >> 3, ch = x & 7; float v8[8];
#pragma unroll
        for (int e = 0; e < 8; ++e) { const int c = 8 * ch + e; v8[e] = kf[c * 132 + k] * __expf(gl - gcs[c]); }
        u32x4 o; o.x = cvt_pk_bf16(v8[0], v8[1]); o.y = cvt_pk_bf16(v8[2], v8[3]); o.z = cvt_pk_bf16(v8[4], v8[5]); o.w = cvt_pk_bf16(v8[6], v8[7]);
        { const int dc = 4 * (ch >> 2) + 2 * (ch & 1), hb = 8 * ((ch & 3) >> 1);
          *(u32x2*)(gK + (unsigned)k * 128u + (unsigned)(((dc) ^ ((k >> 1) & 7)) * 16 + hb)) = (u32x2){o.x, o.y}; *(u32x2*)(gK + (unsigned)k * 128u + (unsigned)(((dc + 1) ^ ((k >> 1) & 7)) * 16 + hb)) = (u32x2){o.z, o.w}; } }
    if (tid == 0) ((float*)(F.ws + WS_GGL))[cidx] = __expf(gl);
    __syncthreads();
    LAS unsigned char* loff = (LAS unsigned char*)(sc1 + 64);
    LAS unsigned char* dinv = loff + 8192;
    { const int r = tid >> 3, cq = tid & 7, s2 = cq >> 2, qq = cq & 3;
      const f32x4 a = *(const LAS f32x4*)(Ls + r * 68 + 32 * s2 + 4 * qq), bq = *(const LAS f32x4*)(Ls + r * 68 + 32 * s2 + 16 + 4 * qq);
      const bool k0 = (2 * s2) < (r >> 4), k1 = (2 * s2 + 1) < (r >> 4);
      u32x4 o; o.x = k0 ? cvt_pk_bf16(-a.x, -a.y) : 0u; o.y = k0 ? cvt_pk_bf16(-a.z, -a.w) : 0u; o.z = k1 ? cvt_pk_bf16(-bq.x, -bq.y) : 0u; o.w = k1 ? cvt_pk_bf16(-bq.z, -bq.w) : 0u;
      *(LAS u32x4*)(loff + r * 128 + ((cq ^ ((r >> 1) & 7)) * 16)) = o;
      if (tid < 256) ((LAS u32x4*)dinv)[tid] = (u32x4){0u, 0u, 0u, 0u}; }
    __syncthreads();
    if (tid < 64) {
        const int bk = tid >> 4, j = tid & 15; float t[16];
#pragma unroll
        for (int i = 0; i < 16; ++i) { float a = (i == j) ? 1.f : 0.f;
#pragma unroll
            for (int k = 0; k < i; ++k) a -= Ls[(16 * bk + i) * 68 + 16 * bk + k] * t[k];
            t[i] = (i < j) ? 0.f : a; }
#pragma unroll
        for (int i = 0; i < 16; ++i) *(LAS bf16_t*)(dinv + (16 * bk + i) * 64 + 16 * (j >> 2) + 2 * (j & 3)) = (bf16_t)f2bf(t[i]);
    }
    __syncthreads();
    {
        const int nn = lane & 15, q = lane >> 4;
        const LAS float* srcm = (wave < 4) ? vf : kf; const LAS float* scl = (wave < 4) ? bts : sc1; const int cb = 32 * (wave & 3);
        f32x4 X[4][2];
#pragma unroll
        for (int bk = 0; bk < 4; ++bk)
#pragma unroll
            for (int nt = 0; nt < 2; ++nt)
#pragma unroll
                for (int i = 0; i < 4; ++i) { const int row = 16 * bk + 4 * q + i; X[bk][nt][i] = scl[row] * srcm[row * 132 + cb + 16 * nt + nn]; }
        const f32x4 z4 = {0.f, 0.f, 0.f, 0.f};
#pragma unroll
        for (int bk = 0; bk < 4; ++bk) {
#pragma unroll
            for (int nt = 0; nt < 2; ++nt) {
                f32x4 r = X[bk][nt];
#pragma unroll
                for (int s2 = 0; s2 < 2; ++s2) if (2 * s2 < bk) {
                    const int row = 16 * bk + nn; const bf16x8 lf = *(const LAS bf16x8*)(loff + row * 128 + (((4 * s2 + q) ^ ((row >> 1) & 7)) * 16));
                    const f32x4 xa = X[2 * s2][nt], xb = X[2 * s2 + 1][nt];
                    u32x4 pw; pw.x = cvt_pk_bf16(xa[0], xa[1]); pw.y = cvt_pk_bf16(xa[2], xa[3]); pw.z = cvt_pk_bf16(xb[0], xb[1]); pw.w = cvt_pk_bf16(xb[2], xb[3]);
                    r = MFMA16(lf, __builtin_bit_cast(bf16x8, pw), r); }
                const bf16x8 df = *(const LAS bf16x8*)(dinv + (16 * bk + nn) * 64 + q * 16);
                u32x4 pr; pr.x = cvt_pk_bf16(r[0], r[1]); pr.y = cvt_pk_bf16(r[2], r[3]); pr.z = 0u; pr.w = 0u;
                X[bk][nt] = MFMA16(df, __builtin_bit_cast(bf16x8, pr), z4);
            }
        }
        if (wave < 4) {
#pragma unroll
            for (int bk = 0; bk < 4; ++bk)
#pragma unroll
                for (int nt = 0; nt < 2; ++nt) *(f32x4*)(gU + ((size_t)(((2 * wave + nt) * 4 + bk) * 64 + lane)) * 4) = X[bk][nt];
        } else {
#pragma unroll
            for (int bk = 0; bk < 4; ++bk)
#pragma unroll
                for (int nt = 0; nt < 2; ++nt)
#pragma unroll
                    for (int i = 0; i < 4; ++i) kf[(16 * bk + 4 * q + i) * 132 + cb + 16 * nt + nn] = X[bk][nt][i];
        }
    }
    __syncthreads();
    for (int x = tid; x < 1024; x += 512) { const int c = x >> 4, ch = x & 15; const f32x4 a = *(const LAS f32x4*)(kf + c * 132 + 8 * ch), bq = *(const LAS f32x4*)(kf + c * 132 + 8 * ch + 4);
        u32x4 o; o.x = cvt_pk_bf16(a.x, a.y); o.y = cvt_pk_bf16(a.z, a.w); o.z = cvt_pk_bf16(bq.x, bq.y); o.w = cvt_pk_bf16(bq.z, bq.w);
        { const int dc = 4 * (ch >> 2) + 2 * (ch & 1), hb = 8 * ((ch & 3) >> 1);
          *(u32x2*)(gW + (unsigned)c * 256u + (unsigned)(((dc) ^ (c & 15)) * 16 + hb)) = (u32x2){o.x, o.y}; *(u32x2*)(gW + (unsigned)c * 256u + (unsigned)(((dc + 1) ^ (c & 15)) * 16 + hb)) = (u32x2){o.z, o.w}; } }
    __syncthreads();
}

DI void gdn_scan_mfma(Frame& F, int su) {
    const int bh = su >> 1, vh = su & 1, b = bh >> 3, h = bh & 7;
    int tid = F.tid; asm volatile("" : "+v"(tid)); const int lane = tid & 63, wave = __builtin_amdgcn_readfirstlane(tid >> 6);
    const int nn = lane & 15, q = lane >> 4;
    LAS unsigned char* buf = F.lds + LDS_SCR;
    const unsigned char* gC = F.ws + WS_GW + (size_t)bh * 32 * 57344;
    const float* gU = (const float*)(F.ws + WS_GU_) + (size_t)bh * 32 * 8192; const float* GL = (const float*)(F.ws + WS_GGL) + bh * 32;
    const int w8 = 4 * vh + (wave & 3);
    const bool active = wave < 4;
    float* Og = (float*)(F.ws + WS_GO) + (size_t)b * SEQ * 1024 + h * HD + 16 * w8 + 4 * q;
#define GDN_ISSUE(nchunk, bufp) do { if (!active) { const unsigned char* sb_ = gC + (size_t)(nchunk) * 57344 + (wave - 4) * 14336; LAS unsigned char* lb_ = (bufp) + (wave - 4) * 14336; \
        _Pragma("unroll") for (int pi = 0; pi < 14; ++pi) dma16s(sb_ + pi * 1024, (unsigned)lane * 16u, lb_ + pi * 1024); \
        const unsigned char* su_ = (const unsigned char*)(gU + (size_t)(nchunk) * 8192 + vh * 4096) + (wave - 4) * 4096; LAS unsigned char* lu_ = (bufp) + 57344 + (wave - 4) * 4096; \
        _Pragma("unroll") for (int pi = 0; pi < 4; ++pi) dma16s(su_ + pi * 1024, (unsigned)lane * 16u, lu_ + pi * 1024); } } while (0)
    f32x4 S[8];
#pragma unroll
    for (int a = 0; a < 8; ++a) S[a] = (f32x4){0.f, 0.f, 0.f, 0.f};
    const int m = nn;
    GDN_ISSUE(0, buf);
    f32x4 Oprev[4]; const float glv = GL[lane & 31];
#pragma unroll
    for (int t = 0; t < 4; ++t) Oprev[t] = (f32x4){0.f, 0.f, 0.f, 0.f};
    int cur = 0;
#pragma unroll 1
    for (int n = 0; n < 32; ++n) {
        FA_LANDED();
        if (n < 31) GDN_ISSUE(n + 1, buf + (cur ^ 1) * 73728);
        const LAS unsigned char* lw = buf + cur * 73728; const LAS unsigned char* lq = lw + 16384; const LAS unsigned char* lk = lw + 32768; const LAS unsigned char* la = lw + 49152;
        if (active) {
        if (n > 0) {
#pragma unroll
            for (int t = 0; t < 4; ++t) *(f32x4*)(Og + (size_t)(64 * (n - 1) + 16 * t + nn) * 1024) = Oprev[t]; }
        f32x4 U[4];
#pragma unroll
        for (int t = 0; t < 4; ++t) U[t] = *(const LAS f32x4*)(lw + 57344 + ((wave & 3) * 4 + t) * 1024 + lane * 16);
        const float gl = __builtin_bit_cast(float, __builtin_amdgcn_readlane(__builtin_bit_cast(int, glv), n));
        bf16x8 Sb[4];
#pragma unroll
        for (int s = 0; s < 4; ++s) { u32x4 pw; pw.x = cvt_pk_bf16(S[2 * s][0], S[2 * s][1]); pw.y = cvt_pk_bf16(S[2 * s][2], S[2 * s][3]); pw.z = cvt_pk_bf16(S[2 * s + 1][0], S[2 * s + 1][1]); pw.w = cvt_pk_bf16(S[2 * s + 1][2], S[2 * s + 1][3]);
            Sb[s] = __builtin_bit_cast(bf16x8, pw); }
#define GF256(base, row, s_) (*(const LAS bf16x8*)((base) + (unsigned)(row) * 256u + (unsigned)(((4 * (s_) + q) ^ ((row) & 15)) * 16)))
#define GF128(base, row, s_) (*(const LAS bf16x8*)((base) + (unsigned)(row) * 128u + (unsigned)(((4 * (s_) + q) ^ (((row) >> 1) & 7)) * 16)))
#define GSB() __builtin_amdgcn_sched_barrier(0)
        bf16x8 F0[8], F1[8];
        f32x4 T1[4], T2[4];
#pragma unroll
        for (int t = 0; t < 4; ++t) { T1[t] = (f32x4){0.f, 0.f, 0.f, 0.f}; T2[t] = (f32x4){0.f, 0.f, 0.f, 0.f}; }
#pragma unroll
        for (int i = 0; i < 8; ++i) F0[i] = GF256(lw, 16 * (i >> 2) + m, i & 3);
        GSB();
#pragma unroll
        for (int i = 0; i < 8; ++i) F1[i] = GF256(lw, 16 * (2 + (i >> 2)) + m, i & 3);
        GSB();
#pragma unroll
        for (int i = 0; i < 8; ++i) T1[i >> 2] = MFMA16(F0[i], Sb[i & 3], T1[i >> 2]);
        GSB();
#pragma unroll
        for (int i = 0; i < 8; ++i) F0[i] = GF128(lk, 16 * (i >> 1) + m, i & 1);
        GSB();
#pragma unroll
        for (int i = 0; i < 8; ++i) T1[2 + (i >> 2)] = MFMA16(F1[i], Sb[i & 3], T1[2 + (i >> 2)]);
        GSB();
        bf16x8 vb[2];
#pragma unroll
        for (int s2 = 0; s2 < 2; ++s2) { const f32x4 v0 = U[2 * s2] - T1[2 * s2], v1 = U[2 * s2 + 1] - T1[2 * s2 + 1];
            u32x4 pw; pw.x = cvt_pk_bf16(v0[0], v0[1]); pw.y = cvt_pk_bf16(v0[2], v0[3]); pw.z = cvt_pk_bf16(v1[0], v1[1]); pw.w = cvt_pk_bf16(v1[2], v1[3]); vb[s2] = __builtin_bit_cast(bf16x8, pw); }
#pragma unroll
        for (int i = 0; i < 8; ++i) F1[i] = GF128(lk, 16 * (4 + (i >> 1)) + m, i & 1);
        GSB();
#pragma unroll
        for (int a = 0; a < 8; ++a) S[a] = S[a] * gl;
#pragma unroll
        for (int i = 0; i < 8; ++i) S[i >> 1] = MFMA16(F0[i], vb[i & 1], S[i >> 1]);
        GSB();
#pragma unroll
        for (int i = 0; i < 8; ++i) F0[i] = GF256(lq, 16 * (i >> 2) + m, i & 3);
        GSB();
#pragma unroll
        for (int i = 0; i < 8; ++i) S[4 + (i >> 1)] = MFMA16(F1[i], vb[i & 1], S[4 + (i >> 1)]);
        GSB();
#pragma unroll
        for (int i = 0; i < 8; ++i) F1[i] = GF256(lq, 16 * (2 + (i >> 2)) + m, i & 3);
        GSB();
#pragma unroll
        for (int i = 0; i < 8; ++i) T2[i >> 2] = MFMA16(Sb[i & 3], F0[i], T2[i >> 2]);
        GSB();
#pragma unroll
        for (int i = 0; i < 8; ++i) F0[i] = GF128(la, 16 * (i >> 1) + m, i & 1);
        GSB();
#pragma unroll
        for (int i = 0; i < 8; ++i) T2[2 + (i >> 2)] = MFMA16(Sb[i & 3], F1[i], T2[2 + (i >> 2)]);
        GSB();
#pragma unroll
        for (int i = 0; i < 8; ++i) T2[i >> 1] = MFMA16(vb[i & 1], F0[i], T2[i >> 1]);
#undef GF256
#undef GF128
#undef GSB
#pragma unroll
        for (int t = 0; t < 4; ++t) Oprev[t] = T2[t];
        }
        cur ^= 1;
    }
    if (active) {
#pragma unroll
    for (int t = 0; t < 4; ++t) *(f32x4*)(Og + (size_t)(64 * 31 + 16 * t + nn) * 1024) = Oprev[t];
    }
#undef GDN_ISSUE
    __syncthreads();
}

DI void phase_gdn_out(Frame& F, const float* nw) {
    const bf16_t* proj = (const bf16_t*)(F.ws + WS_PROJ); const float* Og = (const float*)(F.ws + WS_GO); bf16_t* mix = (bf16_t*)(F.ws + WS_MIX);
    const int gw = F.bid * 8 + F.wave, NGW = F.G * 8, lane = F.lane, sub = lane >> 4, l16 = lane & 15;
    const f32x4 wa = *(const f32x4*)(nw + 8 * l16), wb = *(const f32x4*)(nw + 8 * l16 + 4);
#pragma unroll 4
    for (int it = gw; it < NTOK * NGH / 4; it += NGW) { const int item = 4 * it + sub, tok = item >> 3, h = item & 7;
        const float* op = Og + (size_t)tok * 1024 + h * HD + 8 * l16;
        const f32x4 a = *(const f32x4*)op, c = *(const f32x4*)(op + 4);
        const u32x4 zz = *(const u32x4*)(proj + (size_t)tok * DINP + C_GZ + h * HD + 8 * l16);
        const float ss = row16_sum(((a.x * a.x + a.y * a.y) + (a.z * a.z + a.w * a.w)) + ((c.x * c.x + c.y * c.y) + (c.z * c.z + c.w * c.w)));
        const float rs = rsqrtf(ss * (1.f / HD) + EPS);
        u32x4 o;
        o.x = pk2(a.x * rs * wa.x * siluf_(bflo(zz.x)), a.y * rs * wa.y * siluf_(bfhi(zz.x))); o.y = pk2(a.z * rs * wa.z * siluf_(bflo(zz.y)), a.w * rs * wa.w * siluf_(bfhi(zz.y)));
        o.z = pk2(c.x * rs * wb.x * siluf_(bflo(zz.z)), c.y * rs * wb.y * siluf_(bfhi(zz.z))); o.w = pk2(c.z * rs * wb.z * siluf_(bflo(zz.w)), c.w * rs * wb.w * siluf_(bfhi(zz.w)));
        *(u32x4*)(mix + (size_t)tok * DM + 512 + h * HD + 8 * l16) = o; }
}

DI void phase_route(Frame& F) {
    const int* topi = (const int*)(F.ws + WS_RT + RT_TOPI); const float* topg = (const float*)(F.ws + WS_RT + RT_TOPG);
    int* pos = (int*)(F.ws + WS_RT + RT_POS); float* rgate = (float*)(F.ws + WS_RT + RT_RGATE); int* texp = (int*)(F.ws + WS_RT + RT_TEXP); int* ntl = (int*)(F.ws + WS_RT + RT_NTILES);
    const bf16_t* hb = (const bf16_t*)(F.ws + WS_HB); bf16_t* hperm = (bf16_t*)(F.ws + WS_HPERM);
    LAS int* tot = (LAS int*)(F.lds + LDS_SCR);
    LAS int* bef = tot + 8;
    LAS int* pst = bef + 8;
    LAS int* dests = pst + 16;
    const int tid = F.tid, lane = F.lane;
    for (int blk = F.bid; blk < NTOK / 32; blk += F.G) {
        if (tid < 16) tot[tid] = 0;
        __syncthreads();
        int ct[NEXP], cb[NEXP];
#pragma unroll
        for (int e = 0; e < NEXP; ++e) { ct[e] = 0; cb[e] = 0; }
        { i32x4 tv[8];
#pragma unroll
          for (int j = 0; j < 8; ++j) tv[j] = ((const i32x4*)topi)[tid + 512 * j];
#pragma unroll
          for (int j = 0; j < 8; ++j)
#pragma unroll
            for (int c = 0; c < 4; ++c) { const int e = tv[j][c]; const bool before = 4 * (tid + 512 * j) + c < 64 * blk;
#pragma unroll
                for (int q = 0; q < NEXP; ++q) { ct[q] += (e == q); cb[q] += (e == q && before); } } }
#pragma unroll
        for (int e = 0; e < NEXP; ++e) { const int v = wave_sum_i(ct[e]), w = wave_sum_i(cb[e]);
            if (lane == 0) { atomicAdd((int*)(tot + e), v); atomicAdd((int*)(bef + e), w); } }
        __syncthreads();
        if (tid == 0) { int s = 0; for (int e = 0; e < NEXP; ++e) { pst[e] = s; s += (tot[e] + 255) / 256 * 256; } pst[NEXP] = s; }
        __syncthreads();
        if (tid < 64) { const int a = 64 * blk + tid, e = topi[a]; int rank = 0;
#pragma unroll
            for (int q = 0; q < NEXP; ++q) { const unsigned long long m = __ballot(e == q); if (e == q) rank = __popcll(m & ((1ull << lane) - 1ull)); }
            const int d = pst[e] + bef[e] + rank; dests[tid] = d; pos[a] = d; rgate[d] = topg[a]; }
        __syncthreads();
#pragma unroll 4
        for (int al = F.wave; al < 64; al += 8) { const int d = dests[al], tok = 32 * blk + (al >> 1);
            const u32x4* s = (const u32x4*)(hb + (size_t)tok * DM) + lane; u32x2* dd = (u32x2*)((unsigned char*)hperm + (size_t)d * DM) + lane;
#pragma unroll
            for (int j = 0; j < 4; ++j) { const u32x4 v = s[64 * j]; int w0 = 0, w1 = 0;
                w0 = __builtin_amdgcn_cvt_pk_fp8_f32(bflo(v.x), bfhi(v.x), w0, false); w0 = __builtin_amdgcn_cvt_pk_fp8_f32(bflo(v.y), bfhi(v.y), w0, true);
                w1 = __builtin_amdgcn_cvt_pk_fp8_f32(bflo(v.z), bfhi(v.z), w1, false); w1 = __builtin_amdgcn_cvt_pk_fp8_f32(bflo(v.w), bfhi(v.w), w1, true);
                dd[64 * j] = (u32x2){(unsigned)w0, (unsigned)w1}; } }
        for (int e = 0; e < NEXP; ++e) { const int lo = pst[e] + tot[e], hi = pst[e + 1];
            for (int r = lo + blk; r < hi; r += NTOK / 32) { ((unsigned*)((unsigned char*)hperm + (size_t)r * DM))[tid] = 0u; if (tid == 0) rgate[r] = 0.f; } }
        if (blk == 0) { const int nt = pst[NEXP] / 256; if (tid == 0) *ntl = nt;
            for (int i = tid; i < 72 * 8; i += 512) ((int*)(F.ws + WS_RT + RT_TAIL))[i] = -1;
            if (tid < nt) { int e = 0;
#pragma unroll
                for (int q = 1; q < NEXP; ++q) if (256 * tid >= pst[q]) e = q;
                texp[tid] = e; } }
        __syncthreads();
    }
}

DI void phase_final(Frame& F, const float* w) {
    const float* x = (const float*)(F.ws + WS_X); const bf16_t* y = (const bf16_t*)(F.ws + WS_Y); const int* pos = (const int*)(F.ws + WS_RT + RT_POS);
    const int gw = F.bid * 8 + F.wave, NGW = F.G * 8;
    for (int m = gw; m < NTOK; m += NGW) {
        const int p0 = pos[2 * m], p1 = pos[2 * m + 1];
        const f32x4* xr = (const f32x4*)(x + (size_t)m * DM) + F.lane; const u32x2* y0 = (const u32x2*)(y + (size_t)p0 * DM) + F.lane; const u32x2* y1 = (const u32x2*)(y + (size_t)p1 * DM) + F.lane;
        f32x4 v[8]; float s = 0.f;
        const int* tix = (const int*)(F.ws + WS_RT + RT_TAIL); const float* slab = (const float*)(F.ws + WS_SLAB); const float* rg = (const float*)(F.ws + WS_RT + RT_RGATE);
        const int tl0 = F.lane < 8 ? tix[(p0 >> 8) * 8 + F.lane] : -1, tl1 = F.lane < 8 ? tix[(p1 >> 8) * 8 + F.lane] : -1;
        const int KSPLIT = __builtin_amdgcn_readfirstlane(((const int*)(F.ws + WS_RT + RT_NTILES))[1]);
        f32x4 ya[8], yb[8];
#pragma unroll
        for (int j = 0; j < 8; ++j) { v[j] = xr[64 * j]; const u32x2 a = y0[64 * j], c = y1[64 * j]; ya[j] = (f32x4){bflo(a.x), bfhi(a.x), bflo(a.y), bfhi(a.y)}; yb[j] = (f32x4){bflo(c.x), bfhi(c.x), bflo(c.y), bfhi(c.y)}; }
        const unsigned m0 = (unsigned)__ballot(tl0 >= 0), m1 = (unsigned)__ballot(tl1 >= 0);
        if ((m0 | m1) != 0u) {
            const float g0 = rg[p0] * 0.015625f, g1 = rg[p1] * 0.015625f;
#pragma unroll
            for (int j = 0; j < 8; ++j) {
                if ((m0 >> j) & 1u) { asm volatile("" ::: "memory"); const int t0 = __builtin_amdgcn_readlane(tl0, j); const f32x4* sp = (const f32x4*)(slab + ((size_t)(t0 * KSPLIT) * 256 + (p0 & 255)) * 256) + F.lane; f32x4 a = sp[0];
#pragma unroll 1
                    for (int ks = 1; ks < KSPLIT; ++ks) a += sp[(size_t)ks * 16384];
                    ya[j] = a * g0; }
                if ((m1 >> j) & 1u) { asm volatile("" ::: "memory"); const int t1 = __builtin_amdgcn_readlane(tl1, j); const f32x4* sp = (const f32x4*)(slab + ((size_t)(t1 * KSPLIT) * 256 + (p1 & 255)) * 256) + F.lane; f32x4 a = sp[0];
#pragma unroll 1
                    for (int ks = 1; ks < KSPLIT; ++ks) a += sp[(size_t)ks * 16384];
                    yb[j] = a * g1; }
            }
        }
#pragma unroll
        for (int j = 0; j < 8; ++j) { v[j] = v[j] + ya[j] + yb[j]; s += (v[j].x * v[j].x + v[j].y * v[j].y) + (v[j].z * v[j].z + v[j].w * v[j].w); }
        const float rs = rsqrtf(wave_sum(s) * (1.f / DM) + EPS);
        f32x4* o = (f32x4*)(F.out + (size_t)m * DM) + F.lane;
#pragma unroll
        for (int j = 0; j < 8; ++j) o[64 * j] = v[j] * rs * ((const f32x4*)w)[F.lane + 64 * j];
    }
}

constexpr int PH_PER_LAYER = 11, N_PHASES = 1 + 2 * PH_PER_LAYER + 1;
#ifndef GDN_NAIVE
#define GDN_NAIVE 0
#endif
#define GDN_CHUNK gdn_chunk_mfma
#ifndef NSA_NAIVE
#define NSA_NAIVE 0
#endif
#ifndef REPMASK
#define REPMASK 0
#endif
#define NREP(k) ((((REPMASK) >> (k)) & 1) + 1)
#ifndef REPG
#define REPG 1
#endif
#ifndef REPX
#define REPX 1
#endif
#ifndef REPS
#define REPS 1
#endif
#ifndef REPN
#define REPN 1
#endif
#ifndef REPA
#define REPA 1
#endif
#ifndef REPB
#define REPB 1
#endif
#ifndef REPC
#define REPC 1
#endif
#ifndef PHMASK
#define PHMASK 0xFFFF
#endif
#define EN(k) (((PHMASK) >> (k)) & 1)
#define IN(k) (lo <= (k) && (k) < hi && (F.refresh(), true))
#define MARK(name) asm volatile("; MARK " name ::: "memory")
#define SEAM(k) do { if (IN((k) + 1)) xcd_barrier(bar, F.tid == 0); } while (0)
#define SEAMW(k) do { if (IN((k) + 1)) xcd_barrier_steal(bar, F.tid == 0, F, qactive, args.in[I_MGATE], args.in[I_MUP], args.in[I_MDOWN]); } while (0)
template <int layer> DI void run_layer(Frame& F, const Args& args, const int lo, const int hi, const XcdBarrier& bar, bool& qactive) {
    LAS unsigned char* scr = F.lds + LDS_SCR;
    bf16_t* HB = (bf16_t*)(F.ws + WS_HB); bf16_t* PROJ = (bf16_t*)(F.ws + WS_PROJ); bf16_t* MIX = (bf16_t*)(F.ws + WS_MIX); float* XB = (float*)(F.ws + WS_X);
    bf16_t* ACT = (bf16_t*)(F.ws + WS_ACT); bf16_t* HPERM = (bf16_t*)(F.ws + WS_HPERM); float* YB = (float*)(F.ws + WS_Y);
        const int pb = 1 + layer * PH_PER_LAYER;
        const float* xin = layer == 0 ? args.in[I_X] : XB;
        if (layer == 0 && EN(1) && IN(pb + 0)) { _Pragma("unroll 1") for (int rep_ = 0; rep_ < NREP(1); ++rep_) { phase_norm<false>(F, xin, args.in[I_ATTN_NORM] + layer * DM, HB, nullptr); } SEAMW(pb + 0); }
        if (EN(2) && IN(pb + 1)) { pg8::StaticOrder S; S.init(HB, DM * 2, F.ws + WS_WIN + layer * SZ_WIN, DM * 2, NTOK, DINP, F.G, F.bid);
            _Pragma("unroll 1") for (int rep_ = 0; rep_ < NREP(2); ++rep_) { pg8::EpiBf16 E{PROJ, DINP, layer == 1 ? (const float*)(F.ws + WS_RT + RT_RSQ) : nullptr}; pg8::gemm_phase(scr, DM / 64, DM * 2, DM * 2, S, E, F.tid); } SEAMW(pb + 1); }
        if (EN(3) && IN(pb + 2)) {
            for (int rep = 0; rep < REPA; ++rep, __syncthreads()) {
                const bool deal = (F.G == 256);
                for (int u = F.bid; u < 1024; u += F.G) { if (deal && u >= 768 && F.bid >= 128 && F.bid < 160) continue; GDN_CHUNK(F, u, args.in[I_CONV] + layer * 4 * 3072, args.in[I_ALOG] + layer * NGH, args.in[I_DTB] + layer * NGH); }
                if (deal && F.bid < 32) GDN_CHUNK(F, 768 + 128 + F.bid, args.in[I_CONV] + layer * 4 * 3072, args.in[I_ALOG] + layer * NGH, args.in[I_DTB] + layer * NGH);
                for (int u = F.bid; u < 160; u += F.G) { if (u >= 128) cmp_unit_mfma(F, u - 128, layer, args.in[I_POS_K] + layer * 32 * HD, args.in[I_POS_V] + layer * 32 * HD); }
            }
            SEAMW(pb + 2); }
        if (EN(4) && IN(pb + 3)) {
            for (int rep = 0; rep < REPB; ++rep, __syncthreads())
            for (int u = F.bid; u < 64 + 128 + 128; u += F.G) {
                if (u < 64) { for (int rs_ = 0; rs_ < REPS; ++rs_) gdn_scan_mfma(F, u); }
                else if (u < 192) { for (int rn_ = 0; rn_ < REPN; ++rn_) nsa_unit(F, u - 64); }
                else { const int sw = u - 192; if (F.G == 256 && sw >= 64) continue; swa_unit(F, args.in[I_SINKS] + layer * 4, sw); if (F.G == 256) swa_unit(F, args.in[I_SINKS] + layer * 4, sw + 64); }
            }
            SEAMW(pb + 3); }
        if (EN(5) && IN(pb + 4)) { _Pragma("unroll 1") for (int rep_ = 0; rep_ < NREP(5); ++rep_) { phase_gdn_out(F, args.in[I_GNORM] + layer * HD); } SEAMW(pb + 4); }
        if (EN(6) && IN(pb + 5)) { pg8::StaticOrder S; S.init(MIX, DM * 2, F.ws + WS_WOUT + layer * SZ_WOUT, DM * 2, NTOK, DM, F.G, F.bid);
            if (layer == 0) { pg8::EpiResidN E{xin, XB, HB, (float*)(F.ws + WS_RT + RT_RSQ), DM, (LAS float*)(F.lds + LDS_SCR + 131072), F.tid}; pg8::gemm_phase(scr, DM / 64, DM * 2, DM * 2, S, E, F.tid); }
            else { pg8::EpiResid E{xin, XB, DM}; pg8::gemm_phase(scr, DM / 64, DM * 2, DM * 2, S, E, F.tid); }
            SEAMW(pb + 5); }
        if (layer == 0) {
            if (EN(9) && IN(pb + 8)) { pg8::StaticOrder S; S.init(HB, DM * 2, F.ws + WS_DGU, DM * 2, NTOK, GU, F.G, F.bid);
                _Pragma("unroll 1") for (int rep_ = 0; rep_ < NREP(9); ++rep_) { pg8::EpiSwiGLU E{ACT, DFF, (const float*)(F.ws + WS_RT + RT_RSQ)}; pg8::gemm_phase(scr, DM / 64, DM * 2, DM * 2, S, E, F.tid); } SEAMW(pb + 8); }
            if (EN(10) && IN(pb + 9)) { pg8::StaticOrder S; S.init(ACT, DFF * 2, F.ws + WS_DDN, DFF * 2, NTOK, DM, F.G, F.bid);
                pg8::EpiResidN E{XB, XB, HB, (float*)(F.ws + WS_RT + RT_RSQ), DM, (LAS float*)(F.lds + LDS_SCR + 131072), F.tid}; pg8::gemm_phase(scr, DFF / 64, DFF * 2, DFF * 2, S, E, F.tid); SEAMW(pb + 9); }
        } else {
            if (EN(7) && IN(pb + 6)) { _Pragma("unroll 1") for (int rep_ = 0; rep_ < NREP(7); ++rep_) { phase_norm<true>(F, XB, args.in[I_FFN_NORM] + DM, HB, args.in[I_ROUTER]); } SEAMW(pb + 6); }
            if (EN(8) && IN(pb + 7)) { phase_route(F); if (hi - lo > 1) { if (qactive) { drain_convert(F, args.in[I_MGATE], args.in[I_MUP], args.in[I_MDOWN]); qactive = false; } } SEAM(pb + 7); }
            const int* texp = (const int*)(F.ws + WS_RT + RT_TEXP);
            if (EN(9) && IN(pb + 8)) { const int ntiles = __builtin_amdgcn_readfirstlane(*(const int*)(F.ws + WS_RT + RT_NTILES));
                pg8::MoeOrder S; S.init(HPERM, DM, F.ws + WS_MGU, DM, (size_t)GU * DM, texp, ntiles, GU, F.G, F.bid);
                _Pragma("unroll 1") for (int rep_ = 0; rep_ < NREP(9); ++rep_) { pg8::EpiSwiGLUT<true> E{ACT, DFF, nullptr}; pg8::gemm_phase<pg8::EpiSwiGLUT<true>, pg8::MoeOrder, true>(scr, DM / 128, DM, DM, S, E, F.tid); } SEAM(pb + 8); }
            if (EN(10) && IN(pb + 9)) { const int ntiles = __builtin_amdgcn_readfirstlane(*(const int*)(F.ws + WS_RT + RT_NTILES));
                pg8::MoeOrder S; S.init(ACT, DFF, F.ws + WS_MDN, DFF, (size_t)DM * DFF, texp, ntiles, DM, F.G, F.bid);
                const int nun = ntiles * (DM / 256), nfull = nun / F.G, R = nun - nfull * F.G;
                const int ks = R * 14 <= F.G ? 14 : R * 7 <= F.G ? 7 : R * 4 <= F.G ? 4 : R * 2 <= F.G ? 2 : 1;
                const bool split = (hi - lo > 1) && R > 0 && R <= MAX_TAIL && ks > 1;
                if (F.bid == 0 && F.tid == 0) ((int*)(F.ws + WS_RT + RT_NTILES))[1] = split ? ks : 0;
                if (split) S.nrounds = nfull;
                { pg8::EpiRowScaleBf E{(const float*)(F.ws + WS_RT + RT_RGATE), (bf16_t*)YB, DM, 0.015625f}; pg8::gemm_phase<pg8::EpiRowScaleBf, pg8::MoeOrder, true>(scr, DFF / 128, DFF, DFF, S, E, F.tid); }
                if (split) { pg8::MoeTailOrder T; T.M = S; T.M.nrounds = 1 << 30; T.L0 = nfull * F.G; T.R = R; T.kbytes = DFF / ks; T.ks = ks;
                    pg8::EpiSlab E2{(float*)(F.ws + WS_SLAB), (int*)(F.ws + WS_RT + RT_TAIL), ks}; pg8::gemm_phase<pg8::EpiSlab, pg8::MoeTailOrder, true>(scr, DFF / ks / 128, DFF, DFF, T, E2, F.tid); }
                SEAM(pb + 9); }
        }
    }
__global__ void __launch_bounds__(512, 2) trunk_fwd(Args args) {
    extern __shared__ __attribute__((aligned(16))) unsigned char lds_raw[];
    Frame F;
    F.lds = (LAS unsigned char*)lds_raw;
    F.tid = threadIdx.x; F.lane = F.tid & 63; F.wave = __builtin_amdgcn_readfirstlane(F.tid >> 6); F.wave0 = F.wave; F.G = gridDim.x; F.bid = blockIdx.x;
    F.out = args.out; F.ws = args.ws;
    volatile LAS unsigned* MISC = (volatile LAS unsigned*)(F.lds + LDS_MISC);
    if (F.tid < 64) MISC[F.tid] = 0u;
    __syncthreads();
    unsigned* ctl = (unsigned*)(F.ws + WS_CTL);
    XcdBarrier bar; bar.bar = ctl + CW_BAR; bar.x = 0; bar.st = nullptr;
    const int lo = args.ph_lo, hi = args.ph_hi;
    if (hi - lo > 1) bar = xcd_barrier_post(ctl + CW_BAR, MISC + 8);
    LAS unsigned char* scr = F.lds + LDS_SCR;
    bf16_t* HB = (bf16_t*)(F.ws + WS_HB); bf16_t* PROJ = (bf16_t*)(F.ws + WS_PROJ); bf16_t* MIX = (bf16_t*)(F.ws + WS_MIX); float* XB = (float*)(F.ws + WS_X);
    bf16_t* ACT = (bf16_t*)(F.ws + WS_ACT); bf16_t* HPERM = (bf16_t*)(F.ws + WS_HPERM); float* YB = (float*)(F.ws + WS_Y);

    bool qactive = (hi - lo > 1);
    if (EN(0) && IN(0)) { phase_convert(F, args.in[I_W_IN], args.in[I_W_OUT], args.in[I_DGATE], args.in[I_DUP], args.in[I_DDOWN], args.in[I_W1K], args.in[I_W1V], args.in[I_W2K], args.in[I_W2V], args.in[I_ATTN_NORM] + DM, args.in[I_FFN_NORM]);
        if (hi - lo <= 1) { LAS float* scr0 = (LAS float*)(F.lds + LDS_SCR + F.wave * 16384); for (int q = F.bid * 8 + F.wave; q < Q_TOTAL; q += F.G * 8) moe_item(F.ws, args.in[I_MGATE], args.in[I_MUP], args.in[I_MDOWN], q, scr0, F.lane); }
        SEAMW(0); }
    run_layer<0>(F, args, lo, hi, bar, qactive);
    run_layer<1>(F, args, lo, hi, bar, qactive);
    if (EN(11) && IN(N_PHASES - 1)) phase_final(F, args.in[I_FINAL]);
}

extern "C" void kernel_launch(void* const* d_in, const int* in_sizes, int n_in, void* d_out, int out_size, void* d_ws, size_t ws_size, hipStream_t stream) {
    static int grid = 0;
    if (grid == 0) {
        if (n_in != 24 || in_sizes[0] != NTOK * DM || out_size != NTOK * DM || ws_size < WS_END) {
            fprintf(stderr, "kernel_launch: unexpected shapes (n_in %d, in0 %d, out %d, ws %zu < %zu)\n", n_in, n_in > 0 ? in_sizes[0] : -1, out_size, ws_size, (size_t)WS_END); grid = -1; return; }
        int dev = 0, cus = 0, per_cu = 0;
        if (hipGetDevice(&dev) != hipSuccess || hipDeviceGetAttribute(&cus, hipDeviceAttributeMultiprocessorCount, dev) != hipSuccess) { grid = -1; return; }
        if (hipFuncSetAttribute((const void*)trunk_fwd, hipFuncAttributeMaxDynamicSharedMemorySize, LDS_BYTES) != hipSuccess) { fprintf(stderr, "kernel_launch: hipFuncSetAttribute failed\n"); grid = -1; return; }
        if (hipOccupancyMaxActiveBlocksPerMultiprocessor(&per_cu, (const void*)trunk_fwd, 512, LDS_BYTES) != hipSuccess || per_cu < 1) { fprintf(stderr, "kernel_launch: occupancy query says %d\n", per_cu); }
        (void)hipGetLastError();
        grid = cus;
    }
    if (grid < 0) return;
    (void)hipMemsetAsync((char*)d_ws + WS_CTL, 0, CTL_BYTES, stream);
    Args a{};
    for (int i = 0; i < 24; ++i) a.in[i] = (const float*)d_in[i];
    a.out = (float*)d_out; a.ws = (unsigned char*)d_ws;
#if MK_PER_PHASE
    for (int p = 0; p < N_PHASES; ++p) { a.ph_lo = p; a.ph_hi = p + 1; hipLaunchKernelGGL(trunk_fwd, dim3(grid), dim3(512), LDS_BYTES, stream, a); }
#else
    a.ph_lo = 0; a.ph_hi = N_PHASES;
    hipLaunchKernelGGL(trunk_fwd, dim3(grid), dim3(512), LDS_BYTES, stream, a);
#endif
}
```

```cpp
#include <hip/hip_runtime.h>
#include <cstdio>
#include <cstdint>

#ifndef MK_PER_PHASE
#define MK_PER_PHASE 0
#endif

#define DI __device__ __forceinline__
#define LAS __attribute__((address_space(3)))
DI void dma16s(const void* sbase  , unsigned voff, LAS void* l) { const unsigned la = (unsigned)(size_t)l; asm volatile("s_mov_b32 m0, %2\n\ts_nop 0\n\tglobal_load_lds_dwordx4 %0, %1" :: "v"(voff), "s"(sbase), "s"(la) : "memory", "m0"); }
DI void dma16(const void* g, LAS void* l) { const unsigned la = (unsigned)(size_t)l; asm volatile("s_mov_b32 m0, %1\n\ts_nop 0\n\tglobal_load_lds_dwordx4 %0, off" :: "v"(g), "s"(la) : "memory"); }
typedef int i32x4 __attribute__((ext_vector_type(4)));
typedef unsigned short bf16_t;
typedef short bf16x8 __attribute__((ext_vector_type(8)));
typedef float f32x4 __attribute__((ext_vector_type(4)));
typedef float f32x2 __attribute__((ext_vector_type(2)));
typedef unsigned u32x4 __attribute__((ext_vector_type(4)));
typedef unsigned u32x2 __attribute__((ext_vector_type(2)));

constexpr int NB = 4, SEQ = 2048, DM = 2048, NTOK = NB * SEQ, HD = 128;
constexpr int DIN = 6428, DINP = 6656;
constexpr int DFF = 7168, NEXP = 8, GU = 2 * DFF;
constexpr int NGH = 8;
constexpr int PMAX = 2 * NTOK + NEXP * 256;
constexpr int C_NQ = 0, C_KC = 512, C_VC = 640, C_KSL = 768, C_VSL = 896, C_KW = 1024, C_VW = 1152, C_GQ = 1280, C_GK = 2304, C_GV = 3328, C_GZ = 4352,
              C_SQ = 5376, C_SK = 5888, C_SV = 6144, C_NG = 6400, C_GA = 6412, C_GB = 6420;
constexpr float EPS = 1e-6f;
constexpr float QSCALE = 0.08838834764831845f;

constexpr size_t MiB = 1u << 20;
constexpr size_t WS_CTL = 0, CTL_BYTES = 1 * MiB;
constexpr size_t SZ_WIN = (size_t)DINP * DM * 2, SZ_WOUT = (size_t)DM * DM * 2, SZ_WGU = (size_t)GU * DM * 2, SZ_WDN = (size_t)DM * DFF * 2;
constexpr size_t WS_WIN = 2 * MiB;
constexpr size_t WS_WOUT = WS_WIN + 2 * SZ_WIN;
constexpr size_t WS_DGU = WS_WOUT + 2 * SZ_WOUT;
constexpr size_t WS_DDN = WS_DGU + SZ_WGU;
constexpr size_t WS_MGU = WS_DDN + SZ_WDN;
constexpr size_t WS_MDN = WS_MGU + NEXP * SZ_WGU;
constexpr size_t WS_HB = WS_MDN + NEXP * SZ_WDN;
constexpr size_t WS_MIX = WS_HB + (size_t)NTOK * DM * 2;
constexpr size_t WS_X = WS_MIX + (size_t)NTOK * DM * 2;
constexpr size_t WS_HPERM = WS_X + (size_t)NTOK * DM * 4;
constexpr size_t WS_Y = WS_HPERM + (size_t)PMAX * DM * 2;
constexpr size_t WS_RT = WS_Y + (size_t)PMAX * DM * 4;
constexpr size_t WS_KC = WS_RT + 1 * MiB;
constexpr size_t WS_CW1 = WS_KC + 1 * MiB;
constexpr size_t WS_CW2 = WS_CW1 + 8 * MiB;
constexpr size_t WS_OVL = WS_CW2 + 1 * MiB;
constexpr size_t WS_ACT = WS_OVL;
constexpr size_t WS_PROJ = WS_OVL;
constexpr size_t SZ_G = (size_t)NB * NGH * SEQ * HD * 4;
constexpr size_t WS_GU_ = WS_PROJ + (size_t)NTOK * DINP * 2;
constexpr size_t WS_GW = WS_GU_ + SZ_G, WS_GQ = WS_GW + SZ_G, WS_GK = WS_GQ + SZ_G;
constexpr size_t WS_GAT = WS_GK + SZ_G;
constexpr size_t WS_GO = WS_GAT + 16 * MiB;
constexpr size_t WS_GGL = WS_GO + 32 * MiB;
constexpr size_t WS_NSAO = WS_GGL + 1 * MiB;
constexpr size_t OVL_A = (size_t)PMAX * DFF * 2, OVL_B = (WS_NSAO + 16 * MiB) - WS_OVL;
constexpr size_t WS_END = WS_OVL + (OVL_A > OVL_B ? OVL_A : OVL_B);
constexpr size_t RT_RSQ = 524288;
constexpr size_t RT_TOPI = 0, RT_TOPG = 65536, RT_POS = 131072, RT_RGATE = 196608, RT_TEXP = 294912, RT_NTILES = 295936, RT_TAIL = 296960;

constexpr int CW_BAR = 4096;
constexpr int KSPLIT_MAX = 14;
constexpr size_t WS_SLAB = WS_MGU + (size_t)NEXP * GU * DM;
constexpr int MAX_TAIL = 64;
constexpr int CW_CMPRDY = 2112;
constexpr int CW_QHEAD = 2048;

constexpr int LDS_SCR = 0, LDS_SCR_BYTES = 153600;
constexpr int LDS_MISC = LDS_SCR_BYTES;
constexpr int LDS_BYTES = LDS_SCR_BYTES + 256;

DI float bf2f(unsigned v) { return __uint_as_float(v << 16); }
DI float bflo(unsigned v) { return __uint_as_float(v << 16); }
DI float bfhi(unsigned v) { return __uint_as_float(v & 0xffff0000u); }
DI unsigned f2bf(float f) { unsigned u = __float_as_uint(f); return (u + 0x7fffu + ((u >> 16) & 1u)) >> 16; }
DI unsigned pk2(float lo, float hi) { return f2bf(lo) | (f2bf(hi) << 16); }
typedef __bf16 bf16v2_t __attribute__((ext_vector_type(2)));
DI unsigned cvt_pk_bf16(float lo, float hi) { const f32x2 v = {lo, hi}; return __builtin_bit_cast(unsigned, __builtin_convertvector(v, bf16v2_t)); }
#define DPPF(x, ctrl) __builtin_bit_cast(float, __builtin_amdgcn_update_dpp(0, __builtin_bit_cast(int, (x)), (ctrl), 0xf, 0xf, true))
DI float wave_sum(float v) {
    v += DPPF(v, 0xB1);
    v += DPPF(v, 0x4E);
    v += DPPF(v, 0x141);
    v += DPPF(v, 0x140);
    v += __builtin_bit_cast(float, __builtin_amdgcn_ds_swizzle(__builtin_bit_cast(int, v), 0x401F));
    return __builtin_bit_cast(float, __builtin_amdgcn_readlane(__builtin_bit_cast(int, v), 0)) + __builtin_bit_cast(float, __builtin_amdgcn_readlane(__builtin_bit_cast(int, v), 32));
}
DI float wave_max(float v) {
    v = fmaxf(v, DPPF(v, 0xB1));
    v = fmaxf(v, DPPF(v, 0x4E));
    v = fmaxf(v, DPPF(v, 0x141));
    v = fmaxf(v, DPPF(v, 0x140));
    v = fmaxf(v, __builtin_bit_cast(float, __builtin_amdgcn_ds_swizzle(__builtin_bit_cast(int, v), 0x401F)));
    return fmaxf(__builtin_bit_cast(float, __builtin_amdgcn_readlane(__builtin_bit_cast(int, v), 0)), __builtin_bit_cast(float, __builtin_amdgcn_readlane(__builtin_bit_cast(int, v), 32)));
}
DI int wave_sum_i(int v) {
    v += __builtin_amdgcn_update_dpp(0, v, 0xB1, 0xf, 0xf, true);
    v += __builtin_amdgcn_update_dpp(0, v, 0x4E, 0xf, 0xf, true);
    v += __builtin_amdgcn_update_dpp(0, v, 0x141, 0xf, 0xf, true);
    v += __builtin_amdgcn_update_dpp(0, v, 0x140, 0xf, 0xf, true);
    v += __builtin_amdgcn_ds_swizzle(v, 0x401F);
    return __builtin_amdgcn_readlane(v, 0) + __builtin_amdgcn_readlane(v, 32);
}
DI float sigmoidf_(float x) { return 1.f / (1.f + __expf(-x)); }
DI float siluf_(float x) { return x / (1.f + __expf(-x)); }
DI float softplusf_(float x) { return x > 20.f ? x : log1pf(__expf(x)); }
#define LDS_WAIT() asm volatile("s_waitcnt lgkmcnt(0)" ::: "memory")

#define XB_TMO      128
#define XB_XCNT(j)  (256  + 64 * (j))
#define XB_XSUB(j)  (1280 + 64 * (j))
#define XB_XGEN(j)  (2304 + 64 * (j))
#define XB_TOP      3328
#define XB_TOPGEN   3392
#define XCD_BAR_WORDS 3456
#define XB_SPIN_CAP (1u << 22)
DI unsigned xb_ld(unsigned* p)              { return __hip_atomic_load(p, __ATOMIC_RELAXED, __HIP_MEMORY_SCOPE_AGENT); }
DI unsigned xb_add(unsigned* p, unsigned v) { return __hip_atomic_fetch_add(p, v, __ATOMIC_RELAXED, __HIP_MEMORY_SCOPE_AGENT); }
DI unsigned xb_xcc_id() { return (unsigned)__builtin_amdgcn_s_getreg((3 << 11) | 20) & 0xFu; }
#define XB_SPIN(cond, bar) do { unsigned _sp = 0; while (cond) { __builtin_amdgcn_s_sleep(1); \
    if ((++_sp & 255u) == 0u) { if (xb_ld(&(bar)[XB_TMO])) break; if (_sp > XB_SPIN_CAP) { atomicAdd(&(bar)[XB_TMO], 1u); break; } } } } while (0)
struct XcdBarrier { unsigned* bar; unsigned x; volatile LAS unsigned* st; };
DI XcdBarrier xcd_barrier_post(unsigned* bar, volatile LAS unsigned* st) {
    XcdBarrier b; b.bar = bar; b.x = xb_xcc_id(); b.st = st;
    if (threadIdx.x == 0) (void)xb_add(&bar[XB_XCNT(b.x)], 1u);
    return b;
}
DI void xcd_barrier_complete(unsigned* bar, unsigned x, unsigned& nloc, unsigned& nx) {
    const unsigned G = gridDim.x * gridDim.y * gridDim.z;
    unsigned sum, cnt, mine, sp = 0u;
    for (;;) {
        sum = 0u; cnt = 0u; mine = 0u;
#pragma unroll
        for (unsigned j = 0; j < 16; ++j) { const unsigned c = xb_ld(&bar[XB_XCNT(j)]); sum += c; cnt += (c > 0u) ? 1u : 0u; mine = (j == x) ? c : mine; }
        if (sum == G) break;
        __builtin_amdgcn_s_sleep(1);
        if ((++sp & 255u) == 0u) { if (xb_ld(&bar[XB_TMO])) break; if (sp > XB_SPIN_CAP) { atomicAdd(&bar[XB_TMO], 1u); break; } }
    }
    nloc = mine > 0u ? mine : 1u; nx = cnt > 0u ? cnt : 1u;
}
DI void xcd_barrier(const XcdBarrier& b, const bool leader  ) {
    asm volatile("s_waitcnt vmcnt(0)" ::: "memory");
    __syncthreads();
    if (leader) {
        unsigned* bar = b.bar;
        __builtin_amdgcn_s_waitcnt(0);
        unsigned nloc = b.st[0], nx = b.st[1];
        if (nloc == 0u) { xcd_barrier_complete(bar, b.x, nloc, nx); b.st[0] = nloc; b.st[1] = nx; }
        const unsigned old = xb_add(&bar[XB_XSUB(b.x)], 1u);
        const unsigned gen = old / nloc;
        if (old + 1u == (gen + 1u) * nloc) {
            __builtin_amdgcn_fence(__ATOMIC_RELEASE, "agent");
            asm volatile("s_waitcnt vmcnt(0)" ::: "memory");
            const unsigned og = xb_add(&bar[XB_TOP], 1u);
            const unsigned tg = og / nx;
            if (og + 1u == (tg + 1u) * nx) xb_add(&bar[XB_TOPGEN], 1u);
            else XB_SPIN(xb_ld(&bar[XB_TOPGEN]) == tg, bar);
            __builtin_amdgcn_fence(__ATOMIC_ACQUIRE, "agent");
            xb_add(&bar[XB_XGEN(b.x)], 1u);
            asm volatile("s_waitcnt vmcnt(0)" ::: "memory");
        } else {
            XB_SPIN(xb_ld(&bar[XB_XGEN(b.x)]) == gen, bar);
            __builtin_amdgcn_fence(__ATOMIC_ACQUIRE, "agent");
            asm volatile("s_waitcnt vmcnt(0)" ::: "memory");
        }
    }
    __syncthreads();
}

namespace pg8 {
constexpr int BM = 256, BK = 64, HALF = 128, HTB = HALF * BK * 2, STAGE_BYTES = 8 * HTB, NXCD = 8, WGM = 8;
__host__ __device__ __forceinline__ int lds_byte(int r, int c) { const int st = (r >> 4) * 2 + (c >> 5), rr = r & 15, cc = c & 31, ob = rr * 64 + cc * 2; return st * 1024 + (ob ^ (((ob >> 9) & 1) << 5)); }
__host__ __device__ __forceinline__ void stage_rc(int b, int& R, int& C) { const int st = b / 1024, sb = b % 1024, swz = sb ^ (((sb >> 9) & 1) << 5); R = (st >> 1) * 16 + swz / 64; C = (st & 1) * 32 + (swz % 64) / 2; }
__host__ __device__ __forceinline__ int perm32(int rho) { const int n = rho >> 4, i = rho & 15; return 8 * (i >> 2) + 4 * n + (i & 3); }
struct Unit { int pm, pn, aux; };
DI bool order_next(int i, int G, int c, int nM, int nN, Unit& u) {
    const int nwg = nM * nN; const long L = (long)i * G + c; if (L >= nwg) return false;
    int wgid = (int)L; { const int q = nwg / NXCD, r = nwg % NXCD, xcd = wgid % NXCD, off = wgid / NXCD; wgid = (xcd < r ? xcd * (q + 1) : r * (q + 1) + (xcd - r) * q) + off; }
    const int nig = WGM * nN, gid = wgid / nig, fm = gid * WGM, gsz = (nM - fm) < WGM ? (nM - fm) : WGM;
    u.pm = fm + ((wgid % nig) % gsz); u.pn = (wgid % nig) / gsz; u.aux = 0; return true;
}
struct StaticOrder {
    const char* A; const char* Bt; int nM, nN, G, c; size_t a_tstep, b_tstep;
    DI void init(const void* A_, int ldaB, const void* Bt_, int ldbB, int M, int N, int G_, int c_) { A = (const char*)A_; Bt = (const char*)Bt_; nM = M / BM; nN = N / BM; G = G_; c = c_; a_tstep = (size_t)BM * ldaB; b_tstep = (size_t)BM * ldbB; }
    DI bool next(int i, Unit& u) const { return order_next(i, G, c, nM, nN, u); }
    DI const char* abase(const Unit& u) const { return A + (size_t)u.pm * a_tstep; }
    DI const char* bbase(const Unit& u) const { return Bt + (size_t)u.pn * b_tstep; }
};
struct MoeOrder {
    const char* A; const char* W; const int* texp; int nM, nN, G, c; size_t a_tstep, b_tstep, estride;
    DI void init(const void* A_, int ldaB, const void* W_, int ldbB, size_t estride_bytes, const int* texp_, int ntiles, int N, int G_, int c_) {
        A = (const char*)A_; W = (const char*)W_; texp = texp_; nM = ntiles; nN = N / BM; G = G_; c = c_; a_tstep = (size_t)BM * ldaB; b_tstep = (size_t)BM * ldbB; estride = estride_bytes; }
    int nrounds = 1 << 30;
    DI bool next(int i, Unit& u) const { return i < nrounds && order_next(i, G, c, nM, nN, u); }
    DI const char* abase(const Unit& u) const { return A + (size_t)u.pm * a_tstep; }
    DI const char* bbase(const Unit& u) const { const int e = __builtin_amdgcn_readfirstlane(texp[u.pm]); return W + (size_t)e * estride + (size_t)u.pn * b_tstep; }
};
struct MoeTailOrder {
    MoeOrder M; int L0, R, kbytes, ks;
    DI bool next(int i, Unit& u) const { const int j = i * M.G + M.c; if (j >= R * ks) return false; const int t = j / ks;
        order_next(0, 1 << 30, L0 + t, M.nM, M.nN, u); u.aux = j; return true; }
    DI const char* abase(const Unit& u) const { return M.abase(u) + (size_t)(u.aux % ks) * kbytes; }
    DI const char* bbase(const Unit& u) const { return M.bbase(u) + (size_t)(u.aux % ks) * kbytes; }
};
struct EpiSlab {
    static constexpr bool PERM = false;
    float* slab; int* tailidx; int ks;
    DI void operator()(const f32x4 (&acc)[2][2][4][2], const Unit& u, int wr, int wc, int fr, int fq) const {
        float* base = slab + (size_t)u.aux * 65536; const int row0 = wr * 64 + fr, col0 = wc * 32 + 4 * fq;
        if ((u.aux % ks) == 0 && wr == 0 && wc == 0 && fr == 0 && fq == 0) tailidx[u.pm * 8 + u.pn] = u.aux / ks;
#pragma unroll
        for (int ai = 0; ai < 2; ++ai)
#pragma unroll
            for (int m = 0; m < 4; ++m) { float* rp = base + (size_t)(row0 + ai * HALF + m * 16) * 256 + col0;
#pragma unroll
                for (int bj = 0; bj < 2; ++bj)
#pragma unroll
                    for (int n = 0; n < 2; ++n) *(f32x4*)(rp + bj * HALF + n * 16) = acc[ai][bj][m][n];
                asm volatile("" ::: "memory"); }
    }
};
DI float row_rs(const float* rsq, int row) { float s = 0.f;
#pragma unroll
    for (int p = 0; p < 8; ++p) s += rsq[(size_t)p * NTOK + row];
    return rsqrtf(s * (1.f / DM) + EPS); }
struct EpiBf16 {
    static constexpr bool PERM = true;
    bf16_t* O; int ldc; const float* rsq;
    unsigned* pub = nullptr; int pubcol = -1;
    DI void operator()(const f32x4 (&acc)[2][2][4][2], const Unit& u, int wr, int wc, int fr, int fq) const {
        const int row0 = u.pm * BM + wr * 64 + fr, col0 = u.pn * BM + wc * 32 + 8 * fq;
        float rsv[2][4];
#pragma unroll
        for (int ai = 0; ai < 2; ++ai)
#pragma unroll
            for (int m = 0; m < 4; ++m) rsv[ai][m] = rsq ? row_rs(rsq, row0 + ai * HALF + m * 16) : 1.f;
#pragma unroll
        for (int ai = 0; ai < 2; ++ai)
#pragma unroll
            for (int m = 0; m < 4; ++m) { bf16_t* rowp = O + (size_t)(row0 + ai * HALF + m * 16) * ldc + col0;
#pragma unroll
                for (int bj = 0; bj < 2; ++bj) { const f32x4 v0 = acc[ai][bj][m][0] * rsv[ai][m], v1 = acc[ai][bj][m][1] * rsv[ai][m];
                    u32x4 w; w.x = cvt_pk_bf16(v0[0], v0[1]); w.y = cvt_pk_bf16(v0[2], v0[3]); w.z = cvt_pk_bf16(v1[0], v1[1]); w.w = cvt_pk_bf16(v1[2], v1[3]);
                    *(u32x4*)(rowp + bj * HALF) = w; } }
        if (pub && u.pn == pubcol) { asm volatile("s_waitcnt vmcnt(0)" ::: "memory"); __builtin_amdgcn_fence(__ATOMIC_RELEASE, "agent"); asm volatile("s_waitcnt vmcnt(0)" ::: "memory");
            if ((threadIdx.x & 63) == 0) (void)__hip_atomic_fetch_add(pub, 1u, __ATOMIC_RELAXED, __HIP_MEMORY_SCOPE_AGENT); }
    }
};
template <bool F8> struct EpiSwiGLUT {
    static constexpr bool PERM = true;
    bf16_t* O; int ldc; const float* rsq;
    DI void operator()(const f32x4 (&acc)[2][2][4][2], const Unit& u, int wr, int wc, int fr, int fq) const {
        const int row0 = u.pm * BM + wr * 64 + fr, col0 = u.pn * HALF + wc * 32 + 8 * fq;
        float rsv[2][4];
#pragma unroll
        for (int ai = 0; ai < 2; ++ai)
#pragma unroll
            for (int m = 0; m < 4; ++m) rsv[ai][m] = (rsq ? row_rs(rsq, row0 + ai * HALF + m * 16) : 1.f) * (F8 ? 0.015625f : 1.f);
#pragma unroll
        for (int ai = 0; ai < 2; ++ai)
#pragma unroll
            for (int m = 0; m < 4; ++m) { bf16_t* rowp = O + (size_t)(row0 + ai * HALF + m * 16) * ldc + col0;
                float o[8];
#pragma unroll
                for (int n = 0; n < 2; ++n)
#pragma unroll
                    for (int j = 0; j < 4; ++j) { const float g = acc[ai][0][m][n][j] * rsv[ai][m], up = acc[ai][1][m][n][j] * rsv[ai][m]; o[n * 4 + j] = g * __builtin_amdgcn_rcpf(1.f + __expf(-g)) * up; }
                if (F8) { int w0 = 0, w1 = 0; w0 = __builtin_amdgcn_cvt_pk_fp8_f32(o[0], o[1], w0, false); w0 = __builtin_amdgcn_cvt_pk_fp8_f32(o[2], o[3], w0, true);
                    w1 = __builtin_amdgcn_cvt_pk_fp8_f32(o[4], o[5], w1, false); w1 = __builtin_amdgcn_cvt_pk_fp8_f32(o[6], o[7], w1, true);
                    *(u32x2*)((unsigned char*)O + (size_t)(row0 + ai * HALF + m * 16) * ldc + col0) = (u32x2){(unsigned)w0, (unsigned)w1}; }
                else { u32x4 w; w.x = cvt_pk_bf16(o[0], o[1]); w.y = cvt_pk_bf16(o[2], o[3]); w.z = cvt_pk_bf16(o[4], o[5]); w.w = cvt_pk_bf16(o[6], o[7]);
                    *(u32x4*)rowp = w; }
                asm volatile("" ::: "memory"); }
    }
};
typedef EpiSwiGLUT<false> EpiSwiGLU;
struct EpiResid {
    static constexpr bool PERM = false;
    const float* resid; float* out; int ldc;
    DI void operator()(const f32x4 (&acc)[2][2][4][2], const Unit& u, int wr, int wc, int fr, int fq) const {
        const int row0 = u.pm * BM + wr * 64 + fr, col0 = u.pn * BM + wc * 32 + 4 * fq;
#pragma unroll
        for (int ai = 0; ai < 2; ++ai)
#pragma unroll
            for (int m = 0; m < 4; ++m) { const size_t off = (size_t)(row0 + ai * HALF + m * 16) * ldc + col0;
#pragma unroll
                for (int bj = 0; bj < 2; ++bj)
#pragma unroll
                    for (int n = 0; n < 2; ++n) { const f32x4 r = *(const f32x4*)(resid + off + bj * HALF + n * 16); *(f32x4*)(out + off + bj * HALF + n * 16) = r + acc[ai][bj][m][n]; } }
    }
};
struct EpiResidN {
    static constexpr bool PERM = false;
    const float* resid; float* out; bf16_t* xb; float* rsq; int ldc; LAS float* P  ; int tid;
    DI void operator()(const f32x4 (&acc)[2][2][4][2], const Unit& u, int wr, int wc, int fr, int fq) const {
        const int row0 = u.pm * BM + wr * 64 + fr, col0 = u.pn * BM + wc * 32 + 4 * fq;
        const int lane = fr + 16 * fq;
#pragma unroll
        for (int ai = 0; ai < 2; ++ai)
#pragma unroll
            for (int m = 0; m < 4; ++m) { const size_t off = (size_t)(row0 + ai * HALF + m * 16) * ldc + col0; float ss = 0.f;
#pragma unroll
                for (int bj = 0; bj < 2; ++bj)
#pragma unroll
                    for (int n = 0; n < 2; ++n) { const f32x4 v = *(const f32x4*)(resid + off + bj * HALF + n * 16) + acc[ai][bj][m][n]; *(f32x4*)(out + off + bj * HALF + n * 16) = v;
                        *(u32x2*)(xb + off + bj * HALF + n * 16) = (u32x2){cvt_pk_bf16(v[0], v[1]), cvt_pk_bf16(v[2], v[3])}; ss += (v[0] * v[0] + v[1] * v[1]) + (v[2] * v[2] + v[3] * v[3]); }
                ss += __builtin_bit_cast(float, __builtin_amdgcn_ds_swizzle(__builtin_bit_cast(int, ss), 0x401F));
                ss += __builtin_bit_cast(float, __builtin_amdgcn_ds_bpermute((lane ^ 32) << 2, __builtin_bit_cast(int, ss)));
                if (fq == 0) P[(wr * 64 + ai * HALF + m * 16 + fr) * 4 + wc] = ss;
                asm volatile("" ::: "memory"); }
        asm volatile("s_waitcnt lgkmcnt(0)" ::: "memory"); __builtin_amdgcn_s_barrier(); asm volatile("" ::: "memory");
        if (tid < 256) { const LAS float* p = P + tid * 4; rsq[(size_t)u.pn * NTOK + u.pm * BM + tid] = (p[0] + p[1]) + (p[2] + p[3]); }
    }
};
struct EpiRowScaleBf {
    static constexpr bool PERM = true;
    const float* rscale; bf16_t* out; int ldc; float mul;
    DI void operator()(const f32x4 (&acc)[2][2][4][2], const Unit& u, int wr, int wc, int fr, int fq) const {
        const int row0 = u.pm * BM + wr * 64 + fr, col0 = u.pn * BM + wc * 32 + 8 * fq;
#pragma unroll
        for (int ai = 0; ai < 2; ++ai)
#pragma unroll
            for (int m = 0; m < 4; ++m) { const int row = row0 + ai * HALF + m * 16; const float s = rscale[row] * mul; bf16_t* rowp = out + (size_t)row * ldc + col0;
#pragma unroll
                for (int bj = 0; bj < 2; ++bj) { const f32x4 v0 = acc[ai][bj][m][0] * s, v1 = acc[ai][bj][m][1] * s;
                    u32x4 w; w.x = cvt_pk_bf16(v0[0], v0[1]); w.y = cvt_pk_bf16(v0[2], v0[3]); w.z = cvt_pk_bf16(v1[0], v1[1]); w.w = cvt_pk_bf16(v1[2], v1[3]);
                    *(u32x4*)(rowp + bj * HALF) = w; }
                asm volatile("" ::: "memory"); }
    }
};
struct EpiRowScale {
    static constexpr bool PERM = false;
    const float* rscale; float* out; int ldc; float mul;
    DI void operator()(const f32x4 (&acc)[2][2][4][2], const Unit& u, int wr, int wc, int fr, int fq) const {
        const int row0 = u.pm * BM + wr * 64 + fr, col0 = u.pn * BM + wc * 32 + 4 * fq;
#pragma unroll
        for (int ai = 0; ai < 2; ++ai)
#pragma unroll
            for (int m = 0; m < 4; ++m) { const int row = row0 + ai * HALF + m * 16; const float s = rscale[row] * mul; const size_t off = (size_t)row * ldc + col0;
#pragma unroll
                for (int bj = 0; bj < 2; ++bj)
#pragma unroll
                    for (int n = 0; n < 2; ++n) *(f32x4*)(out + off + bj * HALF + n * 16) = acc[ai][bj][m][n] * s;
                asm volatile("" ::: "memory"); }
    }
};

typedef int v8i_t __attribute__((ext_vector_type(8)));
template <class Epi, class Sched, bool FP8 = false, bool ALIGN_EPI = true, bool SP2 = true>
DI void gemm_phase(LAS unsigned char* lds, const int nt, const int ldaB, const int ldbB, const Sched& S, const Epi& E, int tid) {
    asm volatile("" : "+v"(tid));
    const int wid = __builtin_amdgcn_readfirstlane(tid >> 6), lane = tid & 63, wr = wid >> 2, wc = wid & 3, fr = lane & 15, fq = lane >> 4;
    unsigned voffA[2], voffB[2];
#pragma unroll
    for (int i = 0; i < 2; ++i) { int R, C; stage_rc(tid * 16 + i * 8192, R, C); const int Rb = Epi::PERM ? ((R & ~31) + perm32(R & 31)) : R;
        voffA[i] = (unsigned)(R * ldaB + C * 2); voffB[i] = (unsigned)(Rb * ldbB + C * 2); }
    const size_t kstep = (size_t)(BK * 2);
    const size_t hstepA = (size_t)HALF * ldaB, hstepB = (size_t)HALF * ldbB;
    const unsigned ldsw = (unsigned)wid * 1024u;
    const int aoff = lds_byte(wr * 64 + fr, fq * 8), boff = lds_byte(wc * 32 + fr, fq * 8);
#define PG8_SA(b, h) (((b) * 2 + (h)) * HTB)
#define PG8_SB(b, h) ((4 + (b) * 2 + (h)) * HTB)
#define PG8_STAGE(bufoff, gbase, voff) do { _Pragma("unroll") for (int _i = 0; _i < 2; ++_i) \
        __builtin_amdgcn_global_load_lds((const unsigned*)((const char*)(gbase) + (voff)[_i]), (LAS unsigned*)(lds + (bufoff) + ldsw + _i * 8192), 16, 0, 0); } while (0)
#define PG8_LDA(dst, b, h) do { _Pragma("unroll") for (int m = 0; m < 4; ++m) _Pragma("unroll") for (int k = 0; k < 2; ++k) dst[m][k] = *(const LAS bf16x8*)(lds + PG8_SA(b, h) + aoff + m * 2048 + k * 1024); } while (0)
#define PG8_LDB(dst, b, h) do { _Pragma("unroll") for (int n = 0; n < 2; ++n) _Pragma("unroll") for (int k = 0; k < 2; ++k) dst[n][k] = *(const LAS bf16x8*)(lds + PG8_SB(b, h) + boff + n * 2048 + k * 1024); } while (0)
#define PG8_CAT(x0, x1) __builtin_shufflevector(__builtin_bit_cast(u32x4, (x0)), __builtin_bit_cast(u32x4, (x1)), 0, 1, 2, 3, 4, 5, 6, 7)
#define PG8_MMA(ai, bj, At, Bt) do { __builtin_amdgcn_s_setprio(1); _Pragma("unroll") for (int m = 0; m < 4; ++m) _Pragma("unroll") for (int n = 0; n < 2; ++n) { \
        if constexpr (FP8) { const v8i_t wa_ = __builtin_bit_cast(v8i_t, PG8_CAT(Bt[n][0], Bt[n][1])), xa_ = __builtin_bit_cast(v8i_t, PG8_CAT(At[m][0], At[m][1])); \
            asm volatile("v_mfma_f32_16x16x128_f8f6f4 %0, %1, %2, %0" : "+v"(acc[ai][bj][m][n]) : "v"(wa_), "v"(xa_)); }   \
        else { _Pragma("unroll") for (int k = 0; k < 2; ++k) acc[ai][bj][m][n] = __builtin_amdgcn_mfma_f32_16x16x32_bf16(Bt[n][k], At[m][k], acc[ai][bj][m][n], 0, 0, 0); } } \
        __builtin_amdgcn_s_setprio(0); } while (0)
#define PG8_WAIT_V(n) asm volatile("s_waitcnt vmcnt(" #n ")" ::: "memory")
#define PG8_WAIT_L(n) asm volatile("s_waitcnt lgkmcnt(" #n ")" ::: "memory")
#define PG8_BAR __builtin_amdgcn_s_barrier()
#define PG8_SCHED __builtin_amdgcn_sched_barrier(0)
    Unit cur, nxt; int ui = 0;
    if (!S.next(0, cur)) return;
    f32x4 acc[2][2][4][2];
#pragma unroll
    for (int a = 0; a < 2; ++a)
#pragma unroll
        for (int b = 0; b < 2; ++b)
#pragma unroll
            for (int m = 0; m < 4; ++m)
#pragma unroll
                for (int n = 0; n < 2; ++n) acc[a][b][m][n] = (f32x4){0.f, 0.f, 0.f, 0.f};
    bf16x8 At[4][2], B0[2][2], B1[2][2];
    const char* cA = S.abase(cur); const char* cB = S.bbase(cur);
    static_assert(SP2, "only the SP2 loop is kept");
    PG8_STAGE(PG8_SB(0, 0), cB, voffB); PG8_STAGE(PG8_SB(0, 1), cB + hstepB, voffB); PG8_STAGE(PG8_SA(0, 0), cA, voffA); PG8_STAGE(PG8_SA(0, 1), cA + hstepA, voffA);
    if (wr == 1) PG8_BAR;
    PG8_WAIT_V(2); PG8_BAR;
    PG8_STAGE(PG8_SB(1, 0), cB + kstep, voffB); PG8_STAGE(PG8_SA(1, 0), cA + kstep, voffA); PG8_STAGE(PG8_SB(1, 1), cB + hstepB + kstep, voffB);
    PG8_WAIT_V(6); PG8_BAR;
    for (;;) {
        const bool has_next = S.next(ui + 1, nxt);
        const char* nA = has_next ? S.abase(nxt) : cA; const char* nB = has_next ? S.bbase(nxt) : cB;
        for (int t = 0; t < nt; t += 2) {
            const bool last = (t == nt - 2);
            const char* a1 = cA + (size_t)(t + 1) * kstep;
            const char* a2 = last ? nA : cA + (size_t)(t + 2) * kstep; const char* b2 = last ? nB : cB + (size_t)(t + 2) * kstep;
            const char* a3 = a2 + kstep; const char* b3 = b2 + kstep;
            PG8_LDB(B0, 0, 0); PG8_LDB(B1, 0, 1); PG8_SCHED; PG8_LDA(At, 0, 0); PG8_STAGE(PG8_SA(1, 1), a1 + hstepA, voffA);
            PG8_WAIT_V(8); PG8_WAIT_L(0); PG8_BAR; PG8_MMA(0, 0, At, B0); PG8_MMA(0, 1, At, B1); PG8_BAR; PG8_SCHED;
            PG8_LDA(At, 0, 1); PG8_STAGE(PG8_SB(0, 0), b2, voffB); PG8_STAGE(PG8_SB(0, 1), b2 + hstepB, voffB); PG8_STAGE(PG8_SA(0, 0), a2, voffA);
            PG8_WAIT_V(8); PG8_WAIT_L(0); PG8_BAR; PG8_MMA(1, 0, At, B0); PG8_MMA(1, 1, At, B1); PG8_BAR; PG8_SCHED;
            PG8_LDB(B0, 1, 0); PG8_LDB(B1, 1, 1); PG8_SCHED; PG8_LDA(At, 1, 0); PG8_STAGE(PG8_SA(0, 1), a2 + hstepA, voffA);
            PG8_WAIT_V(8); PG8_WAIT_L(0); PG8_BAR; PG8_MMA(0, 0, At, B0); PG8_MMA(0, 1, At, B1); PG8_BAR; PG8_SCHED;
            PG8_LDA(At, 1, 1); PG8_STAGE(PG8_SB(1, 0), b3, voffB); PG8_STAGE(PG8_SB(1, 1), b3 + hstepB, voffB); PG8_STAGE(PG8_SA(1, 0), a3, voffA);
            PG8_WAIT_V(8); PG8_WAIT_L(0); PG8_BAR; PG8_MMA(1, 0, At, B0); PG8_MMA(1, 1, At, B1); PG8_BAR; PG8_SCHED;
        }
        if constexpr (ALIGN_EPI) { if (wr == 0) PG8_BAR; }
        if constexpr (FP8) asm volatile("s_nop 15\n\ts_nop 15" ::: "memory");
        E(acc, cur, wr, wc, fr, fq);
        if (!has_next) break;
#pragma unroll
        for (int a = 0; a < 2; ++a)
#pragma unroll
            for (int b = 0; b < 2; ++b)
#pragma unroll
                for (int m = 0; m < 4; ++m)
#pragma unroll
                    for (int n = 0; n < 2; ++n) acc[a][b][m][n] = (f32x4){0.f, 0.f, 0.f, 0.f};
        cur = nxt; cA = nA; cB = nB; ++ui;
        if constexpr (ALIGN_EPI) { if (wr == 1) PG8_BAR; }
    }
    PG8_WAIT_V(0);
    if constexpr (!ALIGN_EPI) { if (wr == 0) PG8_BAR; }
    PG8_BAR;
#undef PG8_SA
#undef PG8_SB
#undef PG8_STAGE
#undef PG8_LDA
#undef PG8_LDB
#undef PG8_MMA
#undef PG8_CAT
#undef PG8_WAIT_V
#undef PG8_WAIT_L
#undef PG8_BAR
#undef PG8_SCHED
}
}

struct Args { const float* in[24]; float* out; unsigned char* ws; int ph_lo, ph_hi; };
enum { I_X = 0, I_ATTN_NORM, I_W_IN, I_POS_K, I_POS_V, I_W1K, I_W2K, I_W1V, I_W2V, I_CONV, I_ALOG, I_DTB, I_GNORM, I_SINKS, I_W_OUT, I_FFN_NORM,
       I_DGATE, I_DUP, I_DDOWN, I_ROUTER, I_MGATE, I_MUP, I_MDOWN, I_FINAL };
struct Frame {
    LAS unsigned char* lds;
    int tid, lane, wave, G, bid;
    float* out; unsigned char* ws;
    int wave0;
    DI void refresh() { int l = __builtin_amdgcn_mbcnt_hi(-1, __builtin_amdgcn_mbcnt_lo(-1, 0)); asm volatile("" : "+v"(l)); lane = l; wave = wave0; tid = wave0 * 64 + l; }
};

template <class F> DI void tr_item(const float* W, int ldw, int k0, bf16_t* dst, int K, LAS float* scr, int lane, F srccol, const float* rowgain = nullptr  ) {
    const int r = lane & 31; const int sc = srccol(r);
#pragma unroll 8
    for (int i = 0; i < 32; ++i) { const int kk = 2 * i + (lane >> 5); scr[kk * 33 + r] = sc >= 0 ? W[(size_t)(k0 + kk) * ldw + sc] * (rowgain ? rowgain[k0 + kk] : 1.f) : 0.f; }
    LDS_WAIT();
    const int c = lane & 7;
#pragma unroll
    for (int j = 0; j < 4; ++j) { const int n = (lane >> 3) + 8 * j; const LAS float* s = scr + (8 * c) * 33 + n;
        u32x4 o; o.x = pk2(s[0 * 33], s[1 * 33]); o.y = pk2(s[2 * 33], s[3 * 33]); o.z = pk2(s[4 * 33], s[5 * 33]); o.w = pk2(s[6 * 33], s[7 * 33]);
        *(u32x4*)(dst + (size_t)n * K + k0 + 8 * c) = o; }
    LDS_WAIT();
}
DI int win_srccol(int n) { return n < 1280 ? n : n < 5376 ? n + 12 : n < 6400 ? n + 28 : n < 6412 ? 1280 + (n - 6400) : n < 6428 ? 5388 + (n - 6412) : -1; }
DI void tr64_load(const float* src, int ldw, int lane, f32x4 (&v)[16]) { const int n4 = lane & 15, kr = lane >> 4;
#pragma unroll
    for (int i = 0; i < 16; ++i) v[i] = *(const f32x4*)(src + (size_t)(4 * i + kr) * ldw + 4 * n4); }
DI void tr64_stepA(f32x4 (&v)[16], LAS float* scr, int lane, const float* rowgain) { const int n4 = lane & 15, kr = lane >> 4;
    if (rowgain) {
#pragma unroll
        for (int i = 0; i < 16; ++i) v[i] *= rowgain[4 * i + kr]; }
#pragma unroll
    for (int i = 0; i < 16; ++i) { const int k = 4 * i + kr; *(LAS f32x4*)(scr + k * 64 + 4 * (n4 ^ ((k >> 3) & 7))) = v[i]; }
    LDS_WAIT(); }
DI void tr64_stepB(bf16_t* dst, int K, LAS float* scr, int lane) { const int c = lane & 7, nb = lane >> 3;
#pragma unroll
    for (int j = 0; j < 8; ++j) { const int n = nb + 8 * j; const LAS float* sp = scr + (8 * c) * 64 + (n ^ (c << 2));
        u32x4 o; o.x = cvt_pk_bf16(sp[0 * 64], sp[1 * 64]); o.y = cvt_pk_bf16(sp[2 * 64], sp[3 * 64]); o.z = cvt_pk_bf16(sp[4 * 64], sp[5 * 64]); o.w = cvt_pk_bf16(sp[6 * 64], sp[7 * 64]);
        *(u32x4*)(dst + (size_t)n * K + 8 * c) = o; }
    LDS_WAIT(); }
DI void tr_item64(const float* src, int ldw, bf16_t* dst, int K, LAS float* scr, int lane, const float* rowgain = nullptr  ) {
    const int n4 = lane & 15, kr = lane >> 4;
    f32x4 v[16];
#pragma unroll
    for (int i = 0; i < 16; ++i) v[i] = *(const f32x4*)(src + (size_t)(4 * i + kr) * ldw + 4 * n4);
    if (rowgain) {
#pragma unroll
        for (int i = 0; i < 16; ++i) v[i] *= rowgain[4 * i + kr]; }
#pragma unroll
    for (int i = 0; i < 16; ++i) { const int k = 4 * i + kr; *(LAS f32x4*)(scr + k * 64 + 4 * (n4 ^ ((k >> 3) & 7))) = v[i]; }
    LDS_WAIT();
    const int c = lane & 7, nb = lane >> 3;
#pragma unroll
    for (int j = 0; j < 8; ++j) { const int n = nb + 8 * j; const LAS float* sp = scr + (8 * c) * 64 + (n ^ (c << 2));
        u32x4 o; o.x = cvt_pk_bf16(sp[0 * 64], sp[1 * 64]); o.y = cvt_pk_bf16(sp[2 * 64], sp[3 * 64]); o.z = cvt_pk_bf16(sp[4 * 64], sp[5 * 64]); o.w = cvt_pk_bf16(sp[6 * 64], sp[7 * 64]);
        *(u32x4*)(dst + (size_t)n * K + 8 * c) = o; }
    LDS_WAIT();
}
constexpr int J_WIN = 32 * 100, J_WOUT = 32 * 32, J_GU = 32 * (GU / 64), J_DN = (DFF / 64) * (DM / 64);
constexpr int Q_TOTAL = NEXP * (J_GU + J_DN);
DI void tr_item64_f8(const float* src, int ldw, unsigned char* dst, int K, LAS float* scr, int lane) {
    const int n4 = lane & 15, kr = lane >> 4;
    f32x4 v[16];
#pragma unroll
    for (int i = 0; i < 16; ++i) v[i] = *(const f32x4*)(src + (size_t)(4 * i + kr) * ldw + 4 * n4);
#pragma unroll
    for (int i = 0; i < 16; ++i) { const int k = 4 * i + kr; *(LAS f32x4*)(scr + k * 64 + 4 * (n4 ^ ((k >> 3) & 7))) = v[i]; }
    LDS_WAIT();
    const int c = lane & 7, nb = lane >> 3;
#pragma unroll
    for (int j = 0; j < 8; ++j) { const int n = nb + 8 * j; const LAS float* sp = scr + (8 * c) * 64 + (n ^ (c << 2));
        int w0 = 0, w1 = 0;
        w0 = __builtin_amdgcn_cvt_pk_fp8_f32(sp[0 * 64] * 64.f, sp[1 * 64] * 64.f, w0, false); w0 = __builtin_amdgcn_cvt_pk_fp8_f32(sp[2 * 64] * 64.f, sp[3 * 64] * 64.f, w0, true);
        w1 = __builtin_amdgcn_cvt_pk_fp8_f32(sp[4 * 64] * 64.f, sp[5 * 64] * 64.f, w1, false); w1 = __builtin_amdgcn_cvt_pk_fp8_f32(sp[6 * 64] * 64.f, sp[7 * 64] * 64.f, w1, true);
        *(u32x2*)(dst + (size_t)n * K + 8 * c) = (u32x2){(unsigned)w0, (unsigned)w1}; }
    LDS_WAIT();
}
DI void moe_item(unsigned char* ws, const float* mgate, const float* mup, const float* mdown, int q, LAS float* scr, int lane) {
    const float* src; unsigned char* dst; int ldw, K;
    if (q < NEXP * J_GU) { const int e = q / J_GU, r = q % J_GU, nblk = GU / 64, pr_ = r >> 1, kb = 2 * (pr_ / nblk) + (r & 1), nb = pr_ % nblk;
        const int d0 = 64 * nb, j = d0 >> 8, half = (d0 >> 7) & 1, c0 = d0 & 127;
        src = (half ? mup : mgate) + (size_t)e * DM * DFF + (size_t)(64 * kb) * DFF + 128 * j + c0; ldw = DFF;
        dst = ws + WS_MGU + (size_t)e * GU * DM + (size_t)d0 * DM + 64 * kb; K = DM;
    } else { const int q2 = q - NEXP * J_GU, e = q2 / J_DN, r = q2 % J_DN, nblk = DM / 64, pr_ = r >> 1, kb = 2 * (pr_ / nblk) + (r & 1), nb = pr_ % nblk;
        src = mdown + (size_t)e * DFF * DM + (size_t)(64 * kb) * DM + 64 * nb; ldw = DM;
        dst = ws + WS_MDN + (size_t)e * DM * DFF + (size_t)(64 * nb) * DFF + 64 * kb; K = DFF; }
    tr_item64_f8(src, ldw, dst, K, scr, lane);
}
DI bool steal_convert(Frame& F, const float* mgate, const float* mup, const float* mdown) {
    volatile LAS int* qs = (volatile LAS int*)(F.lds + LDS_MISC) + 16;
    if (F.tid == 0) qs[0] = (int)atomicAdd((unsigned*)(F.ws + WS_CTL) + CW_QHEAD, 8u);
    __syncthreads();
    const int base = __builtin_amdgcn_readfirstlane(qs[0]);
    __syncthreads();
    if (base >= Q_TOTAL) return false;
    const int q = base + F.wave;
    if (q < Q_TOTAL) moe_item(F.ws, mgate, mup, mdown, q, (LAS float*)(F.lds + LDS_SCR + F.wave * 16384), F.lane);
    return true;
}
struct CvItem { const float* src; bf16_t* dst; int ldw, K; const float* gain; };
DI CvItem cv_decode(int it, unsigned char* ws, const float* w_in, const float* w_out, const float* dgate, const float* dup, const float* ddown,
                    const float* w1k, const float* w1v, const float* w2k, const float* w2v, const float* attn_norm1, const float* ffn_norm0) {
    constexpr int T0 = 2 * J_WIN, T1 = T0 + 2 * J_WOUT, T2 = T1 + J_GU, T3 = T2 + J_DN, T6 = T3 + 4 * 256;
        const float* src; bf16_t* dst; int ldw, K; const float* gain = nullptr;
        if (it >= T6) { const int q = it - T6, mi = q >> 3, r = q & 7, kb = r >> 1, nb = r & 1, L = mi >> 1, kv = mi & 1;
            src = (kv ? w2v : w2k) + (size_t)L * 256 * HD + (size_t)(64 * kb) * HD + 64 * nb; ldw = HD; dst = (bf16_t*)(ws + WS_CW2) + (size_t)mi * HD * 256 + (size_t)(64 * nb) * 256 + 64 * kb; K = 256;
        } else if (it >= T3) { const int q = it - T3, mi = q >> 8, r = q & 255, kb = r >> 2, nb = r & 3, L = mi >> 1, kv = mi & 1;
            src = (kv ? w1v : w1k) + (size_t)L * 4096 * 256 + (size_t)(64 * kb) * 256 + 64 * nb; ldw = 256; dst = (bf16_t*)(ws + WS_CW1) + (size_t)mi * 256 * 4096 + (size_t)(64 * nb) * 4096 + 64 * kb; K = 4096;
        } else if (it < T0) { const int L = it / J_WIN, r = it % J_WIN, kb = r / 100, nb = r % 100, nd = 64 * nb, ns = win_srccol(nd);
            src = w_in + (size_t)L * DM * DIN + (size_t)(64 * kb) * DIN + ns; ldw = DIN; dst = (bf16_t*)(ws + WS_WIN + L * SZ_WIN) + (size_t)nd * DM + 64 * kb; K = DM; if (L == 1) gain = attn_norm1 + 64 * kb;
        } else if (it < T1) { const int q = it - T0, L = q / J_WOUT, r = q % J_WOUT, kb = r / 32, nb = r % 32;
            src = w_out + (size_t)L * DM * DM + (size_t)(64 * kb) * DM + 64 * nb; ldw = DM; dst = (bf16_t*)(ws + WS_WOUT + L * SZ_WOUT) + (size_t)(64 * nb) * DM + 64 * kb; K = DM;
        } else if (it < T2) {
            const int r = it - T1, nblk = GU / 64, kb = r / nblk, nb = r % nblk;
            const int d0 = 64 * nb, j = d0 >> 8, half = (d0 >> 7) & 1, c0 = d0 & 127;
            src = (half ? dup : dgate) + (size_t)(64 * kb) * DFF + 128 * j + c0; ldw = DFF;
            dst = (bf16_t*)(ws + WS_DGU) + (size_t)d0 * DM + 64 * kb; K = DM; gain = ffn_norm0 + 64 * kb;
        } else { const int r = it - T2, nblk = DM / 64, kb = r / nblk, nb = r % nblk;
            src = ddown + (size_t)(64 * kb) * DM + 64 * nb; ldw = DM;
            dst = (bf16_t*)(ws + WS_DDN) + (size_t)(64 * nb) * DFF + 64 * kb; K = DFF;
        }
    return CvItem{src, dst, ldw, K, gain};
}
DI void phase_convert(Frame& F, const float* w_in, const float* w_out, const float* dgate, const float* dup, const float* ddown,
                      const float* w1k, const float* w1v, const float* w2k, const float* w2v, const float* attn_norm1, const float* ffn_norm0) {
    LAS float* scr = (LAS float*)(F.lds + LDS_SCR + F.wave * 16384);
    const int gw = F.bid * 8 + F.wave, NGW = F.G * 8;
    constexpr int T0 = 2 * J_WIN, T1 = T0 + 2 * J_WOUT, T2 = T1 + J_GU, T3 = T2 + J_DN, T6 = T3 + 4 * 256, T7 = T6 + 4 * 8;
    if (gw < T7) {
        f32x4 v[16];
        CvItem cur = cv_decode(gw, F.ws, w_in, w_out, dgate, dup, ddown, w1k, w1v, w2k, w2v, attn_norm1, ffn_norm0); tr64_load(cur.src, cur.ldw, F.lane, v);
#pragma unroll 1
        for (int it = gw; it < T7; it += NGW) {
            tr64_stepA(v, scr, F.lane, cur.gain);
            bf16_t* const cdst = cur.dst; const int cK = cur.K;
            if (it + NGW < T7) { cur = cv_decode(it + NGW, F.ws, w_in, w_out, dgate, dup, ddown, w1k, w1v, w2k, w2v, attn_norm1, ffn_norm0); tr64_load(cur.src, cur.ldw, F.lane, v); }
            tr64_stepB(cdst, cK, scr, F.lane);
        }
    }

    for (int it = gw; it < 2 * 32; it += NGW) { const int L = it / 32, kb = it % 32;
        tr_item(w_in + (size_t)L * DM * DIN, DIN, 64 * kb, (bf16_t*)(F.ws + WS_WIN + L * SZ_WIN) + (size_t)6400 * DM, DM, scr, F.lane, [&](int rr) { return win_srccol(6400 + rr); }, L == 1 ? attn_norm1 : nullptr); }
    for (int it = gw; it < 2 * 224; it += NGW) { const int L = it / 224, row = 6432 + it % 224; u32x4* d = (u32x4*)((bf16_t*)(F.ws + WS_WIN + L * SZ_WIN) + (size_t)row * DM);
#pragma unroll
        for (int j = 0; j < 4; ++j) d[F.lane + 64 * j] = (u32x4){0u, 0u, 0u, 0u}; }
}

DI void xcd_barrier_steal(const XcdBarrier& b, const bool leader, Frame& F, bool& qactive, const float* mgate, const float* mup, const float* mdown) {
    asm volatile("s_waitcnt vmcnt(0)" ::: "memory");
    __syncthreads();
    volatile LAS unsigned* fl = b.st + 2;
    if (leader) {
        unsigned* bar = b.bar;
        __builtin_amdgcn_s_waitcnt(0);
        unsigned nloc = b.st[0], nx = b.st[1];
        if (nloc == 0u) { xcd_barrier_complete(bar, b.x, nloc, nx); b.st[0] = nloc; b.st[1] = nx; }
        const unsigned old = xb_add(&bar[XB_XSUB(b.x)], 1u);
        const unsigned gen = old / nloc;
        if (old + 1u == (gen + 1u) * nloc) {
            __builtin_amdgcn_fence(__ATOMIC_RELEASE, "agent");
            asm volatile("s_waitcnt vmcnt(0)" ::: "memory");
            const unsigned og = xb_add(&bar[XB_TOP], 1u);
            const unsigned tg = og / nx;
            if (og + 1u == (tg + 1u) * nx) xb_add(&bar[XB_TOPGEN], 1u);
            else XB_SPIN(xb_ld(&bar[XB_TOPGEN]) == tg, bar);
            __builtin_amdgcn_fence(__ATOMIC_ACQUIRE, "agent");
            xb_add(&bar[XB_XGEN(b.x)], 1u);
            asm volatile("s_waitcnt vmcnt(0)" ::: "memory");
            fl[0] = 1u; fl[1] = 0xFFFFFFFFu;
        } else { fl[0] = 0u; fl[1] = gen; }
    }
    __syncthreads();
    bool released = fl[0] != 0u;
    const bool waited = !released;
    __syncthreads();
    while (!released) {
        bool more = false;
        if (qactive) { more = steal_convert(F, mgate, mup, mdown); if (!more) qactive = false; }
        if (leader) {
            unsigned* bar = b.bar; const unsigned gen = fl[1];
            if (more) { if (xb_ld(&bar[XB_XGEN(b.x)]) != gen || xb_ld(&bar[XB_TMO]) != 0u) fl[0] = 1u; }
            else { XB_SPIN(xb_ld(&bar[XB_XGEN(b.x)]) == gen, bar); fl[0] = 1u; }
        }
        __syncthreads();
        released = fl[0] != 0u;
        __syncthreads();
    }
    if (leader && waited) { asm volatile("s_waitcnt vmcnt(0)" ::: "memory"); __builtin_amdgcn_fence(__ATOMIC_ACQUIRE, "agent"); asm volatile("s_waitcnt vmcnt(0)" ::: "memory"); }
    __syncthreads();
}

template <bool ROUTER> DI void phase_norm(Frame& F, const float* x, const float* w, bf16_t* hb, const float* router) {
    LAS float* rl = (LAS float*)(F.lds + LDS_SCR);
    if (ROUTER) { for (int i = F.tid; i < DM * NEXP / 4; i += 512) ((LAS f32x4*)rl)[i ^ ((i >> 4) & 7)] = ((const f32x4*)router)[i]; __syncthreads(); }
    int* topi = (int*)(F.ws + WS_RT + RT_TOPI); float* topg = (float*)(F.ws + WS_RT + RT_TOPG);
    const int gw = F.bid * 8 + F.wave, NGW = F.G * 8;
    f32x4 vn[8];
    if (gw < NTOK) { const f32x4* xr = (const f32x4*)(x + (size_t)gw * DM) + F.lane;
#pragma unroll
        for (int j = 0; j < 8; ++j) vn[j] = xr[64 * j]; }
    for (int m = gw; m < NTOK; m += NGW) {
        f32x4 v[8]; float s = 0.f;
#pragma unroll
        for (int j = 0; j < 8; ++j) v[j] = vn[j];
        if (m + NGW < NTOK) { const f32x4* xr = (const f32x4*)(x + (size_t)(m + NGW) * DM) + F.lane;
#pragma unroll
            for (int j = 0; j < 8; ++j) vn[j] = xr[64 * j]; }
#pragma unroll
        for (int j = 0; j < 8; ++j) s += (v[j].x * v[j].x + v[j].y * v[j].y) + (v[j].z * v[j].z + v[j].w * v[j].w);
        const float rs = rsqrtf(wave_sum(s) * (1.f / DM) + EPS);
        float lg[NEXP];
        if (ROUTER) {
#pragma unroll
            for (int e = 0; e < NEXP; ++e) lg[e] = 0.f; }
        u32x2* o8 = (u32x2*)(hb + (size_t)m * DM) + F.lane;
#pragma unroll
        for (int j = 0; j < 8; ++j) { const f32x4 w4 = ((const f32x4*)w)[F.lane + 64 * j]; const f32x4 y = v[j] * rs * w4;
            u32x2 o; o.x = pk2(y.x, y.y); o.y = pk2(y.z, y.w); o8[64 * j] = o;
            if (ROUTER) {
#pragma unroll
                for (int i = 0; i < 4; ++i) { const int k = 4 * (F.lane + 64 * j) + i; const int sw = (k >> 3) & 7; const f32x4 r0 = ((const LAS f32x4*)rl)[(2 * k) ^ sw], r1 = ((const LAS f32x4*)rl)[(2 * k + 1) ^ sw]; const float yy = y[i];
                    lg[0] += yy * r0.x; lg[1] += yy * r0.y; lg[2] += yy * r0.z; lg[3] += yy * r0.w; lg[4] += yy * r1.x; lg[5] += yy * r1.y; lg[6] += yy * r1.z; lg[7] += yy * r1.w; }
                asm volatile("" ::: "memory"); } }
        if (ROUTER) {
#pragma unroll
            for (int e = 0; e < NEXP; ++e) lg[e] = wave_sum(lg[e]);
            int i1 = 0; float l1 = lg[0];
#pragma unroll
            for (int e = 1; e < NEXP; ++e) if (lg[e] > l1) { l1 = lg[e]; i1 = e; }
            int i2 = -1; float l2 = -3.0e38f;
#pragma unroll
            for (int e = 0; e < NEXP; ++e) if (e != i1 && lg[e] > l2) { l2 = lg[e]; i2 = e; }
            const float g1 = 1.f / (1.f + __expf(l2 - l1)), g2 = 1.f - g1;
            if (F.lane == 0) { topi[2 * m] = i1; topi[2 * m + 1] = i2; topg[2 * m] = g1; topg[2 * m + 1] = g2; }
        }
    }
    if (ROUTER) __syncthreads();
}

typedef float f32x16 __attribute__((ext_vector_type(16)));
typedef short s16x4 __attribute__((ext_vector_type(4)));
#define MFMA32(a, b, c) __builtin_amdgcn_mfma_f32_32x32x16_bf16((a), (b), (c), 0, 0, 0)
constexpr float LOG2E = 1.4426950408889634f;
DI unsigned off_b(unsigned row, unsigned ch) { return 256u * row + 16u * (ch ^ (((row & 3) << 2) | ((row >> 2) & 3))); }
DI float xhalf_other(float x) { const int l = __builtin_amdgcn_mbcnt_hi(-1, __builtin_amdgcn_mbcnt_lo(-1, 0)); return __builtin_bit_cast(float, __builtin_amdgcn_ds_bpermute((l ^ 32) << 2, __builtin_bit_cast(int, x))); }
DI float xhalf_max(float x) { return fmaxf(x, xhalf_other(x)); }
DI float xhalf_sum(float x) { return x + xhalf_other(x); }
struct FaState { f32x16 acc[4]; float m, l; };
DI void fa_reset(FaState& st) {
#pragma unroll
    for (int d = 0; d < 4; ++d)
#pragma unroll
        for (int i = 0; i < 16; ++i) st.acc[d][i] = 0.f;
    st.m = -1e30f; st.l = 0.f; }
DI void fa_issue(const bf16_t* K, const bf16_t* V, size_t stride, int k0, LAS unsigned char* kb, LAS unsigned char* vb, int wave, int lane) {
#pragma unroll
    for (int i = 0; i < 2; ++i) { const int pos = (wave + 8 * i) * 64 + lane, row = pos >> 4, ch = (pos & 15) ^ (((row & 3) << 2) | ((row >> 2) & 3));
        const size_t o = (size_t)(k0 + row) * stride + ch * 8;
        dma16(K + o, kb + (wave + 8 * i) * 1024);
        dma16(V + o, vb + (wave + 8 * i) * 1024); } }
#define FA_LANDED() do { asm volatile("s_waitcnt vmcnt(0)" ::: "memory"); __syncthreads(); } while (0)
template <int MODE> DI void fa_tile(FaState& st, const LAS unsigned char* qf  , const LAS unsigned char* kb, const LAS unsigned char* vbuf, int kbase, int vb4, int h,
                                    int k0, int ka, int kc, int qp, int window, float sc2, float sl2, bool lanevalid) {
    f32x16 s0, s1;
#pragma unroll
    for (int i = 0; i < 16; ++i) { s0[i] = 0.f; s1[i] = 0.f; }
#pragma unroll
    for (int s = 0; s < 8; ++s) { const bf16x8 a0 = *(const LAS bf16x8*)(kb + (kbase ^ (32 * s))), a1 = *(const LAS bf16x8*)(kb + (kbase ^ (32 * s)) + 8192);
        const bf16x8 qv = *(const LAS bf16x8*)(qf + 1024 * s);
        s0 = MFMA32(a0, qv, s0); s1 = MFMA32(a1, qv, s1);
        }
    float x[32]; float mx = -1e30f;
    const int kp0 = ka * (k0 + 4 * h) + kc;
    const int qw = __builtin_amdgcn_readfirstlane(qp & ~31);
    if (qw >= ka * (k0 + 63) + kc && qw + 31 - (ka * k0 + kc) < window) {
        const float base = lanevalid ? -sl2 * (float)(qp - kp0) : -1e30f, tk = sl2 * (float)ka;
#pragma unroll
        for (int mt = 0; mt < 2; ++mt)
#pragma unroll
            for (int i = 0; i < 16; ++i) { const float sv = mt ? s1[i] : s0[i]; const float xv = __builtin_fmaf((float)(32 * mt + (i & 3) + 8 * (i >> 2)), tk, __builtin_fmaf(sv, sc2, base)); x[mt * 16 + i] = xv; mx = fmaxf(mx, xv); }
    } else {
#pragma unroll
        for (int mt = 0; mt < 2; ++mt)
#pragma unroll
            for (int i = 0; i < 16; ++i) { const int dist = qp - (kp0 + ka * (32 * mt + (i & 3) + 8 * (i >> 2))); const bool ok = lanevalid && dist >= 0 && dist < window;
                const float sv = mt ? s1[i] : s0[i]; const float xv = ok ? sv * sc2 - sl2 * (float)dist : -1e30f; x[mt * 16 + i] = xv; mx = fmaxf(mx, xv); }
    }
    if (MODE == 1) {
#pragma unroll
        for (int mt = 0; mt < 2; ++mt)
#pragma unroll
            for (int g4 = 0; g4 < 4; ++g4) { float pp[4];
#pragma unroll
                for (int e = 0; e < 4; ++e) { const float xv = x[mt * 16 + 4 * g4 + e]; pp[e] = xv > -1e29f ? exp2f(xv - st.m) * st.l : 0.f; }
                const float av = (pp[0] + pp[1]) + (pp[2] + 0.5f * pp[3]), bv = 0.5f * pp[3];
                if (k0 == 0) { st.acc[0][2 * (mt * 4 + g4)] = av; st.acc[0][2 * (mt * 4 + g4) + 1] = bv; } else { st.acc[1][2 * (mt * 4 + g4)] = av; st.acc[1][2 * (mt * 4 + g4) + 1] = bv; } }
        return;
    }
    mx = xhalf_max(mx);
    const float mn = fmaxf(st.m, mx), alpha = __builtin_amdgcn_exp2f(st.m - mn), mne = fmaxf(mn, -1e28f);
    float ls = 0.f;
#pragma unroll
    for (int i = 0; i < 32; ++i) { const float pv = __builtin_amdgcn_exp2f(x[i] - mne); x[i] = pv; ls += pv; }
    const bool moved = __builtin_amdgcn_ballot_w64(mn > st.m) != 0ull;
    st.l = st.l * alpha + ls; st.m = mn;
    if (moved) {
#pragma unroll
        for (int d = 0; d < 4; ++d)
#pragma unroll
            for (int i = 0; i < 16; ++i) st.acc[d][i] *= alpha;
    }
#pragma unroll
    for (int mt = 0; mt < 2; ++mt)
#pragma unroll
        for (int s2 = 0; s2 < 2; ++s2) {
            u32x4 pw; const int o = mt * 16 + 8 * s2;
            pw.x = cvt_pk_bf16(x[o + 0], x[o + 1]); pw.y = cvt_pk_bf16(x[o + 2], x[o + 3]); pw.z = cvt_pk_bf16(x[o + 4], x[o + 5]); pw.w = cvt_pk_bf16(x[o + 6], x[o + 7]);
            const bf16x8 pf = __builtin_bit_cast(bf16x8, pw);
#pragma unroll
            for (int dt = 0; dt < 4; ++dt) {
                const s16x4 t0 = __builtin_amdgcn_ds_read_tr16_b64_v4i16((LAS s16x4*)(vbuf + ((vb4 ^ (64 * dt)) + 8192 * mt + 4096 * s2)));
                const s16x4 t1 = __builtin_amdgcn_ds_read_tr16_b64_v4i16((LAS s16x4*)(vbuf + ((vb4 ^ (64 * dt + 32)) + 8192 * mt + 4096 * s2 + 2048)));
                const bf16x8 vf = {t0[0], t0[1], t0[2], t0[3], t1[0], t1[1], t1[2], t1[3]};
                st.acc[dt] = MFMA32(vf, pf, st.acc[dt]); }
        }
}
struct FaLane { int r, h, kbase, vb4; };
DI FaLane fa_lane(int lane) { FaLane L; L.r = lane & 31; L.h = lane >> 5;
    L.kbase = 256 * L.r + 16 * (L.h ^ (((L.r & 3) << 2) | ((L.r >> 2) & 3)));
    const int q = (lane & 15) >> 2, p = lane & 3, blk = (lane >> 4) & 1, lowx = (2 * blk + (p >> 1)) ^ L.h;
    L.vb4 = 1024 * L.h + 256 * q + 64 * q + 16 * lowx + 8 * (p & 1); return L; }

DI void swa_unit(Frame& F, const float* sinks, int u) {
    const int qt = u & 15, g = (u >> 4) & 1, b = u >> 5;
    int tid = F.tid; asm volatile("" : "+v"(tid)); const int lane = tid & 63, wave = __builtin_amdgcn_readfirstlane(tid >> 6);
    const FaLane L = fa_lane(lane);
    const bf16_t* proj = (const bf16_t*)(F.ws + WS_PROJ) + (size_t)b * SEQ * DINP;
    const int head = g * 2 + (wave >> 2), qp = 128 * qt + 32 * (wave & 3) + L.r;
    LAS unsigned char* buf = F.lds + LDS_SCR;
    LAS unsigned char* qf = F.lds + LDS_SCR + 65536 + wave * 8192 + lane * 16;
    { const bf16_t* qrow = proj + (size_t)qp * DINP + C_SQ + head * HD + 8 * L.h;
#pragma unroll
      for (int s = 0; s < 8; ++s) *(LAS bf16x8*)(qf + 1024 * s) = *(const bf16x8*)(qrow + 16 * s); }
    const float sl2 = exp2f(-(float)(head + 1)) * LOG2E, sc2 = QSCALE * LOG2E;
    const bf16_t* K = proj + C_SK + g * HD; const bf16_t* V = proj + C_SV + g * HD;
    FaState st; fa_reset(st);
    const int t_lo = 2 * qt - 2 > 0 ? 2 * qt - 2 : 0, t_hi = 2 * qt + 1;
    int cur = 0;
    fa_issue(K, V, DINP, 64 * t_hi, buf, buf + 16384, wave, lane);
    for (int t = t_hi; t >= t_lo; --t) {
        FA_LANDED();
        if (t > t_lo) fa_issue(K, V, DINP, 64 * (t - 1), buf + (cur ^ 1) * 32768, buf + (cur ^ 1) * 32768 + 16384, wave, lane);
        fa_tile<0>(st, qf, buf + cur * 32768, buf + cur * 32768 + 16384, L.kbase, L.vb4, L.h, 64 * t, 1, 0, qp, 128, sc2, sl2, true);
        cur ^= 1;
    }
    const float ltot = xhalf_sum(st.l) + exp2f(sinks[head] * LOG2E - st.m); const float inv = 1.f / ltot;
    bf16_t* orow = (bf16_t*)(F.ws + WS_MIX) + (size_t)(b * SEQ + qp) * DM + 1536 + head * HD + 4 * L.h;
#pragma unroll
    for (int dt = 0; dt < 4; ++dt)
#pragma unroll
        for (int g4 = 0; g4 < 4; ++g4) { u32x2 w; w.x = cvt_pk_bf16(st.acc[dt][4 * g4] * inv, st.acc[dt][4 * g4 + 1] * inv); w.y = cvt_pk_bf16(st.acc[dt][4 * g4 + 2] * inv, st.acc[dt][4 * g4 + 3] * inv);
            *(u32x2*)(orow + 32 * dt + 8 * g4) = w; }
    __syncthreads();
}

DI void nsa_unit(Frame& F, int u) {
    const int qt = 31 - (u & 31), b = u >> 5;
    int tid = F.tid; asm volatile("" : "+v"(tid)); const int lane = tid & 63, wave = __builtin_amdgcn_readfirstlane(tid >> 6);
    const FaLane L = fa_lane(lane);
    const bf16_t* proj = (const bf16_t*)(F.ws + WS_PROJ) + (size_t)b * SEQ * DINP;
    const int head = wave >> 1, ql = 32 * (wave & 1) + L.r, qp = 64 * qt + ql;
    LAS unsigned char* buf = F.lds + LDS_SCR;
    LAS unsigned char* qf = F.lds + LDS_SCR + 65536 + wave * 8192 + lane * 16;
    LAS float* imp = (LAS float*)(F.lds + LDS_SCR + 131072);
    LAS unsigned* selm = (LAS unsigned*)(F.lds + LDS_SCR + 131072 + 2 * 64 * 33 * 4);
    if (tid == 0) selm[64] = 0u;
    { const bf16_t* qrow = proj + (size_t)qp * DINP + C_NQ + head * HD + 8 * L.h;
#pragma unroll
      for (int s = 0; s < 8; ++s) *(LAS bf16x8*)(qf + 1024 * s) = *(const bf16x8*)(qrow + 16 * s); }
    const float sl2 = exp2f(-(float)(5 + head)) * LOG2E, sc2 = QSCALE * LOG2E;
    float* orow = (float*)(F.ws + WS_NSAO) + (size_t)(b * SEQ + qp) * 512 + head * HD + 4 * L.h;
    LAS float* impA = imp + (head * 64 + ql) * 33; LAS float* impB = impA + 4 * 64 * 33;
    FaState st; fa_reset(st);
    unsigned mysel = 0u; int cur = 0;
    const bf16_t gr0 = proj[(size_t)qp * DINP + C_NG + head], gr1 = proj[(size_t)qp * DINP + C_NG + 4 + head], gr2 = proj[(size_t)qp * DINP + C_NG + 8 + head];
    __syncthreads();
#pragma unroll 1
    for (int br = 0; br < 4; ++br) {
        const bool cmpb = br < 2;
        const bf16_t* K = cmpb ? (const bf16_t*)(F.ws + WS_KC) + (size_t)b * 128 * HD : proj + (br == 2 ? C_KSL : C_KW);
        const bf16_t* V = cmpb ? (const bf16_t*)(F.ws + WS_KC) + (size_t)(NB + b) * 128 * HD : proj + (br == 2 ? C_VSL : C_VW);
        const size_t stride = cmpb ? HD : DINP;
        const int ka = cmpb ? 16 : 1, kc = cmpb ? 31 : 0, window = br == 3 ? 512 : (1 << 30);
        unsigned tmask;
        if (cmpb) tmask = (4 * qt + 3 > 64) ? 3u : 1u;
        else if (br == 2) tmask = selm[64];
        else { const int lo = qt - 8 > 0 ? qt - 8 : 0; tmask = (qt == 31 ? 0xFFFFFFFFu : ((1u << (qt + 1)) - 1u)) & ~((1u << lo) - 1u); }
        tmask = __builtin_amdgcn_readfirstlane(tmask);
        if (tmask) fa_issue(K, V, stride, 64 * (31 - __builtin_clz(tmask)), buf + cur * 32768, buf + cur * 32768 + 16384, wave, lane);
        while (tmask) {
            const int j = 31 - __builtin_clz(tmask); tmask &= ~(1u << j);
            FA_LANDED();
            if (tmask) fa_issue(K, V, stride, 64 * (31 - __builtin_clz(tmask)), buf + (cur ^ 1) * 32768, buf + (cur ^ 1) * 32768 + 16384, wave, lane);
            const bool lv = br == 2 ? ((mysel >> j) & 1u) != 0u : true;
            if (br == 1) fa_tile<1>(st, qf, buf + cur * 32768, buf + cur * 32768 + 16384, L.kbase, L.vb4, L.h, 64 * j, ka, kc, qp, window, sc2, sl2, lv);
            else fa_tile<0>(st, qf, buf + cur * 32768, buf + cur * 32768 + 16384, L.kbase, L.vb4, L.h, 64 * j, ka, kc, qp, window, sc2, sl2, lv);
            cur ^= 1;
        }
        if (br == 1) {
#pragma unroll 1
            for (int hd = 0; hd < 4; ++hd) {
                if (head == hd) { LAS float* ia = imp + ql * 33; LAS float* ib = ia + 64 * 33;
#pragma unroll
                    for (int tl = 0; tl < 2; ++tl)
#pragma unroll
                        for (int g = 0; g < 8; ++g) { const int j = 16 * tl + 2 * g + L.h; const float av = st.acc[tl][2 * g], bv = st.acc[tl][2 * g + 1];
                            if (hd == 0) { ia[j] = av; ib[j + 1] = bv; } else { ia[j] += av; ib[j + 1] += bv; } }
                    if (hd == 0 && L.h == 0) ib[0] = 0.f; }
                __syncthreads();
            }
            if (tid < 64) {
                float sc[32];
                int qv = qt; asm volatile("" : "+v"(qv));
#pragma unroll
                for (int j = 0; j < 32; ++j) { float a = 0.f;
                    a = imp[tid * 33 + j] + imp[64 * 33 + tid * 33 + j];
                    const bool forced = (j == 0) || (j == qv) || (j == qv - 1);
                    sc[j] = (j <= qv) ? a + (forced ? 1000.f : 0.f) : -1.f; }
                unsigned m = 0u;
#pragma unroll 1
                for (int r = 0; r < 8; ++r) { float best = sc[0]; int bi = 0;
#pragma unroll
                    for (int j = 1; j < 32; ++j) if (sc[j] > best) { best = sc[j]; bi = j; }
                    if (best >= 0.f) m |= 1u << bi;
#pragma unroll
                    for (int j = 0; j < 32; ++j) sc[j] = (j == bi) ? -3.f : sc[j]; }
                selm[tid] = m; atomicOr((unsigned*)(selm + 64), m);
            }
            __syncthreads();
            mysel = selm[ql];
            fa_reset(st);
            continue;
        }
        const float ltot = xhalf_sum(st.l); const float inv = ltot > 0.f ? 1.f / ltot : 0.f;
        const int gi = br == 0 ? 0 : br - 1;
        const float gate = sigmoidf_(bf2f(gi == 0 ? gr0 : gi == 1 ? gr1 : gr2)) * inv;
        if (br == 0) {
#pragma unroll
            for (int dt = 0; dt < 4; ++dt)
#pragma unroll
                for (int g4 = 0; g4 < 4; ++g4) { f32x4 o; o.x = st.acc[dt][4 * g4] * gate; o.y = st.acc[dt][4 * g4 + 1] * gate; o.z = st.acc[dt][4 * g4 + 2] * gate; o.w = st.acc[dt][4 * g4 + 3] * gate;
                    *(f32x4*)(orow + 32 * dt + 8 * g4) = o; }
            st.l = inv;
#pragma unroll
            for (int d = 0; d < 4; ++d)
#pragma unroll
                for (int i = 0; i < 16; ++i) st.acc[d][i] = 0.f;
        } else if (br == 2) {
#pragma unroll
            for (int dt = 0; dt < 4; ++dt)
#pragma unroll
                for (int g4 = 0; g4 < 4; ++g4) { f32x4 o = *(const f32x4*)(orow + 32 * dt + 8 * g4); o.x += st.acc[dt][4 * g4] * gate; o.y += st.acc[dt][4 * g4 + 1] * gate; o.z += st.acc[dt][4 * g4 + 2] * gate; o.w += st.acc[dt][4 * g4 + 3] * gate;
                    *(f32x4*)(orow + 32 * dt + 8 * g4) = o; }
            fa_reset(st);
        } else {
            bf16_t* mrow = (bf16_t*)(F.ws + WS_MIX) + (size_t)(b * SEQ + qp) * DM + head * HD + 4 * L.h;
#pragma unroll
            for (int dt = 0; dt < 4; ++dt)
#pragma unroll
                for (int g4 = 0; g4 < 4; ++g4) { const f32x4 o = *(const f32x4*)(orow + 32 * dt + 8 * g4);
                    u32x2 w; w.x = cvt_pk_bf16(o.x + st.acc[dt][4 * g4] * gate, o.y + st.acc[dt][4 * g4 + 1] * gate); w.y = cvt_pk_bf16(o.z + st.acc[dt][4 * g4 + 2] * gate, o.w + st.acc[dt][4 * g4 + 3] * gate);
                    *(u32x2*)(mrow + 32 * dt + 8 * g4) = w; }
        }
    }
    __syncthreads();
}

DI void cmp_unit_mfma(Frame& F, int u, int layer, const float* posk, const float* posv) {
    const int mt = u & 3, b = (u >> 2) & 3, kv = u >> 4;
    int tid = F.tid; asm volatile("" : "+v"(tid)); const int lane = tid & 63, wave = __builtin_amdgcn_readfirstlane(tid >> 6), r = lane & 31, hh = lane >> 5;
    const bf16_t* proj = (const bf16_t*)(F.ws + WS_PROJ) + (size_t)b * SEQ * DINP + (kv ? C_VC : C_KC);
    const bf16_t* w1t = (const bf16_t*)(F.ws + WS_CW1) + (size_t)(layer * 2 + kv) * 256 * 4096;
    const bf16_t* w2t = (const bf16_t*)(F.ws + WS_CW2) + (size_t)(layer * 2 + kv) * HD * 256;
    const float* pos = kv ? posv : posk;
    LAS unsigned char* bufs = F.lds + LDS_SCR;
    const int srow = tid >> 4, sch = tid & 15;
    const int tokb = 16 * (32 * mt + srow);
    const unsigned sslot = (unsigned)srow * 256u + (unsigned)((sch ^ (srow & 15)) * 16);
    u32x4 pa;
#define CMP_LOADA(j) do { const int tk_ = tokb + (j) < SEQ ? tokb + (j) : SEQ - 1; pa = *(const u32x4*)(proj + (size_t)tk_ * DINP + 8 * sch); } while (0)
#define CMP_ISSUEB(j, bb_) do { _Pragma("unroll") for (int i_ = 0; i_ < 8; ++i_) { const int pc_ = wave + 8 * i_, row_ = 4 * pc_ + (lane >> 4), ch_ = (lane & 15) ^ (row_ & 15); \
        dma16(w1t + (size_t)row_ * 4096 + (j) * 128 + 8 * ch_, (bb_) + pc_ * 1024); } } while (0)
    CMP_LOADA(0); CMP_ISSUEB(0, bufs + 8192);
    f32x16 acc;
#pragma unroll
    for (int i = 0; i < 16; ++i) acc[i] = 0.f;
#pragma unroll 1
    for (int j = 0; j < 32; ++j) {
        LAS unsigned char* ab = bufs + (j & 1) * 73728; LAS unsigned char* bb = ab + 8192;
        { const f32x4 p0 = *(const f32x4*)(pos + j * 128 + 8 * sch), p1 = *(const f32x4*)(pos + j * 128 + 8 * sch + 4);
          u32x4 aw; aw.x = cvt_pk_bf16(bflo(pa.x) + p0.x, bfhi(pa.x) + p0.y); aw.y = cvt_pk_bf16(bflo(pa.y) + p0.z, bfhi(pa.y) + p0.w);
          aw.z = cvt_pk_bf16(bflo(pa.z) + p1.x, bfhi(pa.z) + p1.y); aw.w = cvt_pk_bf16(bflo(pa.w) + p1.z, bfhi(pa.w) + p1.w);
          *(LAS u32x4*)(ab + sslot) = aw; }
        FA_LANDED();
        if (j < 31) { CMP_LOADA(j + 1); CMP_ISSUEB(j + 1, bufs + ((j + 1) & 1) * 73728 + 8192); }
#pragma unroll
        for (int s = 0; s < 8; ++s) { const bf16x8 a = *(const LAS bf16x8*)(ab + r * 256 + (((2 * s + hh) ^ (r & 15)) * 16)); const bf16x8 bw = *(const LAS bf16x8*)(bb + (32 * wave + r) * 256 + (((2 * s + hh) ^ (r & 15)) * 16));
            acc = MFMA32(a, bw, acc); }
    }
#undef CMP_LOADA
#undef CMP_ISSUEB
    __syncthreads();
    LAS unsigned char* h1 = bufs;
    { const int o = 32 * wave + r;
#pragma unroll
      for (int i = 0; i < 16; ++i) { const int nl = (i & 3) + 8 * (i >> 2) + 4 * hh; *(LAS bf16_t*)(h1 + nl * 512 + (((o >> 3) ^ (nl & 15)) * 16) + (o & 7) * 2) = (bf16_t)f2bf(siluf_(acc[i])); } }
    __syncthreads();
    if (wave < 4) {
        f32x16 a2;
#pragma unroll
        for (int i = 0; i < 16; ++i) a2[i] = 0.f;
        const bf16_t* b2 = w2t + (size_t)(32 * wave + r) * 256 + 8 * hh;
#pragma unroll
        for (int s = 0; s < 16; ++s) { const bf16x8 a = *(const LAS bf16x8*)(h1 + r * 512 + (((2 * s + hh) ^ (r & 15)) * 16)); const bf16x8 bb2 = *(const bf16x8*)(b2 + 16 * s); a2 = MFMA32(a, bb2, a2); }
        bf16_t* outb = (bf16_t*)(F.ws + WS_KC) + ((size_t)(kv * NB + b) * 128) * HD + 32 * wave + r;
#pragma unroll
        for (int i = 0; i < 16; ++i) { const int n = 32 * mt + (i & 3) + 8 * (i >> 2) + 4 * hh; outb[(size_t)n * HD] = (bf16_t)(n < 127 ? f2bf(a2[i]) : 0u); }
    }
    __syncthreads();
}

#define MFMA16(a, b, c) __builtin_amdgcn_mfma_f32_16x16x32_bf16((a), (b), (c), 0, 0, 0)
DI float row16_sum(float v) { v += DPPF(v, 0xB1); v += DPPF(v, 0x4E); v += DPPF(v, 0x141); v += DPPF(v, 0x140); return v; }
DI void gdn_chunk_mfma(Frame& F, int u, const float* cw, const float* alog, const float* dtb) {
    const int n = u & 31, h = (u >> 5) & 7, b = u >> 8, bh = b * NGH + h, t0 = n * 64;
    int tid = F.tid; asm volatile("" : "+v"(tid)); const int lane = tid & 63, wave = __builtin_amdgcn_readfirstlane(tid >> 6);
    const bf16_t* proj = (const bf16_t*)(F.ws + WS_PROJ) + (size_t)b * SEQ * DINP;
    LAS float* kf = (LAS float*)(F.lds + LDS_SCR);
    LAS float* vf = kf + 64 * 132;
    LAS float* Ls = vf + 64 * 132;
    LAS unsigned char* qb = (LAS unsigned char*)(Ls + 64 * 68);
    LAS unsigned char* kb = qb + 16384;
    LAS float* gcs = (LAS float*)(kb + 16384);
    LAS float* bts = gcs + 64;
    LAS float* egs = bts + 64;
    LAS float* sc1 = egs + 64;
    const size_t cidx = (size_t)bh * 32 + n;
    unsigned char* gW = F.ws + WS_GW + cidx * 57344; unsigned char* gQ = gW + 16384; unsigned char* gK = gW + 32768; unsigned char* gA = gW + 49152;
    float* gU = (float*)(F.ws + WS_GU_) + cidx * 8192;
    const int ch = tid & 15, sg = (tid >> 4) & 7, mat = tid >> 7;
    float w[4][8]; u32x4 rows[8], rp[3] = {{0u, 0u, 0u, 0u}, {0u, 0u, 0u, 0u}, {0u, 0u, 0u, 0u}};
    if (tid < 384) {
        const int col = (mat == 0 ? C_GQ : mat == 1 ? C_GK : C_GV) + h * HD + 8 * ch;
#pragma unroll
        for (int j = 0; j < 4; ++j) { const f32x4 a = *(const f32x4*)(cw + j * 3072 + mat * 1024 + h * HD + 8 * ch), c = *(const f32x4*)(cw + j * 3072 + mat * 1024 + h * HD + 8 * ch + 4);
            w[j][0] = a.x; w[j][1] = a.y; w[j][2] = a.z; w[j][3] = a.w; w[j][4] = c.x; w[j][5] = c.y; w[j][6] = c.z; w[j][7] = c.w; }
        const int tb = t0 + 8 * sg;
        if (tb - 3 >= 0) rp[0] = *(const u32x4*)(proj + (size_t)(tb - 3) * DINP + col);
        if (tb - 2 >= 0) rp[1] = *(const u32x4*)(proj + (size_t)(tb - 2) * DINP + col);
        if (tb - 1 >= 0) rp[2] = *(const u32x4*)(proj + (size_t)(tb - 1) * DINP + col);
#pragma unroll
        for (int ii = 0; ii < 8; ++ii) rows[ii] = *(const u32x4*)(proj + (size_t)(tb + ii) * DINP + col);
    }
    if (tid < 64) {
        const bf16_t* pr = proj + (size_t)(t0 + tid) * DINP;
        const float a = bf2f(pr[C_GA + h]), bb = bf2f(pr[C_GB + h]);
        float g = -__expf(alog[h]) * softplusf_(a + dtb[h]);
        g += DPPF(g, 0x111); g += DPPF(g, 0x112); g += DPPF(g, 0x114); g += DPPF(g, 0x118);
        { const float r0 = __builtin_bit_cast(float, __builtin_amdgcn_readlane(__builtin_bit_cast(int, g), 15)), r1 = __builtin_bit_cast(float, __builtin_amdgcn_readlane(__builtin_bit_cast(int, g), 31)),
                      r2 = __builtin_bit_cast(float, __builtin_amdgcn_readlane(__builtin_bit_cast(int, g), 47));
          g += (lane >= 48) ? (r0 + r1) + r2 : (lane >= 32) ? r0 + r1 : (lane >= 16) ? r0 : 0.f; }
        const float be = sigmoidf_(bb), eg = __expf(g);
        gcs[tid] = g; bts[tid] = be; egs[tid] = eg; sc1[tid] = be * eg;
    }
    __syncthreads();
    const float gl = gcs[63];
    if (tid < 384) {
        float x0[8] = {bflo(rp[0].x), bfhi(rp[0].x), bflo(rp[0].y), bfhi(rp[0].y), bflo(rp[0].z), bfhi(rp[0].z), bflo(rp[0].w), bfhi(rp[0].w)};
        float x1[8] = {bflo(rp[1].x), bfhi(rp[1].x), bflo(rp[1].y), bfhi(rp[1].y), bflo(rp[1].z), bfhi(rp[1].z), bflo(rp[1].w), bfhi(rp[1].w)};
        float x2[8] = {bflo(rp[2].x), bfhi(rp[2].x), bflo(rp[2].y), bfhi(rp[2].y), bflo(rp[2].z), bfhi(rp[2].z), bflo(rp[2].w), bfhi(rp[2].w)};
#pragma unroll
        for (int ii = 0; ii < 8; ++ii) {
            const int i = 8 * sg + ii;
            const u32x4 r = rows[ii];
            float x3[8] = {bflo(r.x), bfhi(r.x), bflo(r.y), bfhi(r.y), bflo(r.z), bfhi(r.z), bflo(r.w), bfhi(r.w)};
            float y[8]; float ss = 0.f;
#pragma unroll
            for (int e = 0; e < 8; ++e) { y[e] = siluf_(x0[e] * w[0][e] + x1[e] * w[1][e] + x2[e] * w[2][e] + x3[e] * w[3][e]); ss += y[e] * y[e]; x0[e] = x1[e]; x1[e] = x2[e]; x2[e] = x3[e]; }
            ss = row16_sum(ss);
            const unsigned slot = (unsigned)i * 256u + (unsigned)((ch ^ (i & 15)) * 16);
            if (mat == 0) { const float sc = rsqrtf(ss + EPS) * QSCALE, eg = egs[i];
                u32x4 o, od; o.x = cvt_pk_bf16(y[0] * sc, y[1] * sc); o.y = cvt_pk_bf16(y[2] * sc, y[3] * sc); o.z = cvt_pk_bf16(y[4] * sc, y[5] * sc); o.w = cvt_pk_bf16(y[6] * sc, y[7] * sc);
                const float s2 = sc * eg; od.x = cvt_pk_bf16(y[0] * s2, y[1] * s2); od.y = cvt_pk_bf16(y[2] * s2, y[3] * s2); od.z = cvt_pk_bf16(y[4] * s2, y[5] * s2); od.w = cvt_pk_bf16(y[6] * s2, y[7] * s2);
                *(LAS u32x4*)(qb + slot) = o;
                { const int dc = 4 * (ch >> 2) + 2 * (ch & 1), hb = 8 * ((ch & 3) >> 1);
                  *(u32x2*)(gQ + (unsigned)i * 256u + (unsigned)(((dc) ^ (i & 15)) * 16 + hb)) = (u32x2){od.x, od.y}; *(u32x2*)(gQ + (unsigned)i * 256u + (unsigned)(((dc + 1) ^ (i & 15)) * 16 + hb)) = (u32x2){od.z, od.w}; }
            } else if (mat == 1) { const float sc = rsqrtf(ss + EPS);
                u32x4 o; o.x = cvt_pk_bf16(y[0] * sc, y[1] * sc); o.y = cvt_pk_bf16(y[2] * sc, y[3] * sc); o.z = cvt_pk_bf16(y[4] * sc, y[5] * sc); o.w = cvt_pk_bf16(y[6] * sc, y[7] * sc);
                *(LAS u32x4*)(kb + slot) = o;
                *(LAS f32x4*)(kf + i * 132 + 8 * ch) = (f32x4){y[0] * sc, y[1] * sc, y[2] * sc, y[3] * sc}; *(LAS f32x4*)(kf + i * 132 + 8 * ch + 4) = (f32x4){y[4] * sc, y[5] * sc, y[6] * sc, y[7] * sc};
            } else {
                *(LAS f32x4*)(vf + i * 132 + 8 * ch) = (f32x4){y[0], y[1], y[2], y[3]}; *(LAS f32x4*)(vf + i * 132 + 8 * ch + 4) = (f32x4){y[4], y[5], y[6], y[7]}; }
        }
    }
    __syncthreads();
    {
        const int ti = (wave >> 1) & 1, tj = wave & 1, r = lane & 31, hh = lane >> 5;
        const LAS unsigned char* ab = (wave < 4) ? kb : qb;
        f32x16 c;
#pragma unroll
        for (int i = 0; i < 16; ++i) c[i] = 0.f;
        const int ra = 32 * ti + r, rb = 32 * tj + r;
#pragma unroll
        for (int s = 0; s < 8; ++s) { const bf16x8 a = *(const LAS bf16x8*)(ab + ra * 256 + (((2 * s + hh) ^ (ra & 15)) * 16)), bb = *(const LAS bf16x8*)(kb + rb * 256 + (((2 * s + hh) ^ (rb & 15)) * 16));
            c = MFMA32(a, bb, c); }
        const int j = 32 * tj + r; const float gcj = gcs[j];
#pragma unroll
        for (int rg = 0; rg < 16; ++rg) { const int i = 32 * ti + (rg & 3) + 8 * (rg >> 2) + 4 * hh; const float dec = __expf(fminf(gcs[i] - gcj, 0.f));
            if (wave < 4) Ls[i * 68 + j] = (j < i) ? bts[i] * c[rg] * dec : 0.f;
            else { const float av = (j <= i) ? c[rg] * dec : 0.f; const int jp = (j & 32) + 8 * ((j >> 2) & 3) + 4 * ((j >> 4) & 1) + (j & 3);
                *(bf16_t*)(gA + (size_t)(i * 8 + ((jp >> 3) ^ ((i >> 1) & 7))) * 16 + (jp & 7) * 2) = (bf16_t)f2bf(av); } }
    }
    for (int x = tid; x < 1024; x += 512) { const int k = x >> 3, ch = x & 7; float v8[8];
#pragma unroll
        for (int e = 0; e < 8; ++e) { const int c = 8 * ch + e; v8[e] = kf[c * 132 + k] * __expf(gl - gcs[c]); }
        u32x4 o; o.x = cvt_pk_bf16(v8[0], v8[1]); o.y = cvt_pk_bf16(v8[2], v8[3]); o.z = cvt_pk_bf16(v8[4], v8[5]); o.w = cvt_pk_bf16(v8[6], v8[7]);
        { const int dc = 4 * (ch >> 2) + 2 * (ch & 1), hb = 8 * ((ch & 3) >> 1);
          *(u32x2*)(gK + (unsigned)k * 128u + (unsigned)(((dc) ^ ((k >> 1) & 7)) * 16 + hb)) = (u32x2){o.x, o.y}; *(u32x2*)(gK + (unsigned)k * 128u + (unsigned)(((dc + 1) ^ ((k >> 1) & 7)) * 16 + hb)) = (u32x2){o.z, o.w}; } }
    if (tid == 0) ((float*)(F.ws + WS_GGL))[cidx] = __expf(gl);
    __syncthreads();
    LAS unsigned char* loff = (LAS unsigned char*)(sc1 + 64);
    LAS unsigned char* dinv = loff + 8192;
    { const int r = tid >> 3, cq = tid & 7, s2 = cq >> 2, qq = cq & 3;
      const f32x4 a = *(const LAS f32x4*)(Ls + r * 68 + 32 * s2 + 4 * qq), bq = *(const LAS f32x4*)(Ls + r * 68 + 32 * s2 + 16 + 4 * qq);
      const bool k0 = (2 * s2) < (r >> 4), k1 = (2 * s2 + 1) < (r >> 4);
      u32x4 o; o.x = k0 ? cvt_pk_bf16(-a.x, -a.y) : 0u; o.y = k0 ? cvt_pk_bf16(-a.z, -a.w) : 0u; o.z = k1 ? cvt_pk_bf16(-bq.x, -bq.y) : 0u; o.w = k1 ? cvt_pk_bf16(-bq.z, -bq.w) : 0u;
      *(LAS u32x4*)(loff + r * 128 + ((cq ^ ((r >> 1) & 7)) * 16)) = o;
      if (tid < 256) ((LAS u32x4*)dinv)[tid] = (u32x4){0u, 0u, 0u, 0u}; }
    __syncthreads();
    if (tid < 64) {
        const int bk = tid >> 4, j = tid & 15; float t[16];
#pragma unroll
        for (int i = 0; i < 16; ++i) { float a = (i == j) ? 1.f : 0.f;
#pragma unroll
            for (int k = 0; k < i; ++k) a -= Ls[(16 * bk + i) * 68 + 16 * bk + k] * t[k];
            t[i] = (i < j) ? 0.f : a; }
#pragma unroll
        for (int i = 0; i < 16; ++i) *(LAS bf16_t*)(dinv + (16 * bk + i) * 64 + 16 * (j >> 2) + 2 * (j & 3)) = (bf16_t)f2bf(t[i]);
    }
    __syncthreads();
    {
        const int nn = lane & 15, q = lane >> 4;
        const LAS float* srcm = (wave < 4) ? vf : kf; const LAS float* scl = (wave < 4) ? bts : sc1; const int cb = 32 * (wave & 3);
        f32x4 X[4][2];
#pragma unroll
        for (int bk = 0; bk < 4; ++bk)
#pragma unroll
            for (int nt = 0; nt < 2; ++nt)
#pragma unroll
                for (int i = 0; i < 4; ++i) { const int row = 16 * bk + 4 * q + i; X[bk][nt][i] = scl[row] * srcm[row * 132 + cb + 16 * nt + nn]; }
        const f32x4 z4 = {0.f, 0.f, 0.f, 0.f};
#pragma unroll
        for (int bk = 0; bk < 4; ++bk) {
#pragma unroll
            for (int nt = 0; nt < 2; ++nt) {
                f32x4 r = X[bk][nt];
#pragma unroll
                for (int s2 = 0; s2 < 2; ++s2) if (2 * s2 < bk) {
                    const int row = 16 * bk + nn; const bf16x8 lf = *(const LAS bf16x8*)(loff + row * 128 + (((4 * s2 + q) ^ ((row >> 1) & 7)) * 16));
                    const f32x4 xa = X[2 * s2][nt], xb = X[2 * s2 + 1][nt];
                    u32x4 pw; pw.x = cvt_pk_bf16(xa[0], xa[1]); pw.y = cvt_pk_bf16(xa[2], xa[3]); pw.z = cvt_pk_bf16(xb[0], xb[1]); pw.w = cvt_pk_bf16(xb[2], xb[3]);
                    r = MFMA16(lf, __builtin_bit_cast(bf16x8, pw), r); }
                const bf16x8 df = *(const LAS bf16x8*)(dinv + (16 * bk + nn) * 64 + q * 16);
                u32x4 pr; pr.x = cvt_pk_bf16(r[0], r[1]); pr.y = cvt_pk_bf16(r[2], r[3]); pr.z = 0u; pr.w = 0u;
                X[bk][nt] = MFMA16(df, __builtin_bit_cast(bf16x8, pr), z4);
            }
        }
        if (wave < 4) {
#pragma unroll
            for (int bk = 0; bk < 4; ++bk)
#pragma unroll
                for (int nt = 0; nt < 2; ++nt) *(f32x4*)(gU + ((size_t)(((2 * wave + nt) * 4 + bk) * 64 + lane)) * 4) = X[bk][nt];
        } else {
#pragma unroll
            for (int bk = 0; bk < 4; ++bk)
#pragma unroll
                for (int nt = 0; nt < 2; ++nt)
#pragma unroll
                    for (int i = 0; i < 4; ++i) kf[(16 * bk + 4 * q + i) * 132 + cb + 16 * nt + nn] = X[bk][nt][i];
        }
    }
    __syncthreads();
    for (int x = tid; x < 1024; x += 512) { const int c = x >> 4, ch = x & 15; const f32x4 a = *(const LAS f32x4*)(kf + c * 132 + 8 * ch), bq = *(const LAS f32x4*)(kf + c * 132 + 8 * ch + 4);
        u32x4 o; o.x = cvt_pk_bf16(a.x, a.y); o.y = cvt_pk_bf16(a.z, a.w); o.z = cvt_pk_bf16(bq.x, bq.y); o.w = cvt_pk_bf16(bq.z, bq.w);
        { const int dc = 4 * (ch >> 2) + 2 * (ch & 1), hb = 8 * ((ch & 3) >> 1);
          *(u32x2*)(gW + (unsigned)c * 256u + (unsigned)(((dc) ^ (c & 15)) * 16 + hb)) = (u32x2){o.x, o.y}; *(u32x2*)(gW + (unsigned)c * 256u + (unsigned)(((dc + 1) ^ (c & 15)) * 16 + hb)) = (u32x2){o.z, o.w}; } }
    __syncthreads();
}

DI void gdn_scan_mfma(Frame& F, int su) {
    const int bh = su >> 1, vh = su & 1, b = bh >> 3, h = bh & 7;
    int tid = F.tid; asm volatile("" : "+v"(tid)); const int lane = tid & 63, wave = __builtin_amdgcn_readfirstlane(tid >> 6);
    const int nn = lane & 15, q = lane >> 4;
    LAS unsigned char* buf = F.lds + LDS_SCR;
    const unsigned char* gC = F.ws + WS_GW + (size_t)bh * 32 * 57344;
    const float* gU = (const float*)(F.ws + WS_GU_) + (size_t)bh * 32 * 8192; const float* GL = (const float*)(F.ws + WS_GGL) + bh * 32;
    const int w8 = 4 * vh + (wave & 3);
    const bool active = wave < 4;
    float* Og = (float*)(F.ws + WS_GO) + (size_t)b * SEQ * 1024 + h * HD + 16 * w8 + 4 * q;
#define GDN_ISSUE(nchunk, bufp) do { if (!active) { const unsigned char* sb_ = gC + (size_t)(nchunk) * 57344 + (wave - 4) * 14336; LAS unsigned char* lb_ = (bufp) + (wave - 4) * 14336; \
        _Pragma("unroll") for (int pi = 0; pi < 14; ++pi) dma16s(sb_ + pi * 1024, (unsigned)lane * 16u, lb_ + pi * 1024); \
        const unsigned char* su_ = (const unsigned char*)(gU + (size_t)(nchunk) * 8192 + vh * 4096) + (wave - 4) * 4096; LAS unsigned char* lu_ = (bufp) + 57344 + (wave - 4) * 4096; \
        _Pragma("unroll") for (int pi = 0; pi < 4; ++pi) dma16s(su_ + pi * 1024, (unsigned)lane * 16u, lu_ + pi * 1024); } } while (0)
    f32x4 S[8];
#pragma unroll
    for (int a = 0; a < 8; ++a) S[a] = (f32x4){0.f, 0.f, 0.f, 0.f};
    const int m = nn;
    GDN_ISSUE(0, buf);
    f32x4 Oprev[4]; const float glv = GL[lane & 31];
#pragma unroll
    for (int t = 0; t < 4; ++t) Oprev[t] = (f32x4){0.f, 0.f, 0.f, 0.f};
    int cur = 0;
#pragma unroll 1
    for (int n = 0; n < 32; ++n) {
        FA_LANDED();
        if (n < 31) GDN_ISSUE(n + 1, buf + (cur ^ 1) * 73728);
        const LAS unsigned char* lw = buf + cur * 73728; const LAS unsigned char* lq = lw + 16384; const LAS unsigned char* lk = lw + 32768; const LAS unsigned char* la = lw + 49152;
        if (active) {
        if (n > 0) {
#pragma unroll
            for (int t = 0; t < 4; ++t) *(f32x4*)(Og + (size_t)(64 * (n - 1) + 16 * t + nn) * 1024) = Oprev[t]; }
        f32x4 U[4];
#pragma unroll
        for (int t = 0; t < 4; ++t) U[t] = *(const LAS f32x4*)(lw + 57344 + ((wave & 3) * 4 + t) * 1024 + lane * 16);
        const float gl = __builtin_bit_cast(float, __builtin_amdgcn_readlane(__builtin_bit_cast(int, glv), n));
        bf16x8 Sb[4];
#pragma unroll
        for (int s = 0; s < 4; ++s) { u32x4 pw; pw.x = cvt_pk_bf16(S[2 * s][0], S[2 * s][1]); pw.y = cvt_pk_bf16(S[2 * s][2], S[2 * s][3]); pw.z = cvt_pk_bf16(S[2 * s + 1][0], S[2 * s + 1][1]); pw.w = cvt_pk_bf16(S[2 * s + 1][2], S[2 * s + 1][3]);
            Sb[s] = __builtin_bit_cast(bf16x8, pw); }
#define GF256(base, row, s_) (*(const LAS bf16x8*)((base) + (unsigned)(row) * 256u + (unsigned)(((4 * (s_) + q) ^ ((row) & 15)) * 16)))
#define GF128(base, row, s_) (*(const LAS bf16x8*)((base) + (unsigned)(row) * 128u + (unsigned)(((4 * (s_) + q) ^ (((row) >> 1) & 7)) * 16)))
#define GSB() __builtin_amdgcn_sched_barrier(0)
        bf16x8 F0[8], F1[8];
        f32x4 T1[4], T2[4];
#pragma unroll
        for (int t = 0; t < 4; ++t) { T1[t] = (f32x4){0.f, 0.f, 0.f, 0.f}; T2[t] = (f32x4){0.f, 0.f, 0.f, 0.f}; }
#pragma unroll
        for (int i = 0; i < 8; ++i) F0[i] = GF256(lw, 16 * (i >> 2) + m, i & 3);
        GSB();
#pragma unroll
        for (int i = 0; i < 8; ++i) F1[i] = GF256(lw, 16 * (2 + (i >> 2)) + m, i & 3);
        GSB();
#pragma unroll
        for (int i = 0; i < 8; ++i) T1[i >> 2] = MFMA16(F0[i], Sb[i & 3], T1[i >> 2]);
        GSB();
#pragma unroll
        for (int i = 0; i < 8; ++i) F0[i] = GF128(lk, 16 * (i >> 1) + m, i & 1);
        GSB();
#pragma unroll
        for (int i = 0; i < 8; ++i) T1[2 + (i >> 2)] = MFMA16(F1[i], Sb[i & 3], T1[2 + (i >> 2)]);
        GSB();
        bf16x8 vb[2];
#pragma unroll
        for (int s2 = 0; s2 < 2; ++s2) { const f32x4 v0 = U[2 * s2] - T1[2 * s2], v1 = U[2 * s2 + 1] - T1[2 * s2 + 1];
            u32x4 pw; pw.x = cvt_pk_bf16(v0[0], v0[1]); pw.y = cvt_pk_bf16(v0[2], v0[3]); pw.z = cvt_pk_bf16(v1[0], v1[1]); pw.w = cvt_pk_bf16(v1[2], v1[3]); vb[s2] = __builtin_bit_cast(bf16x8, pw); }
#pragma unroll
        for (int i = 0; i < 8; ++i) F1[i] = GF128(lk, 16 * (4 + (i >> 1)) + m, i & 1);
        GSB();
#pragma unroll
        for (int a = 0; a < 8; ++a) S[a] = S[a] * gl;
#pragma unroll
        for (int i = 0; i < 8; ++i) S[i >> 1] = MFMA16(F0[i], vb[i & 1], S[i >> 1]);
        GSB();
#pragma unroll
        for (int i = 0; i < 8; ++i) F0[i] = GF256(lq, 16 * (i >> 2) + m, i & 3);
        GSB();
#pragma unroll
        for (int i = 0; i < 8; ++i) S[4 + (i >> 1)] = MFMA16(F1[i], vb[i & 1], S[4 + (i >> 1)]);
        GSB();
#pragma unroll
        for (int i = 0; i < 8; ++i) F1[i] = GF256(lq, 16 * (2 + (i >> 2)) + m, i & 3);
        GSB();
#pragma unroll
        for (int i = 0; i < 8; ++i) T2[i >> 2] = MFMA16(Sb[i & 3], F0[i], T2[i >> 2]);
        GSB();
#pragma unroll
        for (int i = 0; i < 8; ++i) F0[i] = GF128(la, 16 * (i >> 1) + m, i & 1);
        GSB();
#pragma unroll
        for (int i = 0; i < 8; ++i) T2[2 + (i >> 2)] = MFMA16(Sb[i & 3], F1[i], T2[2 + (i >> 2)]);
        GSB();
#pragma unroll
        for (int i = 0; i < 8; ++i) T2[i >> 1] = MFMA16(vb[i & 1], F0[i], T2[i >> 1]);
#undef GF256
#undef GF128
#undef GSB
#pragma unroll
        for (int t = 0; t < 4; ++t) Oprev[t] = T2[t];
        }
        cur ^= 1;
    }
    if (active) {
#pragma unroll
    for (int t = 0; t < 4; ++t) *(f32x4*)(Og + (size_t)(64 * 31 + 16 * t + nn) * 1024) = Oprev[t];
    }
#undef GDN_ISSUE
    __syncthreads();
}

DI void phase_gdn_out(Frame& F, const float* nw) {
    const bf16_t* proj = (const bf16_t*)(F.ws + WS_PROJ); const float* Og = (const float*)(F.ws + WS_GO); bf16_t* mix = (bf16_t*)(F.ws + WS_MIX);
    const int gw = F.bid * 8 + F.wave, NGW = F.G * 8, lane = F.lane, sub = lane >> 4, l16 = lane & 15;
    const f32x4 wa = *(const f32x4*)(nw + 8 * l16), wb = *(const f32x4*)(nw + 8 * l16 + 4);
#pragma unroll 4
    for (int it = gw; it < NTOK * NGH / 4; it += NGW) { const int item = 4 * it + sub, tok = item >> 3, h = item & 7;
        const float* op = Og + (size_t)tok * 1024 + h * HD + 8 * l16;
        const f32x4 a = *(const f32x4*)op, c = *(const f32x4*)(op + 4);
        const u32x4 zz = *(const u32x4*)(proj + (size_t)tok * DINP + C_GZ + h * HD + 8 * l16);
        const float ss = row16_sum(((a.x * a.x + a.y * a.y) + (a.z * a.z + a.w * a.w)) + ((c.x * c.x + c.y * c.y) + (c.z * c.z + c.w * c.w)));
        const float rs = rsqrtf(ss * (1.f / HD) + EPS);
        u32x4 o;
        o.x = pk2(a.x * rs * wa.x * siluf_(bflo(zz.x)), a.y * rs * wa.y * siluf_(bfhi(zz.x))); o.y = pk2(a.z * rs * wa.z * siluf_(bflo(zz.y)), a.w * rs * wa.w * siluf_(bfhi(zz.y)));
        o.z = pk2(c.x * rs * wb.x * siluf_(bflo(zz.z)), c.y * rs * wb.y * siluf_(bfhi(zz.z))); o.w = pk2(c.z * rs * wb.z * siluf_(bflo(zz.w)), c.w * rs * wb.w * siluf_(bfhi(zz.w)));
        *(u32x4*)(mix + (size_t)tok * DM + 512 + h * HD + 8 * l16) = o; }
}

DI void phase_route(Frame& F) {
    const int* topi = (const int*)(F.ws + WS_RT + RT_TOPI); const float* topg = (const float*)(F.ws + WS_RT + RT_TOPG);
    int* pos = (int*)(F.ws + WS_RT + RT_POS); float* rgate = (float*)(F.ws + WS_RT + RT_RGATE); int* texp = (int*)(F.ws + WS_RT + RT_TEXP); int* ntl = (int*)(F.ws + WS_RT + RT_NTILES);
    const bf16_t* hb = (const bf16_t*)(F.ws + WS_HB); bf16_t* hperm = (bf16_t*)(F.ws + WS_HPERM);
    LAS int* tot = (LAS int*)(F.lds + LDS_SCR);
    LAS int* bef = tot + 8;
    LAS int* pst = bef + 8;
    LAS int* dests = pst + 16;
    const int tid = F.tid, lane = F.lane;
    for (int blk = F.bid; blk < NTOK / 32; blk += F.G) {
        if (tid < 16) tot[tid] = 0;
        __syncthreads();
        int ct[NEXP], cb[NEXP];
#pragma unroll
        for (int e = 0; e < NEXP; ++e) { ct[e] = 0; cb[e] = 0; }
        { i32x4 tv[8];
#pragma unroll
          for (int j = 0; j < 8; ++j) tv[j] = ((const i32x4*)topi)[tid + 512 * j];
#pragma unroll
          for (int j = 0; j < 8; ++j)
#pragma unroll
            for (int c = 0; c < 4; ++c) { const int e = tv[j][c]; const bool before = 4 * (tid + 512 * j) + c < 64 * blk;
#pragma unroll
                for (int q = 0; q < NEXP; ++q) { ct[q] += (e == q); cb[q] += (e == q && before); } } }
#pragma unroll
        for (int e = 0; e < NEXP; ++e) { const int v = wave_sum_i(ct[e]), w = wave_sum_i(cb[e]);
            if (lane == 0) { atomicAdd((int*)(tot + e), v); atomicAdd((int*)(bef + e), w); } }
        __syncthreads();
        if (tid == 0) { int s = 0; for (int e = 0; e < NEXP; ++e) { pst[e] = s; s += (tot[e] + 255) / 256 * 256; } pst[NEXP] = s; }
        __syncthreads();
        if (tid < 64) { const int a = 64 * blk + tid, e = topi[a]; int rank = 0;
#pragma unroll
            for (int q = 0; q < NEXP; ++q) { const unsigned long long m = __ballot(e == q); if (e == q) rank = __popcll(m & ((1ull << lane) - 1ull)); }
            const int d = pst[e] + bef[e] + rank; dests[tid] = d; pos[a] = d; rgate[d] = topg[a]; }
        __syncthreads();
#pragma unroll 4
        for (int al = F.wave; al < 64; al += 8) { const int d = dests[al], tok = 32 * blk + (al >> 1);
            const u32x4* s = (const u32x4*)(hb + (size_t)tok * DM) + lane; u32x2* dd = (u32x2*)((unsigned char*)hperm + (size_t)d * DM) + lane;
#pragma unroll
            for (int j = 0; j < 4; ++j) { const u32x4 v = s[64 * j]; int w0 = 0, w1 = 0;
                w0 = __builtin_amdgcn_cvt_pk_fp8_f32(bflo(v.x), bfhi(v.x), w0, false); w0 = __builtin_amdgcn_cvt_pk_fp8_f32(bflo(v.y), bfhi(v.y), w0, true);
                w1 = __builtin_amdgcn_cvt_pk_fp8_f32(bflo(v.z), bfhi(v.z), w1, false); w1 = __builtin_amdgcn_cvt_pk_fp8_f32(bflo(v.w), bfhi(v.w), w1, true);
                dd[64 * j] = (u32x2){(unsigned)w0, (unsigned)w1}; } }
        for (int e = 0; e < NEXP; ++e) { const int lo = pst[e] + tot[e], hi = pst[e + 1];
            for (int r = lo + blk; r < hi; r += NTOK / 32) { ((unsigned*)((unsigned char*)hperm + (size_t)r * DM))[tid] = 0u; if (tid == 0) rgate[r] = 0.f; } }
        if (blk == 0) { const int nt = pst[NEXP] / 256; if (tid == 0) *ntl = nt;
            for (int i = tid; i < 72 * 8; i += 512) ((int*)(F.ws + WS_RT + RT_TAIL))[i] = -1;
            if (tid < nt) { int e = 0;
#pragma unroll
                for (int q = 1; q < NEXP; ++q) if (256 * tid >= pst[q]) e = q;
                texp[tid] = e; } }
        __syncthreads();
    }
}

DI void phase_final(Frame& F, const float* w) {
    const float* x = (const float*)(F.ws + WS_X); const bf16_t* y = (const bf16_t*)(F.ws + WS_Y); const int* pos = (const int*)(F.ws + WS_RT + RT_POS);
    const int gw = F.bid * 8 + F.wave, NGW = F.G * 8;
    for (int m = gw; m < NTOK; m += NGW) {
        const int p0 = pos[2 * m], p1 = pos[2 * m + 1];
        const f32x4* xr = (const f32x4*)(x + (size_t)m * DM) + F.lane; const u32x2* y0 = (const u32x2*)(y + (size_t)p0 * DM) + F.lane; const u32x2* y1 = (const u32x2*)(y + (size_t)p1 * DM) + F.lane;
        f32x4 v[8]; float s = 0.f;
        const int* tix = (const int*)(F.ws + WS_RT + RT_TAIL); const float* slab = (const float*)(F.ws + WS_SLAB); const float* rg = (const float*)(F.ws + WS_RT + RT_RGATE);
        const int tl0 = F.lane < 8 ? tix[(p0 >> 8) * 8 + F.lane] : -1, tl1 = F.lane < 8 ? tix[(p1 >> 8) * 8 + F.lane] : -1;
        const int KSPLIT = __builtin_amdgcn_readfirstlane(((const int*)(F.ws + WS_RT + RT_NTILES))[1]);
        f32x4 ya[8], yb[8];
#pragma unroll
        for (int j = 0; j < 8; ++j) { v[j] = xr[64 * j]; const u32x2 a = y0[64 * j], c = y1[64 * j]; ya[j] = (f32x4){bflo(a.x), bfhi(a.x), bflo(a.y), bfhi(a.y)}; yb[j] = (f32x4){bflo(c.x), bfhi(c.x), bflo(c.y), bfhi(c.y)}; }
        const unsigned m0 = (unsigned)__ballot(tl0 >= 0), m1 = (unsigned)__ballot(tl1 >= 0);
        if ((m0 | m1) != 0u) {
            const float g0 = rg[p0] * 0.015625f, g1 = rg[p1] * 0.015625f;
#pragma unroll
            for (int j = 0; j < 8; ++j) {
                if ((m0 >> j) & 1u) { asm volatile("" ::: "memory"); const int t0 = __builtin_amdgcn_readlane(tl0, j); const f32x4* sp = (const f32x4*)(slab + ((size_t)(t0 * KSPLIT) * 256 + (p0 & 255)) * 256) + F.lane; f32x4 a = sp[0];
#pragma unroll 1
                    for (int ks = 1; ks < KSPLIT; ++ks) a += sp[(size_t)ks * 16384];
                    ya[j] = a * g0; }
                if ((m1 >> j) & 1u) { asm volatile("" ::: "memory"); const int t1 = __builtin_amdgcn_readlane(tl1, j); const f32x4* sp = (const f32x4*)(slab + ((size_t)(t1 * KSPLIT) * 256 + (p1 & 255)) * 256) + F.lane; f32x4 a = sp[0];
#pragma unroll 1
                    for (int ks = 1; ks < KSPLIT; ++ks) a += sp[(size_t)ks * 16384];
                    yb[j] = a * g1; }
            }
        }
#pragma unroll
        for (int j = 0; j < 8; ++j) { v[j] = v[j] + ya[j] + yb[j]; s += (v[j].x * v[j].x + v[j].y * v[j].y) + (v[j].z * v[j].z + v[j].w * v[j].w); }
        const float rs = rsqrtf(wave_sum(s) * (1.f / DM) + EPS);
        f32x4* o = (f32x4*)(F.out + (size_t)m * DM) + F.lane;
#pragma unroll
        for (int j = 0; j < 8; ++j) o[64 * j] = v[j] * rs * ((const f32x4*)w)[F.lane + 64 * j];
    }
}

constexpr int PH_PER_LAYER = 11, N_PHASES = 1 + 2 * PH_PER_LAYER + 1;
#ifndef GDN_NAIVE
#define GDN_NAIVE 0
#endif
#define GDN_CHUNK gdn_chunk_mfma
#ifndef NSA_NAIVE
#define NSA_NAIVE 0
#endif
#ifndef REPMASK
#define REPMASK 0
#endif
#define NREP(k) ((((REPMASK) >> (k)) & 1) + 1)
#ifndef REPG
#define REPG 1
#endif
#ifndef REPX
#define REPX 1
#endif
#ifndef REPS
#define REPS 1
#endif
#ifndef REPN
#define REPN 1
#endif
#ifndef REPA
#define REPA 1
#endif
#ifndef REPB
#define REPB 1
#endif
#ifndef REPC
#define REPC 1
#endif
#ifndef PHMASK
#define PHMASK 0xFFFF
#endif
#define EN(k) (((PHMASK) >> (k)) & 1)
#define IN(k) (lo <= (k) && (k) < hi && (F.refresh(), true))
#define MARK(name) asm volatile("; MARK " name ::: "memory")
#define SEAM(k) do { if (IN((k) + 1)) xcd_barrier(bar, F.tid == 0); } while (0)
#define SEAMW(k) do { if (IN((k) + 1)) xcd_barrier_steal(bar, F.tid == 0, F, qactive, args.in[I_MGATE], args.in[I_MUP], args.in[I_MDOWN]); } while (0)
template <int layer> DI void run_layer(Frame& F, const Args& args, const int lo, const int hi, const XcdBarrier& bar, bool& qactive) {
    LAS unsigned char* scr = F.lds + LDS_SCR;
    bf16_t* HB = (bf16_t*)(F.ws + WS_HB); bf16_t* PROJ = (bf16_t*)(F.ws + WS_PROJ); bf16_t* MIX = (bf16_t*)(F.ws + WS_MIX); float* XB = (float*)(F.ws + WS_X);
    bf16_t* ACT = (bf16_t*)(F.ws + WS_ACT); bf16_t* HPERM = (bf16_t*)(F.ws + WS_HPERM); float* YB = (float*)(F.ws + WS_Y);
        const int pb = 1 + layer * PH_PER_LAYER;
        const float* xin = layer == 0 ? args.in[I_X] : XB;
        if (layer == 0 && EN(1) && IN(pb + 0)) { _Pragma("unroll 1") for (int rep_ = 0; rep_ < NREP(1); ++rep_) { phase_norm<false>(F, xin, args.in[I_ATTN_NORM] + layer * DM, HB, nullptr); } SEAMW(pb + 0); }
        if (EN(2) && IN(pb + 1)) { pg8::StaticOrder S; S.init(HB, DM * 2, F.ws + WS_WIN + layer * SZ_WIN, DM * 2, NTOK, DINP, F.G, F.bid);
            const bool early_cmp = (F.G == 256);
            unsigned* cmprdy = (unsigned*)(F.ws + WS_CTL) + CW_CMPRDY + layer;
            _Pragma("unroll 1") for (int rep_ = 0; rep_ < NREP(2); ++rep_) { pg8::EpiBf16 E{PROJ, DINP, layer == 1 ? (const float*)(F.ws + WS_RT + RT_RSQ) : nullptr, early_cmp ? cmprdy : nullptr, C_KC / 256}; pg8::gemm_phase(scr, DM / 64, DM * 2, DM * 2, S, E, F.tid); }
            if (early_cmp && F.bid >= 224) {
                if (F.tid == 0) { unsigned sp_ = 0; while (xb_ld(cmprdy) < 32u * 8u) { __builtin_amdgcn_s_sleep(4); if (++sp_ > XB_SPIN_CAP) break; }
                    __builtin_amdgcn_fence(__ATOMIC_ACQUIRE, "agent"); asm volatile("s_waitcnt vmcnt(0)" ::: "memory"); }
                __syncthreads();
                cmp_unit_mfma(F, F.bid - 224, layer, args.in[I_POS_K] + layer * 32 * HD, args.in[I_POS_V] + layer * 32 * HD);
            }
            SEAMW(pb + 1); }
        if (EN(3) && IN(pb + 2)) {
            for (int rep = 0; rep < REPA; ++rep, __syncthreads()) {
                const bool deal = (F.G == 256);
                for (int u = F.bid; u < 1024; u += F.G) GDN_CHUNK(F, u, args.in[I_CONV] + layer * 4 * 3072, args.in[I_ALOG] + layer * NGH, args.in[I_DTB] + layer * NGH);
                if (!deal) { for (int u = F.bid; u < 160; u += F.G) { if (u >= 128) cmp_unit_mfma(F, u - 128, layer, args.in[I_POS_K] + layer * 32 * HD, args.in[I_POS_V] + layer * 32 * HD); } }
            }
            SEAMW(pb + 2); }
        if (EN(4) && IN(pb + 3)) {
            for (int rep = 0; rep < REPB; ++rep, __syncthreads())
            for (int u = F.bid; u < 64 + 128 + 128; u += F.G) {
                if (u < 64) { for (int rs_ = 0; rs_ < REPS; ++rs_) gdn_scan_mfma(F, u); }
                else if (u < 192) { for (int rn_ = 0; rn_ < REPN; ++rn_) nsa_unit(F, u - 64); }
                else { const int sw = u - 192; if (F.G == 256 && sw >= 64) continue; swa_unit(F, args.in[I_SINKS] + layer * 4, sw); if (F.G == 256) swa_unit(F, args.in[I_SINKS] + layer * 4, sw + 64); }
            }
            SEAMW(pb + 3); }
        if (EN(5) && IN(pb + 4)) { _Pragma("unroll 1") for (int rep_ = 0; rep_ < NREP(5); ++rep_) { phase_gdn_out(F, args.in[I_GNORM] + layer * HD); } SEAMW(pb + 4); }
        if (EN(6) && IN(pb + 5)) { pg8::StaticOrder S; S.init(MIX, DM * 2, F.ws + WS_WOUT + layer * SZ_WOUT, DM * 2, NTOK, DM, F.G, F.bid);
            if (layer == 0) { pg8::EpiResidN E{xin, XB, HB, (float*)(F.ws + WS_RT + RT_RSQ), DM, (LAS float*)(F.lds + LDS_SCR + 131072), F.tid}; pg8::gemm_phase(scr, DM / 64, DM * 2, DM * 2, S, E, F.tid); }
            else { pg8::EpiResid E{xin, XB, DM}; pg8::gemm_phase(scr, DM / 64, DM * 2, DM * 2, S, E, F.tid); }
            SEAMW(pb + 5); }
        if (layer == 0) {
            if (EN(9) && IN(pb + 8)) { pg8::StaticOrder S; S.init(HB, DM * 2, F.ws + WS_DGU, DM * 2, NTOK, GU, F.G, F.bid);
                _Pragma("unroll 1") for (int rep_ = 0; rep_ < NREP(9); ++rep_) { pg8::EpiSwiGLU E{ACT, DFF, (const float*)(F.ws + WS_RT + RT_RSQ)}; pg8::gemm_phase(scr, DM / 64, DM * 2, DM * 2, S, E, F.tid); } SEAMW(pb + 8); }
            if (EN(10) && IN(pb + 9)) { pg8::StaticOrder S; S.init(ACT, DFF * 2, F.ws + WS_DDN, DFF * 2, NTOK, DM, F.G, F.bid);
                pg8::EpiResidN E{XB, XB, HB, (float*)(F.ws + WS_RT + RT_RSQ), DM, (LAS float*)(F.lds + LDS_SCR + 131072), F.tid}; pg8::gemm_phase(scr, DFF / 64, DFF * 2, DFF * 2, S, E, F.tid); SEAMW(pb + 9); }
        } else {
            if (EN(7) && IN(pb + 6)) { _Pragma("unroll 1") for (int rep_ = 0; rep_ < NREP(7); ++rep_) { phase_norm<true>(F, XB, args.in[I_FFN_NORM] + DM, HB, args.in[I_ROUTER]); } SEAMW(pb + 6); }
            if (EN(8) && IN(pb + 7)) { phase_route(F); if (hi - lo > 1) { while (qactive) { if (!steal_convert(F, args.in[I_MGATE], args.in[I_MUP], args.in[I_MDOWN])) qactive = false; } } SEAM(pb + 7); }
            const int* texp = (const int*)(F.ws + WS_RT + RT_TEXP);
            if (EN(9) && IN(pb + 8)) { const int ntiles = __builtin_amdgcn_readfirstlane(*(const int*)(F.ws + WS_RT + RT_NTILES));
                pg8::MoeOrder S; S.init(HPERM, DM, F.ws + WS_MGU, DM, (size_t)GU * DM, texp, ntiles, GU, F.G, F.bid);
                _Pragma("unroll 1") for (int rep_ = 0; rep_ < NREP(9); ++rep_) { pg8::EpiSwiGLUT<true> E{ACT, DFF, nullptr}; pg8::gemm_phase<pg8::EpiSwiGLUT<true>, pg8::MoeOrder, true>(scr, DM / 128, DM, DM, S, E, F.tid); } SEAM(pb + 8); }
            if (EN(10) && IN(pb + 9)) { const int ntiles = __builtin_amdgcn_readfirstlane(*(const int*)(F.ws + WS_RT + RT_NTILES));
                pg8::MoeOrder S; S.init(ACT, DFF, F.ws + WS_MDN, DFF, (size_t)DM * DFF, texp, ntiles, DM, F.G, F.bid);
                const int nun = ntiles * (DM / 256), nfull = nun / F.G, R = nun - nfull * F.G;
                const int ks = R * 14 <= F.G ? 14 : R * 7 <= F.G ? 7 : R * 4 <= F.G ? 4 : R * 2 <= F.G ? 2 : 1;
                const bool split = (hi - lo > 1) && R > 0 && R <= MAX_TAIL && ks > 1;
                if (F.bid == 0 && F.tid == 0) ((int*)(F.ws + WS_RT + RT_NTILES))[1] = split ? ks : 0;
                if (split) S.nrounds = nfull;
                { pg8::EpiRowScaleBf E{(const float*)(F.ws + WS_RT + RT_RGATE), (bf16_t*)YB, DM, 0.015625f}; pg8::gemm_phase<pg8::EpiRowScaleBf, pg8::MoeOrder, true>(scr, DFF / 128, DFF, DFF, S, E, F.tid); }
                if (split) { pg8::MoeTailOrder T; T.M = S; T.M.nrounds = 1 << 30; T.L0 = nfull * F.G; T.R = R; T.kbytes = DFF / ks; T.ks = ks;
                    pg8::EpiSlab E2{(float*)(F.ws + WS_SLAB), (int*)(F.ws + WS_RT + RT_TAIL), ks}; pg8::gemm_phase<pg8::EpiSlab, pg8::MoeTailOrder, true>(scr, DFF / ks / 128, DFF, DFF, T, E2, F.tid); }
                SEAM(pb + 9); }
        }
    }
__global__ void __launch_bounds__(512, 2) trunk_fwd(Args args) {
    extern __shared__ __attribute__((aligned(16))) unsigned char lds_raw[];
    Frame F;
    F.lds = (LAS unsigned char*)lds_raw;
    F.tid = threadIdx.x; F.lane = F.tid & 63; F.wave = __builtin_amdgcn_readfirstlane(F.tid >> 6); F.wave0 = F.wave; F.G = gridDim.x; F.bid = blockIdx.x;
    F.out = args.out; F.ws = args.ws;
    volatile LAS unsigned* MISC = (volatile LAS unsigned*)(F.lds + LDS_MISC);
    if (F.tid < 64) MISC[F.tid] = 0u;
    __syncthreads();
    unsigned* ctl = (unsigned*)(F.ws + WS_CTL);
    XcdBarrier bar; bar.bar = ctl + CW_BAR; bar.x = 0; bar.st = nullptr;
    const int lo = args.ph_lo, hi = args.ph_hi;
    if (hi - lo > 1) bar = xcd_barrier_post(ctl + CW_BAR, MISC + 8);
    LAS unsigned char* scr = F.lds + LDS_SCR;
    bf16_t* HB = (bf16_t*)(F.ws + WS_HB); bf16_t* PROJ = (bf16_t*)(F.ws + WS_PROJ); bf16_t* MIX = (bf16_t*)(F.ws + WS_MIX); float* XB = (float*)(F.ws + WS_X);
    bf16_t* ACT = (bf16_t*)(F.ws + WS_ACT); bf16_t* HPERM = (bf16_t*)(F.ws + WS_HPERM); float* YB = (float*)(F.ws + WS_Y);

    bool qactive = (hi - lo > 1);
    if (EN(0) && IN(0)) { phase_convert(F, args.in[I_W_IN], args.in[I_W_OUT], args.in[I_DGATE], args.in[I_DUP], args.in[I_DDOWN], args.in[I_W1K], args.in[I_W1V], args.in[I_W2K], args.in[I_W2V], args.in[I_ATTN_NORM] + DM, args.in[I_FFN_NORM]);
        if (hi - lo <= 1) { LAS float* scr0 = (LAS float*)(F.lds + LDS_SCR + F.wave * 16384); for (int q = F.bid * 8 + F.wave; q < Q_TOTAL; q += F.G * 8) moe_item(F.ws, args.in[I_MGATE], args.in[I_MUP], args.in[I_MDOWN], q, scr0, F.lane); }
        SEAMW(0); }
    run_layer<0>(F, args, lo, hi, bar, qactive);
    run_layer<1>(F, args, lo, hi, bar, qactive);
    if (EN(11) && IN(N_PHASES - 1)) phase_final(F, args.in[I_FINAL]);
}

extern "C" void kernel_launch(void* const* d_in, const int* in_sizes, int n_in, void* d_out, int out_size, void* d_ws, size_t ws_size, hipStream_t stream) {
    static int grid = 0;
    if (grid == 0) {
        if (n_in != 24 || in_sizes[0] != NTOK * DM || out_size != NTOK * DM || ws_size < WS_END) {
            fprintf(stderr, "kernel_launch: unexpected shapes (n_in %d, in0 %d, out %d, ws %zu < %zu)\n", n_in, n_in > 0 ? in_sizes[0] : -1, out_size, ws_size, (size_t)WS_END); grid = -1; return; }
        int dev = 0, cus = 0, per_cu = 0;
        if (hipGetDevice(&dev) != hipSuccess || hipDeviceGetAttribute(&cus, hipDeviceAttributeMultiprocessorCount, dev) != hipSuccess) { grid = -1; return; }
        if (hipFuncSetAttribute((const void*)trunk_fwd, hipFuncAttributeMaxDynamicSharedMemorySize, LDS_BYTES) != hipSuccess) { fprintf(stderr, "kernel_launch: hipFuncSetAttribute failed\n"); grid = -1; return; }
        if (hipOccupancyMaxActiveBlocksPerMultiprocessor(&per_cu, (const void*)trunk_fwd, 512, LDS_BYTES) != hipSuccess || per_cu < 1) { fprintf(stderr, "kernel_launch: occupancy query says %d\n", per_cu); }
        (void)hipGetLastError();
        grid = cus;
    }
    if (grid < 0) return;
    (void)hipMemsetAsync((char*)d_ws + WS_CTL, 0, CTL_BYTES, stream);
    Args a{};
    for (int i = 0; i < 24; ++i) a.in[i] = (const float*)d_in[i];
    a.out = (float*)d_out; a.ws = (unsigned char*)d_ws;
#if MK_PER_PHASE
    for (int p = 0; p < N_PHASES; ++p) { a.ph_lo = p; a.ph_hi = p + 1; hipLaunchKernelGGL(trunk_fwd, dim3(grid), dim3(512), LDS_BYTES, stream, a); }
#else
    a.ph_lo = 0; a.ph_hi = N_PHASES;
    hipLaunchKernelGGL(trunk_fwd, dim3(grid), dim3(512), LDS_BYTES, stream, a);
#endif
}
```

```cpp
#include <hip/hip_runtime.h>
#include <cstdio>
#include <cstdint>

#ifndef MK_PER_PHASE
#define MK_PER_PHASE 0
#endif

#define DI __device__ __forceinline__
#define LAS __attribute__((address_space(3)))
DI void dma16s(const void* sbase  , unsigned voff, LAS void* l) { const unsigned la = (unsigned)(size_t)l; asm volatile("s_mov_b32 m0, %2\n\ts_nop 0\n\tglobal_load_lds_dwordx4 %0, %1" :: "v"(voff), "s"(sbase), "s"(la) : "memory", "m0"); }
DI void dma16(const void* g, LAS void* l) { const unsigned la = (unsigned)(size_t)l; asm volatile("s_mov_b32 m0, %1\n\ts_nop 0\n\tglobal_load_lds_dwordx4 %0, off" :: "v"(g), "s"(la) : "memory"); }
typedef int i32x4 __attribute__((ext_vector_type(4)));
typedef unsigned short bf16_t;
typedef short bf16x8 __attribute__((ext_vector_type(8)));
typedef float f32x4 __attribute__((ext_vector_type(4)));
typedef float f32x2 __attribute__((ext_vector_type(2)));
typedef unsigned u32x4 __attribute__((ext_vector_type(4)));
typedef unsigned u32x2 __attribute__((ext_vector_type(2)));

constexpr int NB = 4, SEQ = 2048, DM = 2048, NTOK = NB * SEQ, HD = 128;
constexpr int DIN = 6428, DINP = 6656;
constexpr int DFF = 7168, NEXP = 8, GU = 2 * DFF;
constexpr int NGH = 8;
constexpr int PMAX = 2 * NTOK + NEXP * 256;
constexpr int C_NQ = 0, C_KC = 512, C_VC = 640, C_KSL = 768, C_VSL = 896, C_KW = 1024, C_VW = 1152, C_GQ = 1280, C_GK = 2304, C_GV = 3328, C_GZ = 4352,
              C_SQ = 5376, C_SK = 5888, C_SV = 6144, C_NG = 6400, C_GA = 6412, C_GB = 6420;
constexpr float EPS = 1e-6f;
constexpr float QSCALE = 0.08838834764831845f;

constexpr size_t MiB = 1u << 20;
constexpr size_t WS_CTL = 0, CTL_BYTES = 1 * MiB;
constexpr size_t SZ_WIN = (size_t)DINP * DM * 2, SZ_WOUT = (size_t)DM * DM * 2, SZ_WGU = (size_t)GU * DM * 2, SZ_WDN = (size_t)DM * DFF * 2;
constexpr size_t WS_WIN = 2 * MiB;
constexpr size_t WS_WOUT = WS_WIN + 2 * SZ_WIN;
constexpr size_t WS_DGU = WS_WOUT + 2 * SZ_WOUT;
constexpr size_t WS_DDN = WS_DGU + SZ_WGU;
constexpr size_t WS_MGU = WS_DDN + SZ_WDN;
constexpr size_t WS_MDN = WS_MGU + NEXP * SZ_WGU;
constexpr size_t WS_HB = WS_MDN + NEXP * SZ_WDN;
constexpr size_t WS_MIX = WS_HB + (size_t)NTOK * DM * 2;
constexpr size_t WS_X = WS_MIX + (size_t)NTOK * DM * 2;
constexpr size_t WS_HPERM = WS_X + (size_t)NTOK * DM * 4;
constexpr size_t WS_Y = WS_HPERM + (size_t)PMAX * DM * 2;
constexpr size_t WS_RT = WS_Y + (size_t)PMAX * DM * 4;
constexpr size_t WS_KC = WS_RT + 1 * MiB;
constexpr size_t WS_CW1 = WS_KC + 1 * MiB;
constexpr size_t WS_CW2 = WS_CW1 + 8 * MiB;
constexpr size_t WS_OVL = WS_CW2 + 1 * MiB;
constexpr size_t WS_ACT = WS_OVL;
constexpr size_t WS_PROJ = WS_OVL;
constexpr size_t SZ_G = (size_t)NB * NGH * SEQ * HD * 4;
constexpr size_t WS_GU_ = WS_PROJ + (size_t)NTOK * DINP * 2;
constexpr size_t WS_GW = WS_GU_ + SZ_G, WS_GQ = WS_GW + SZ_G, WS_GK = WS_GQ + SZ_G;
constexpr size_t WS_GAT = WS_GK + SZ_G;
constexpr size_t WS_GO = WS_GAT + 16 * MiB;
constexpr size_t WS_GGL = WS_GO + 32 * MiB;
constexpr size_t WS_NSAO = WS_GGL + 1 * MiB;
constexpr size_t OVL_A = (size_t)PMAX * DFF * 2, OVL_B = (WS_NSAO + 16 * MiB) - WS_OVL;
constexpr size_t WS_END = WS_OVL + (OVL_A > OVL_B ? OVL_A : OVL_B);
constexpr size_t RT_RSQ = 524288;
constexpr size_t RT_TOPI = 0, RT_TOPG = 65536, RT_POS = 131072, RT_RGATE = 196608, RT_TEXP = 294912, RT_NTILES = 295936, RT_TAIL = 296960;

constexpr int CW_BAR = 4096;
constexpr int KSPLIT_MAX = 14;
constexpr size_t WS_SLAB = WS_MGU + (size_t)NEXP * GU * DM;
constexpr int MAX_TAIL = 64;
constexpr int CW_CMPRDY = 2112;
constexpr int CW_QHEAD = 2048;

constexpr int LDS_SCR = 0, LDS_SCR_BYTES = 153600;
constexpr int LDS_MISC = LDS_SCR_BYTES;
constexpr int LDS_BYTES = LDS_SCR_BYTES + 256;

DI float bf2f(unsigned v) { return __uint_as_float(v << 16); }
DI float bflo(unsigned v) { return __uint_as_float(v << 16); }
DI float bfhi(unsigned v) { return __uint_as_float(v & 0xffff0000u); }
DI unsigned f2bf(float f) { unsigned u = __float_as_uint(f); return (u + 0x7fffu + ((u >> 16) & 1u)) >> 16; }
DI unsigned pk2(float lo, float hi) { return f2bf(lo) | (f2bf(hi) << 16); }
typedef __bf16 bf16v2_t __attribute__((ext_vector_type(2)));
DI unsigned cvt_pk_bf16(float lo, float hi) { const f32x2 v = {lo, hi}; return __builtin_bit_cast(unsigned, __builtin_convertvector(v, bf16v2_t)); }
#define DPPF(x, ctrl) __builtin_bit_cast(float, __builtin_amdgcn_update_dpp(0, __builtin_bit_cast(int, (x)), (ctrl), 0xf, 0xf, true))
DI float wave_sum(float v) {
    v += DPPF(v, 0xB1);
    v += DPPF(v, 0x4E);
    v += DPPF(v, 0x141);
    v += DPPF(v, 0x140);
    v += __builtin_bit_cast(float, __builtin_amdgcn_ds_swizzle(__builtin_bit_cast(int, v), 0x401F));
    return __builtin_bit_cast(float, __builtin_amdgcn_readlane(__builtin_bit_cast(int, v), 0)) + __builtin_bit_cast(float, __builtin_amdgcn_readlane(__builtin_bit_cast(int, v), 32));
}
DI float wave_max(float v) {
    v = fmaxf(v, DPPF(v, 0xB1));
    v = fmaxf(v, DPPF(v, 0x4E));
    v = fmaxf(v, DPPF(v, 0x141));
    v = fmaxf(v, DPPF(v, 0x140));
    v = fmaxf(v, __builtin_bit_cast(float, __builtin_amdgcn_ds_swizzle(__builtin_bit_cast(int, v), 0x401F)));
    return fmaxf(__builtin_bit_cast(float, __builtin_amdgcn_readlane(__builtin_bit_cast(int, v), 0)), __builtin_bit_cast(float, __builtin_amdgcn_readlane(__builtin_bit_cast(int, v), 32)));
}
DI int wave_sum_i(int v) {
    v += __builtin_amdgcn_update_dpp(0, v, 0xB1, 0xf, 0xf, true);
    v += __builtin_amdgcn_update_dpp(0, v, 0x4E, 0xf, 0xf, true);
    v += __builtin_amdgcn_update_dpp(0, v, 0x141, 0xf, 0xf, true);
    v += __builtin_amdgcn_update_dpp(0, v, 0x140, 0xf, 0xf, true);
    v += __builtin_amdgcn_ds_swizzle(v, 0x401F);
    return __builtin_amdgcn_readlane(v, 0) + __builtin_amdgcn_readlane(v, 32);
}
DI float sigmoidf_(float x) { return 1.f / (1.f + __expf(-x)); }
DI float siluf_(float x) { return x / (1.f + __expf(-x)); }
DI float softplusf_(float x) { return x > 20.f ? x : log1pf(__expf(x)); }
#define LDS_WAIT() asm volatile("s_waitcnt lgkmcnt(0)" ::: "memory")

#define XB_TMO      128
#define XB_XCNT(j)  (256  + 64 * (j))
#define XB_XSUB(j)  (1280 + 64 * (j))
#define XB_XGEN(j)  (2304 + 64 * (j))
#define XB_TOP      3328
#define XB_TOPGEN   3392
#define XCD_BAR_WORDS 3456
#define XB_SPIN_CAP (1u << 22)
DI unsigned xb_ld(unsigned* p)              { return __hip_atomic_load(p, __ATOMIC_RELAXED, __HIP_MEMORY_SCOPE_AGENT); }
DI unsigned xb_add(unsigned* p, unsigned v) { return __hip_atomic_fetch_add(p, v, __ATOMIC_RELAXED, __HIP_MEMORY_SCOPE_AGENT); }
DI unsigned xb_xcc_id() { return (unsigned)__builtin_amdgcn_s_getreg((3 << 11) | 20) & 0xFu; }
#define XB_SPIN(cond, bar) do { unsigned _sp = 0; while (cond) { __builtin_amdgcn_s_sleep(1); \
    if ((++_sp & 255u) == 0u) { if (xb_ld(&(bar)[XB_TMO])) break; if (_sp > XB_SPIN_CAP) { atomicAdd(&(bar)[XB_TMO], 1u); break; } } } } while (0)
struct XcdBarrier { unsigned* bar; unsigned x; volatile LAS unsigned* st; };
DI XcdBarrier xcd_barrier_post(unsigned* bar, volatile LAS unsigned* st) {
    XcdBarrier b; b.bar = bar; b.x = xb_xcc_id(); b.st = st;
    if (threadIdx.x == 0) (void)xb_add(&bar[XB_XCNT(b.x)], 1u);
    return b;
}
DI void xcd_barrier_complete(unsigned* bar, unsigned x, unsigned& nloc, unsigned& nx) {
    const unsigned G = gridDim.x * gridDim.y * gridDim.z;
    unsigned sum, cnt, mine, sp = 0u;
    for (;;) {
        sum = 0u; cnt = 0u; mine = 0u;
#pragma unroll
        for (unsigned j = 0; j < 16; ++j) { const unsigned c = xb_ld(&bar[XB_XCNT(j)]); sum += c; cnt += (c > 0u) ? 1u : 0u; mine = (j == x) ? c : mine; }
        if (sum == G) break;
        __builtin_amdgcn_s_sleep(1);
        if ((++sp & 255u) == 0u) { if (xb_ld(&bar[XB_TMO])) break; if (sp > XB_SPIN_CAP) { atomicAdd(&bar[XB_TMO], 1u); break; } }
    }
    nloc = mine > 0u ? mine : 1u; nx = cnt > 0u ? cnt : 1u;
}
DI void xcd_barrier(const XcdBarrier& b, const bool leader  ) {
    asm volatile("s_waitcnt vmcnt(0)" ::: "memory");
    __syncthreads();
    if (leader) {
        unsigned* bar = b.bar;
        __builtin_amdgcn_s_waitcnt(0);
        unsigned nloc = b.st[0], nx = b.st[1];
        if (nloc == 0u) { xcd_barrier_complete(bar, b.x, nloc, nx); b.st[0] = nloc; b.st[1] = nx; }
        const unsigned old = xb_add(&bar[XB_XSUB(b.x)], 1u);
        const unsigned gen = old / nloc;
        if (old + 1u == (gen + 1u) * nloc) {
            __builtin_amdgcn_fence(__ATOMIC_RELEASE, "agent");
            asm volatile("s_waitcnt vmcnt(0)" ::: "memory");
            const unsigned og = xb_add(&bar[XB_TOP], 1u);
            const unsigned tg = og / nx;
            if (og + 1u == (tg + 1u) * nx) xb_add(&bar[XB_TOPGEN], 1u);
            else XB_SPIN(xb_ld(&bar[XB_TOPGEN]) == tg, bar);
            __builtin_amdgcn_fence(__ATOMIC_ACQUIRE, "agent");
            xb_add(&bar[XB_XGEN(b.x)], 1u);
            asm volatile("s_waitcnt vmcnt(0)" ::: "memory");
        } else {
            XB_SPIN(xb_ld(&bar[XB_XGEN(b.x)]) == gen, bar);
            __builtin_amdgcn_fence(__ATOMIC_ACQUIRE, "agent");
            asm volatile("s_waitcnt vmcnt(0)" ::: "memory");
        }
    }
    __syncthreads();
}

namespace pg8 {
constexpr int BM = 256, BK = 64, HALF = 128, HTB = HALF * BK * 2, STAGE_BYTES = 8 * HTB, NXCD = 8, WGM = 8;
__host__ __device__ __forceinline__ int lds_byte(int r, int c) { const int st = (r >> 4) * 2 + (c >> 5), rr = r & 15, cc = c & 31, ob = rr * 64 + cc * 2; return st * 1024 + (ob ^ (((ob >> 9) & 1) << 5)); }
__host__ __device__ __forceinline__ void stage_rc(int b, int& R, int& C) { const int st = b / 1024, sb = b % 1024, swz = sb ^ (((sb >> 9) & 1) << 5); R = (st >> 1) * 16 + swz / 64; C = (st & 1) * 32 + (swz % 64) / 2; }
__host__ __device__ __forceinline__ int perm32(int rho) { const int n = rho >> 4, i = rho & 15; return 8 * (i >> 2) + 4 * n + (i & 3); }
struct Unit { int pm, pn, aux; };
DI bool order_next(int i, int G, int c, int nM, int nN, Unit& u) {
    const int nwg = nM * nN; const long L = (long)i * G + c; if (L >= nwg) return false;
    int wgid = (int)L; { const int q = nwg / NXCD, r = nwg % NXCD, xcd = wgid % NXCD, off = wgid / NXCD; wgid = (xcd < r ? xcd * (q + 1) : r * (q + 1) + (xcd - r) * q) + off; }
    const int nig = WGM * nN, gid = wgid / nig, fm = gid * WGM, gsz = (nM - fm) < WGM ? (nM - fm) : WGM;
    u.pm = fm + ((wgid % nig) % gsz); u.pn = (wgid % nig) / gsz; u.aux = 0; return true;
}
struct StaticOrder {
    const char* A; const char* Bt; int nM, nN, G, c; size_t a_tstep, b_tstep;
    DI void init(const void* A_, int ldaB, const void* Bt_, int ldbB, int M, int N, int G_, int c_) { A = (const char*)A_; Bt = (const char*)Bt_; nM = M / BM; nN = N / BM; G = G_; c = c_; a_tstep = (size_t)BM * ldaB; b_tstep = (size_t)BM * ldbB; }
    DI bool next(int i, Unit& u) const { return order_next(i, G, c, nM, nN, u); }
    DI const char* abase(const Unit& u) const { return A + (size_t)u.pm * a_tstep; }
    DI const char* bbase(const Unit& u) const { return Bt + (size_t)u.pn * b_tstep; }
};
struct MoeOrder {
    const char* A; const char* W; const int* texp; int nM, nN, G, c; size_t a_tstep, b_tstep, estride;
    DI void init(const void* A_, int ldaB, const void* W_, int ldbB, size_t estride_bytes, const int* texp_, int ntiles, int N, int G_, int c_) {
        A = (const char*)A_; W = (const char*)W_; texp = texp_; nM = ntiles; nN = N / BM; G = G_; c = c_; a_tstep = (size_t)BM * ldaB; b_tstep = (size_t)BM * ldbB; estride = estride_bytes; }
    int nrounds = 1 << 30;
    DI bool next(int i, Unit& u) const { return i < nrounds && order_next(i, G, c, nM, nN, u); }
    DI const char* abase(const Unit& u) const { return A + (size_t)u.pm * a_tstep; }
    DI const char* bbase(const Unit& u) const { const int e = __builtin_amdgcn_readfirstlane(texp[u.pm]); return W + (size_t)e * estride + (size_t)u.pn * b_tstep; }
};
struct MoeTailOrder {
    MoeOrder M; int L0, R, kbytes, ks;
    DI bool next(int i, Unit& u) const { const int j = i * M.G + M.c; if (j >= R * ks) return false; const int t = j / ks;
        order_next(0, 1 << 30, L0 + t, M.nM, M.nN, u); u.aux = j; return true; }
    DI const char* abase(const Unit& u) const { return M.abase(u) + (size_t)(u.aux % ks) * kbytes; }
    DI const char* bbase(const Unit& u) const { return M.bbase(u) + (size_t)(u.aux % ks) * kbytes; }
};
struct EpiSlab {
    static constexpr bool PERM = false;
    float* slab; int* tailidx; int ks;
    DI void operator()(const f32x4 (&acc)[2][2][4][2], const Unit& u, int wr, int wc, int fr, int fq) const {
        float* base = slab + (size_t)u.aux * 65536; const int row0 = wr * 64 + fr, col0 = wc * 32 + 4 * fq;
        if ((u.aux % ks) == 0 && wr == 0 && wc == 0 && fr == 0 && fq == 0) tailidx[u.pm * 8 + u.pn] = u.aux / ks;
#pragma unroll
        for (int ai = 0; ai < 2; ++ai)
#pragma unroll
            for (int m = 0; m < 4; ++m) { float* rp = base + (size_t)(row0 + ai * HALF + m * 16) * 256 + col0;
#pragma unroll
                for (int bj = 0; bj < 2; ++bj)
#pragma unroll
                    for (int n = 0; n < 2; ++n) *(f32x4*)(rp + bj * HALF + n * 16) = acc[ai][bj][m][n];
                asm volatile("" ::: "memory"); }
    }
};
DI float row_rs(const float* rsq, int row) { float s = 0.f;
#pragma unroll
    for (int p = 0; p < 8; ++p) s += rsq[(size_t)p * NTOK + row];
    return rsqrtf(s * (1.f / DM) + EPS); }
struct EpiBf16 {
    static constexpr bool PERM = true;
    bf16_t* O; int ldc; const float* rsq;
    unsigned* pub = nullptr; int pubcol = -1;
    DI void operator()(const f32x4 (&acc)[2][2][4][2], const Unit& u, int wr, int wc, int fr, int fq) const {
        const int row0 = u.pm * BM + wr * 64 + fr, col0 = u.pn * BM + wc * 32 + 8 * fq;
        float rsv[2][4];
#pragma unroll
        for (int ai = 0; ai < 2; ++ai)
#pragma unroll
            for (int m = 0; m < 4; ++m) rsv[ai][m] = rsq ? row_rs(rsq, row0 + ai * HALF + m * 16) : 1.f;
#pragma unroll
        for (int ai = 0; ai < 2; ++ai)
#pragma unroll
            for (int m = 0; m < 4; ++m) { bf16_t* rowp = O + (size_t)(row0 + ai * HALF + m * 16) * ldc + col0;
#pragma unroll
                for (int bj = 0; bj < 2; ++bj) { const f32x4 v0 = acc[ai][bj][m][0] * rsv[ai][m], v1 = acc[ai][bj][m][1] * rsv[ai][m];
                    u32x4 w; w.x = cvt_pk_bf16(v0[0], v0[1]); w.y = cvt_pk_bf16(v0[2], v0[3]); w.z = cvt_pk_bf16(v1[0], v1[1]); w.w = cvt_pk_bf16(v1[2], v1[3]);
                    *(u32x4*)(rowp + bj * HALF) = w; } }
        if (pub && u.pn == pubcol) { asm volatile("s_waitcnt vmcnt(0)" ::: "memory"); __builtin_amdgcn_fence(__ATOMIC_RELEASE, "agent"); asm volatile("s_waitcnt vmcnt(0)" ::: "memory");
            if ((threadIdx.x & 63) == 0) (void)__hip_atomic_fetch_add(pub, 1u, __ATOMIC_RELAXED, __HIP_MEMORY_SCOPE_AGENT); }
    }
};
template <bool F8> struct EpiSwiGLUT {
    static constexpr bool PERM = true;
    bf16_t* O; int ldc; const float* rsq;
    DI void operator()(const f32x4 (&acc)[2][2][4][2], const Unit& u, int wr, int wc, int fr, int fq) const {
        const int row0 = u.pm * BM + wr * 64 + fr, col0 = u.pn * HALF + wc * 32 + 8 * fq;
        float rsv[2][4];
#pragma unroll
        for (int ai = 0; ai < 2; ++ai)
#pragma unroll
            for (int m = 0; m < 4; ++m) rsv[ai][m] = (rsq ? row_rs(rsq, row0 + ai * HALF + m * 16) : 1.f) * (F8 ? 0.015625f : 1.f);
#pragma unroll
        for (int ai = 0; ai < 2; ++ai)
#pragma unroll
            for (int m = 0; m < 4; ++m) { bf16_t* rowp = O + (size_t)(row0 + ai * HALF + m * 16) * ldc + col0;
                float o[8];
#pragma unroll
                for (int n = 0; n < 2; ++n)
#pragma unroll
                    for (int j = 0; j < 4; ++j) { const float g = acc[ai][0][m][n][j] * rsv[ai][m], up = acc[ai][1][m][n][j] * rsv[ai][m]; o[n * 4 + j] = g * __builtin_amdgcn_rcpf(1.f + __expf(-g)) * up; }
                if (F8) { int w0 = 0, w1 = 0; w0 = __builtin_amdgcn_cvt_pk_fp8_f32(o[0], o[1], w0, false); w0 = __builtin_amdgcn_cvt_pk_fp8_f32(o[2], o[3], w0, true);
                    w1 = __builtin_amdgcn_cvt_pk_fp8_f32(o[4], o[5], w1, false); w1 = __builtin_amdgcn_cvt_pk_fp8_f32(o[6], o[7], w1, true);
                    *(u32x2*)((unsigned char*)O + (size_t)(row0 + ai * HALF + m * 16) * ldc + col0) = (u32x2){(unsigned)w0, (unsigned)w1}; }
                else { u32x4 w; w.x = cvt_pk_bf16(o[0], o[1]); w.y = cvt_pk_bf16(o[2], o[3]); w.z = cvt_pk_bf16(o[4], o[5]); w.w = cvt_pk_bf16(o[6], o[7]);
                    *(u32x4*)rowp = w; }
                asm volatile("" ::: "memory"); }
    }
};
typedef EpiSwiGLUT<false> EpiSwiGLU;
struct EpiResid {
    static constexpr bool PERM = false;
    const float* resid; float* out; int ldc;
    DI void operator()(const f32x4 (&acc)[2][2][4][2], const Unit& u, int wr, int wc, int fr, int fq) const {
        const int row0 = u.pm * BM + wr * 64 + fr, col0 = u.pn * BM + wc * 32 + 4 * fq;
#pragma unroll
        for (int ai = 0; ai < 2; ++ai)
#pragma unroll
            for (int m = 0; m < 4; ++m) { const size_t off = (size_t)(row0 + ai * HALF + m * 16) * ldc + col0;
#pragma unroll
                for (int bj = 0; bj < 2; ++bj)
#pragma unroll
                    for (int n = 0; n < 2; ++n) { const f32x4 r = *(const f32x4*)(resid + off + bj * HALF + n * 16); *(f32x4*)(out + off + bj * HALF + n * 16) = r + acc[ai][bj][m][n]; } }
    }
};
struct EpiResidN {
    static constexpr bool PERM = false;
    const float* resid; float* out; bf16_t* xb; float* rsq; int ldc; LAS float* P  ; int tid;
    DI void operator()(const f32x4 (&acc)[2][2][4][2], const Unit& u, int wr, int wc, int fr, int fq) const {
        const int row0 = u.pm * BM + wr * 64 + fr, col0 = u.pn * BM + wc * 32 + 4 * fq;
        const int lane = fr + 16 * fq;
#pragma unroll
        for (int ai = 0; ai < 2; ++ai)
#pragma unroll
            for (int m = 0; m < 4; ++m) { const size_t off = (size_t)(row0 + ai * HALF + m * 16) * ldc + col0; float ss = 0.f;
#pragma unroll
                for (int bj = 0; bj < 2; ++bj)
#pragma unroll
                    for (int n = 0; n < 2; ++n) { const f32x4 v = *(const f32x4*)(resid + off + bj * HALF + n * 16) + acc[ai][bj][m][n]; *(f32x4*)(out + off + bj * HALF + n * 16) = v;
                        *(u32x2*)(xb + off + bj * HALF + n * 16) = (u32x2){cvt_pk_bf16(v[0], v[1]), cvt_pk_bf16(v[2], v[3])}; ss += (v[0] * v[0] + v[1] * v[1]) + (v[2] * v[2] + v[3] * v[3]); }
                ss += __builtin_bit_cast(float, __builtin_amdgcn_ds_swizzle(__builtin_bit_cast(int, ss), 0x401F));
                ss += __builtin_bit_cast(float, __builtin_amdgcn_ds_bpermute((lane ^ 32) << 2, __builtin_bit_cast(int, ss)));
                if (fq == 0) P[(wr * 64 + ai * HALF + m * 16 + fr) * 4 + wc] = ss;
                asm volatile("" ::: "memory"); }
        asm volatile("s_waitcnt lgkmcnt(0)" ::: "memory"); __builtin_amdgcn_s_barrier(); asm volatile("" ::: "memory");
        if (tid < 256) { const LAS float* p = P + tid * 4; rsq[(size_t)u.pn * NTOK + u.pm * BM + tid] = (p[0] + p[1]) + (p[2] + p[3]); }
    }
};
struct EpiRowScaleBf {
    static constexpr bool PERM = true;
    const float* rscale; bf16_t* out; int ldc; float mul;
    DI void operator()(const f32x4 (&acc)[2][2][4][2], const Unit& u, int wr, int wc, int fr, int fq) const {
        const int row0 = u.pm * BM + wr * 64 + fr, col0 = u.pn * BM + wc * 32 + 8 * fq;
#pragma unroll
        for (int ai = 0; ai < 2; ++ai)
#pragma unroll
            for (int m = 0; m < 4; ++m) { const int row = row0 + ai * HALF + m * 16; const float s = rscale[row] * mul; bf16_t* rowp = out + (size_t)row * ldc + col0;
#pragma unroll
                for (int bj = 0; bj < 2; ++bj) { const f32x4 v0 = acc[ai][bj][m][0] * s, v1 = acc[ai][bj][m][1] * s;
                    u32x4 w; w.x = cvt_pk_bf16(v0[0], v0[1]); w.y = cvt_pk_bf16(v0[2], v0[3]); w.z = cvt_pk_bf16(v1[0], v1[1]); w.w = cvt_pk_bf16(v1[2], v1[3]);
                    *(u32x4*)(rowp + bj * HALF) = w; }
                asm volatile("" ::: "memory"); }
    }
};
struct EpiRowScale {
    static constexpr bool PERM = false;
    const float* rscale; float* out; int ldc; float mul;
    DI void operator()(const f32x4 (&acc)[2][2][4][2], const Unit& u, int wr, int wc, int fr, int fq) const {
        const int row0 = u.pm * BM + wr * 64 + fr, col0 = u.pn * BM + wc * 32 + 4 * fq;
#pragma unroll
        for (int ai = 0; ai < 2; ++ai)
#pragma unroll
            for (int m = 0; m < 4; ++m) { const int row = row0 + ai * HALF + m * 16; const float s = rscale[row] * mul; const size_t off = (size_t)row * ldc + col0;
#pragma unroll
                for (int bj = 0; bj < 2; ++bj)
#pragma unroll
                    for (int n = 0; n < 2; ++n) *(f32x4*)(out + off + bj * HALF + n * 16) = acc[ai][bj][m][n] * s;
                asm volatile("" ::: "memory"); }
    }
};

typedef int v8i_t __attribute__((ext_vector_type(8)));
template <class Epi, class Sched, bool FP8 = false, bool ALIGN_EPI = true, bool SP2 = true>
DI void gemm_phase(LAS unsigned char* lds, const int nt, const int ldaB, const int ldbB, const Sched& S, const Epi& E, int tid) {
    asm volatile("" : "+v"(tid));
    const int wid = __builtin_amdgcn_readfirstlane(tid >> 6), lane = tid & 63, wr = wid >> 2, wc = wid & 3, fr = lane & 15, fq = lane >> 4;
    unsigned voffA[2], voffB[2];
#pragma unroll
    for (int i = 0; i < 2; ++i) { int R, C; stage_rc(tid * 16 + i * 8192, R, C); const int Rb = Epi::PERM ? ((R & ~31) + perm32(R & 31)) : R;
        voffA[i] = (unsigned)(R * ldaB + C * 2); voffB[i] = (unsigned)(Rb * ldbB + C * 2); }
    const size_t kstep = (size_t)(BK * 2);
    const size_t hstepA = (size_t)HALF * ldaB, hstepB = (size_t)HALF * ldbB;
    const unsigned ldsw = (unsigned)wid * 1024u;
    const int aoff = lds_byte(wr * 64 + fr, fq * 8), boff = lds_byte(wc * 32 + fr, fq * 8);
#define PG8_SA(b, h) (((b) * 2 + (h)) * HTB)
#define PG8_SB(b, h) ((4 + (b) * 2 + (h)) * HTB)
#define PG8_STAGE(bufoff, gbase, voff) do { _Pragma("unroll") for (int _i = 0; _i < 2; ++_i) \
        __builtin_amdgcn_global_load_lds((const unsigned*)((const char*)(gbase) + (voff)[_i]), (LAS unsigned*)(lds + (bufoff) + ldsw + _i * 8192), 16, 0, 0); } while (0)
#define PG8_LDA(dst, b, h) do { _Pragma("unroll") for (int m = 0; m < 4; ++m) _Pragma("unroll") for (int k = 0; k < 2; ++k) dst[m][k] = *(const LAS bf16x8*)(lds + PG8_SA(b, h) + aoff + m * 2048 + k * 1024); } while (0)
#define PG8_LDB(dst, b, h) do { _Pragma("unroll") for (int n = 0; n < 2; ++n) _Pragma("unroll") for (int k = 0; k < 2; ++k) dst[n][k] = *(const LAS bf16x8*)(lds + PG8_SB(b, h) + boff + n * 2048 + k * 1024); } while (0)
#define PG8_CAT(x0, x1) __builtin_shufflevector(__builtin_bit_cast(u32x4, (x0)), __builtin_bit_cast(u32x4, (x1)), 0, 1, 2, 3, 4, 5, 6, 7)
#define PG8_MMA(ai, bj, At, Bt) do { __builtin_amdgcn_s_setprio(1); _Pragma("unroll") for (int m = 0; m < 4; ++m) _Pragma("unroll") for (int n = 0; n < 2; ++n) { \
        if constexpr (FP8) { const v8i_t wa_ = __builtin_bit_cast(v8i_t, PG8_CAT(Bt[n][0], Bt[n][1])), xa_ = __builtin_bit_cast(v8i_t, PG8_CAT(At[m][0], At[m][1])); \
            asm volatile("v_mfma_f32_16x16x128_f8f6f4 %0, %1, %2, %0" : "+v"(acc[ai][bj][m][n]) : "v"(wa_), "v"(xa_)); }   \
        else { _Pragma("unroll") for (int k = 0; k < 2; ++k) acc[ai][bj][m][n] = __builtin_amdgcn_mfma_f32_16x16x32_bf16(Bt[n][k], At[m][k], acc[ai][bj][m][n], 0, 0, 0); } } \
        __builtin_amdgcn_s_setprio(0); } while (0)
#define PG8_WAIT_V(n) asm volatile("s_waitcnt vmcnt(" #n ")" ::: "memory")
#define PG8_WAIT_L(n) asm volatile("s_waitcnt lgkmcnt(" #n ")" ::: "memory")
#define PG8_BAR __builtin_amdgcn_s_barrier()
#define PG8_SCHED __builtin_amdgcn_sched_barrier(0)
    Unit cur, nxt; int ui = 0;
    if (!S.next(0, cur)) return;
    f32x4 acc[2][2][4][2];
#pragma unroll
    for (int a = 0; a < 2; ++a)
#pragma unroll
        for (int b = 0; b < 2; ++b)
#pragma unroll
            for (int m = 0; m < 4; ++m)
#pragma unroll
                for (int n = 0; n < 2; ++n) acc[a][b][m][n] = (f32x4){0.f, 0.f, 0.f, 0.f};
    bf16x8 At[4][2], B0[2][2], B1[2][2];
    const char* cA = S.abase(cur); const char* cB = S.bbase(cur);
    static_assert(SP2, "only the SP2 loop is kept");
    PG8_STAGE(PG8_SB(0, 0), cB, voffB); PG8_STAGE(PG8_SB(0, 1), cB + hstepB, voffB); PG8_STAGE(PG8_SA(0, 0), cA, voffA); PG8_STAGE(PG8_SA(0, 1), cA + hstepA, voffA);
    if (wr == 1) PG8_BAR;
    PG8_WAIT_V(2); PG8_BAR;
    PG8_STAGE(PG8_SB(1, 0), cB + kstep, voffB); PG8_STAGE(PG8_SA(1, 0), cA + kstep, voffA); PG8_STAGE(PG8_SB(1, 1), cB + hstepB + kstep, voffB);
    PG8_WAIT_V(6); PG8_BAR;
    for (;;) {
        const bool has_next = S.next(ui + 1, nxt);
        const char* nA = has_next ? S.abase(nxt) : cA; const char* nB = has_next ? S.bbase(nxt) : cB;
        for (int t = 0; t < nt; t += 2) {
            const bool last = (t == nt - 2);
            const char* a1 = cA + (size_t)(t + 1) * kstep;
            const char* a2 = last ? nA : cA + (size_t)(t + 2) * kstep; const char* b2 = last ? nB : cB + (size_t)(t + 2) * kstep;
            const char* a3 = a2 + kstep; const char* b3 = b2 + kstep;
            PG8_LDB(B0, 0, 0); PG8_LDB(B1, 0, 1); PG8_SCHED; PG8_LDA(At, 0, 0); PG8_STAGE(PG8_SA(1, 1), a1 + hstepA, voffA);
            PG8_WAIT_V(8); PG8_WAIT_L(0); PG8_BAR; PG8_MMA(0, 0, At, B0); PG8_MMA(0, 1, At, B1); PG8_BAR; PG8_SCHED;
            PG8_LDA(At, 0, 1); PG8_STAGE(PG8_SB(0, 0), b2, voffB); PG8_STAGE(PG8_SB(0, 1), b2 + hstepB, voffB); PG8_STAGE(PG8_SA(0, 0), a2, voffA);
            PG8_WAIT_V(8); PG8_WAIT_L(0); PG8_BAR; PG8_MMA(1, 0, At, B0); PG8_MMA(1, 1, At, B1); PG8_BAR; PG8_SCHED;
            PG8_LDB(B0, 1, 0); PG8_LDB(B1, 1, 1); PG8_SCHED; PG8_LDA(At, 1, 0); PG8_STAGE(PG8_SA(0, 1), a2 + hstepA, voffA);
            PG8_WAIT_V(8); PG8_WAIT_L(0); PG8_BAR; PG8_MMA(0, 0, At, B0); PG8_MMA(0, 1, At, B1); PG8_BAR; PG8_SCHED;
            PG8_LDA(At, 1, 1); PG8_STAGE(PG8_SB(1, 0), b3, voffB); PG8_STAGE(PG8_SB(1, 1), b3 + hstepB, voffB); PG8_STAGE(PG8_SA(1, 0), a3, voffA);
            PG8_WAIT_V(8); PG8_WAIT_L(0); PG8_BAR; PG8_MMA(1, 0, At, B0); PG8_MMA(1, 1, At, B1); PG8_BAR; PG8_SCHED;
        }
        if constexpr (ALIGN_EPI) { if (wr == 0) PG8_BAR; }
        if constexpr (FP8) asm volatile("s_nop 15\n\ts_nop 15" ::: "memory");
        E(acc, cur, wr, wc, fr, fq);
        if (!has_next) break;
#pragma unroll
        for (int a = 0; a < 2; ++a)
#pragma unroll
            for (int b = 0; b < 2; ++b)
#pragma unroll
                for (int m = 0; m < 4; ++m)
#pragma unroll
                    for (int n = 0; n < 2; ++n) acc[a][b][m][n] = (f32x4){0.f, 0.f, 0.f, 0.f};
        cur = nxt; cA = nA; cB = nB; ++ui;
        if constexpr (ALIGN_EPI) { if (wr == 1) PG8_BAR; }
    }
    PG8_WAIT_V(0);
    if constexpr (!ALIGN_EPI) { if (wr == 0) PG8_BAR; }
    PG8_BAR;
#undef PG8_SA
#undef PG8_SB
#undef PG8_STAGE
#undef PG8_LDA
#undef PG8_LDB
#undef PG8_MMA
#undef PG8_CAT
#undef PG8_WAIT_V
#undef PG8_WAIT_L
#undef PG8_BAR
#undef PG8_SCHED
}
}

struct Args { const float* in[24]; float* out; unsigned char* ws; int ph_lo, ph_hi; };
enum { I_X = 0, I_ATTN_NORM, I_W_IN, I_POS_K, I_POS_V, I_W1K, I_W2K, I_W1V, I_W2V, I_CONV, I_ALOG, I_DTB, I_GNORM, I_SINKS, I_W_OUT, I_FFN_NORM,
       I_DGATE, I_DUP, I_DDOWN, I_ROUTER, I_MGATE, I_MUP, I_MDOWN, I_FINAL };
struct Frame {
    LAS unsigned char* lds;
    int tid, lane, wave, G, bid;
    float* out; unsigned char* ws;
    int wave0;
    DI void refresh() { int l = __builtin_amdgcn_mbcnt_hi(-1, __builtin_amdgcn_mbcnt_lo(-1, 0)); asm volatile("" : "+v"(l)); lane = l; wave = wave0; tid = wave0 * 64 + l; }
};

template <class F> DI void tr_item(const float* W, int ldw, int k0, bf16_t* dst, int K, LAS float* scr, int lane, F srccol, const float* rowgain = nullptr  ) {
    const int r = lane & 31; const int sc = srccol(r);
#pragma unroll 8
    for (int i = 0; i < 32; ++i) { const int kk = 2 * i + (lane >> 5); scr[kk * 33 + r] = sc >= 0 ? W[(size_t)(k0 + kk) * ldw + sc] * (rowgain ? rowgain[k0 + kk] : 1.f) : 0.f; }
    LDS_WAIT();
    const int c = lane & 7;
#pragma unroll
    for (int j = 0; j < 4; ++j) { const int n = (lane >> 3) + 8 * j; const LAS float* s = scr + (8 * c) * 33 + n;
        u32x4 o; o.x = pk2(s[0 * 33], s[1 * 33]); o.y = pk2(s[2 * 33], s[3 * 33]); o.z = pk2(s[4 * 33], s[5 * 33]); o.w = pk2(s[6 * 33], s[7 * 33]);
        *(u32x4*)(dst + (size_t)n * K + k0 + 8 * c) = o; }
    LDS_WAIT();
}
DI int win_srccol(int n) { return n < 1280 ? n : n < 5376 ? n + 12 : n < 6400 ? n + 28 : n < 6412 ? 1280 + (n - 6400) : n < 6428 ? 5388 + (n - 6412) : -1; }
DI void tr64_load(const float* src, int ldw, int lane, f32x4 (&v)[16]) { const int n4 = lane & 15, kr = lane >> 4;
#pragma unroll
    for (int i = 0; i < 16; ++i) v[i] = *(const f32x4*)(src + (size_t)(4 * i + kr) * ldw + 4 * n4); }
DI void tr64_stepA(f32x4 (&v)[16], LAS float* scr, int lane, const float* rowgain) { const int n4 = lane & 15, kr = lane >> 4;
    if (rowgain) {
#pragma unroll
        for (int i = 0; i < 16; ++i) v[i] *= rowgain[4 * i + kr]; }
#pragma unroll
    for (int i = 0; i < 16; ++i) { const int k = 4 * i + kr; *(LAS f32x4*)(scr + k * 64 + 4 * (n4 ^ ((k >> 3) & 7))) = v[i]; }
    LDS_WAIT(); }
DI void tr64_stepB(bf16_t* dst, int K, LAS float* scr, int lane) { const int c = lane & 7, nb = lane >> 3;
#pragma unroll
    for (int j = 0; j < 8; ++j) { const int n = nb + 8 * j; const LAS float* sp = scr + (8 * c) * 64 + (n ^ (c << 2));
        u32x4 o; o.x = cvt_pk_bf16(sp[0 * 64], sp[1 * 64]); o.y = cvt_pk_bf16(sp[2 * 64], sp[3 * 64]); o.z = cvt_pk_bf16(sp[4 * 64], sp[5 * 64]); o.w = cvt_pk_bf16(sp[6 * 64], sp[7 * 64]);
        *(u32x4*)(dst + (size_t)n * K + 8 * c) = o; }
    LDS_WAIT(); }
DI void tr_item64(const float* src, int ldw, bf16_t* dst, int K, LAS float* scr, int lane, const float* rowgain = nullptr  ) {
    const int n4 = lane & 15, kr = lane >> 4;
    f32x4 v[16];
#pragma unroll
    for (int i = 0; i < 16; ++i) v[i] = *(const f32x4*)(src + (size_t)(4 * i + kr) * ldw + 4 * n4);
    if (rowgain) {
#pragma unroll
        for (int i = 0; i < 16; ++i) v[i] *= rowgain[4 * i + kr]; }
#pragma unroll
    for (int i = 0; i < 16; ++i) { const int k = 4 * i + kr; *(LAS f32x4*)(scr + k * 64 + 4 * (n4 ^ ((k >> 3) & 7))) = v[i]; }
    LDS_WAIT();
    const int c = lane & 7, nb = lane >> 3;
#pragma unroll
    for (int j = 0; j < 8; ++j) { const int n = nb + 8 * j; const LAS float* sp = scr + (8 * c) * 64 + (n ^ (c << 2));
        u32x4 o; o.x = cvt_pk_bf16(sp[0 * 64], sp[1 * 64]); o.y = cvt_pk_bf16(sp[2 * 64], sp[3 * 64]); o.z = cvt_pk_bf16(sp[4 * 64], sp[5 * 64]); o.w = cvt_pk_bf16(sp[6 * 64], sp[7 * 64]);
        *(u32x4*)(dst + (size_t)n * K + 8 * c) = o; }
    LDS_WAIT();
}
constexpr int J_WIN = 32 * 100, J_WOUT = 32 * 32, J_GU = 32 * (GU / 64), J_DN = (DFF / 64) * (DM / 64);
constexpr int Q_TOTAL = NEXP * (J_GU + J_DN);
DI void tr_item64_f8(const float* src, int ldw, unsigned char* dst, int K, LAS float* scr, int lane) {
    const int n4 = lane & 15, kr = lane >> 4;
    f32x4 v[16];
#pragma unroll
    for (int i = 0; i < 16; ++i) v[i] = *(const f32x4*)(src + (size_t)(4 * i + kr) * ldw + 4 * n4);
#pragma unroll
    for (int i = 0; i < 16; ++i) { const int k = 4 * i + kr; *(LAS f32x4*)(scr + k * 64 + 4 * (n4 ^ ((k >> 3) & 7))) = v[i]; }
    LDS_WAIT();
    const int c = lane & 7, nb = lane >> 3;
#pragma unroll
    for (int j = 0; j < 8; ++j) { const int n = nb + 8 * j; const LAS float* sp = scr + (8 * c) * 64 + (n ^ (c << 2));
        int w0 = 0, w1 = 0;
        w0 = __builtin_amdgcn_cvt_pk_fp8_f32(sp[0 * 64] * 64.f, sp[1 * 64] * 64.f, w0, false); w0 = __builtin_amdgcn_cvt_pk_fp8_f32(sp[2 * 64] * 64.f, sp[3 * 64] * 64.f, w0, true);
        w1 = __builtin_amdgcn_cvt_pk_fp8_f32(sp[4 * 64] * 64.f, sp[5 * 64] * 64.f, w1, false); w1 = __builtin_amdgcn_cvt_pk_fp8_f32(sp[6 * 64] * 64.f, sp[7 * 64] * 64.f, w1, true);
        *(u32x2*)(dst + (size_t)n * K + 8 * c) = (u32x2){(unsigned)w0, (unsigned)w1}; }
    LDS_WAIT();
}
DI void moe_item(unsigned char* ws, const float* mgate, const float* mup, const float* mdown, int qq, LAS float* scr, int lane) {
    const float* src; unsigned char* dst; int ldw, K;
    const int q = Q_TOTAL - 1 - qq;
    if (q < NEXP * J_GU) { const int e = q / J_GU, r = q % J_GU, nblk = GU / 64, pr_ = r >> 1, kb = 2 * (pr_ / nblk) + (r & 1), nb = pr_ % nblk;
        const int d0 = 64 * nb, j = d0 >> 8, half = (d0 >> 7) & 1, c0 = d0 & 127;
        src = (half ? mup : mgate) + (size_t)e * DM * DFF + (size_t)(64 * kb) * DFF + 128 * j + c0; ldw = DFF;
        dst = ws + WS_MGU + (size_t)e * GU * DM + (size_t)d0 * DM + 64 * kb; K = DM;
    } else { const int q2 = q - NEXP * J_GU, e = q2 / J_DN, r = q2 % J_DN, nblk = DM / 64, pr_ = r >> 1, kb = 2 * (pr_ / nblk) + (r & 1), nb = pr_ % nblk;
        src = mdown + (size_t)e * DFF * DM + (size_t)(64 * kb) * DM + 64 * nb; ldw = DM;
        dst = ws + WS_MDN + (size_t)e * DM * DFF + (size_t)(64 * nb) * DFF + 64 * kb; K = DFF; }
    tr_item64_f8(src, ldw, dst, K, scr, lane);
}
DI bool steal_convert(Frame& F, const float* mgate, const float* mup, const float* mdown) {
    volatile LAS int* qs = (volatile LAS int*)(F.lds + LDS_MISC) + 16;
    if (F.tid == 0) qs[0] = (int)atomicAdd((unsigned*)(F.ws + WS_CTL) + CW_QHEAD, 8u);
    __syncthreads();
    const int base = __builtin_amdgcn_readfirstlane(qs[0]);
    __syncthreads();
    if (base >= Q_TOTAL) return false;
    const int q = base + F.wave;
    if (q < Q_TOTAL) moe_item(F.ws, mgate, mup, mdown, q, (LAS float*)(F.lds + LDS_SCR + F.wave * 16384), F.lane);
    return true;
}
struct CvItem { const float* src; bf16_t* dst; int ldw, K; const float* gain; };
DI CvItem cv_decode(int it, unsigned char* ws, const float* w_in, const float* w_out, const float* dgate, const float* dup, const float* ddown,
                    const float* w1k, const float* w1v, const float* w2k, const float* w2v, const float* attn_norm1, const float* ffn_norm0) {
    constexpr int T0 = 2 * J_WIN, T1 = T0 + 2 * J_WOUT, T2 = T1 + J_GU, T3 = T2 + J_DN, T6 = T3 + 4 * 256;
        const float* src; bf16_t* dst; int ldw, K; const float* gain = nullptr;
        if (it >= T6) { const int q = it - T6, mi = q >> 3, r = q & 7, kb = r >> 1, nb = r & 1, L = mi >> 1, kv = mi & 1;
            src = (kv ? w2v : w2k) + (size_t)L * 256 * HD + (size_t)(64 * kb) * HD + 64 * nb; ldw = HD; dst = (bf16_t*)(ws + WS_CW2) + (size_t)mi * HD * 256 + (size_t)(64 * nb) * 256 + 64 * kb; K = 256;
        } else if (it >= T3) { const int q = it - T3, mi = q >> 8, r = q & 255, kb = r >> 2, nb = r & 3, L = mi >> 1, kv = mi & 1;
            src = (kv ? w1v : w1k) + (size_t)L * 4096 * 256 + (size_t)(64 * kb) * 256 + 64 * nb; ldw = 256; dst = (bf16_t*)(ws + WS_CW1) + (size_t)mi * 256 * 4096 + (size_t)(64 * nb) * 4096 + 64 * kb; K = 4096;
        } else if (it < T0) { const int L = it / J_WIN, r = it % J_WIN, kb = r / 100, nb = r % 100, nd = 64 * nb, ns = win_srccol(nd);
            src = w_in + (size_t)L * DM * DIN + (size_t)(64 * kb) * DIN + ns; ldw = DIN; dst = (bf16_t*)(ws + WS_WIN + L * SZ_WIN) + (size_t)nd * DM + 64 * kb; K = DM; if (L == 1) gain = attn_norm1 + 64 * kb;
        } else if (it < T1) { const int q = it - T0, L = q / J_WOUT, r = q % J_WOUT, kb = r / 32, nb = r % 32;
            src = w_out + (size_t)L * DM * DM + (size_t)(64 * kb) * DM + 64 * nb; ldw = DM; dst = (bf16_t*)(ws + WS_WOUT + L * SZ_WOUT) + (size_t)(64 * nb) * DM + 64 * kb; K = DM;
        } else if (it < T2) {
            const int r = it - T1, nblk = GU / 64, kb = r / nblk, nb = r % nblk;
            const int d0 = 64 * nb, j = d0 >> 8, half = (d0 >> 7) & 1, c0 = d0 & 127;
            src = (half ? dup : dgate) + (size_t)(64 * kb) * DFF + 128 * j + c0; ldw = DFF;
            dst = (bf16_t*)(ws + WS_DGU) + (size_t)d0 * DM + 64 * kb; K = DM; gain = ffn_norm0 + 64 * kb;
        } else { const int r = it - T2, nblk = DM / 64, kb = r / nblk, nb = r % nblk;
            src = ddown + (size_t)(64 * kb) * DM + 64 * nb; ldw = DM;
            dst = (bf16_t*)(ws + WS_DDN) + (size_t)(64 * nb) * DFF + 64 * kb; K = DFF;
        }
    return CvItem{src, dst, ldw, K, gain};
}
DI void phase_convert(Frame& F, const float* w_in, const float* w_out, const float* dgate, const float* dup, const float* ddown,
                      const float* w1k, const float* w1v, const float* w2k, const float* w2v, const float* attn_norm1, const float* ffn_norm0) {
    LAS float* scr = (LAS float*)(F.lds + LDS_SCR + F.wave * 16384);
    const int gw = F.bid * 8 + F.wave, NGW = F.G * 8;
    constexpr int T0 = 2 * J_WIN, T1 = T0 + 2 * J_WOUT, T2 = T1 + J_GU, T3 = T2 + J_DN, T6 = T3 + 4 * 256, T7 = T6 + 4 * 8;
    if (gw < T7) {
        f32x4 v[16];
        CvItem cur = cv_decode(gw, F.ws, w_in, w_out, dgate, dup, ddown, w1k, w1v, w2k, w2v, attn_norm1, ffn_norm0); tr64_load(cur.src, cur.ldw, F.lane, v);
#pragma unroll 1
        for (int it = gw; it < T7; it += NGW) {
            tr64_stepA(v, scr, F.lane, cur.gain);
            bf16_t* const cdst = cur.dst; const int cK = cur.K;
            if (it + NGW < T7) { cur = cv_decode(it + NGW, F.ws, w_in, w_out, dgate, dup, ddown, w1k, w1v, w2k, w2v, attn_norm1, ffn_norm0); tr64_load(cur.src, cur.ldw, F.lane, v); }
            tr64_stepB(cdst, cK, scr, F.lane);
        }
    }

    for (int it = gw; it < 2 * 32; it += NGW) { const int L = it / 32, kb = it % 32;
        tr_item(w_in + (size_t)L * DM * DIN, DIN, 64 * kb, (bf16_t*)(F.ws + WS_WIN + L * SZ_WIN) + (size_t)6400 * DM, DM, scr, F.lane, [&](int rr) { return win_srccol(6400 + rr); }, L == 1 ? attn_norm1 : nullptr); }
    for (int it = gw; it < 2 * 224; it += NGW) { const int L = it / 224, row = 6432 + it % 224; u32x4* d = (u32x4*)((bf16_t*)(F.ws + WS_WIN + L * SZ_WIN) + (size_t)row * DM);
#pragma unroll
        for (int j = 0; j < 4; ++j) d[F.lane + 64 * j] = (u32x4){0u, 0u, 0u, 0u}; }
}

DI void xcd_barrier_steal(const XcdBarrier& b, const bool leader, Frame& F, bool& qactive, const float* mgate, const float* mup, const float* mdown) {
    asm volatile("s_waitcnt vmcnt(0)" ::: "memory");
    __syncthreads();
    volatile LAS unsigned* fl = b.st + 2;
    if (leader) {
        unsigned* bar = b.bar;
        __builtin_amdgcn_s_waitcnt(0);
        unsigned nloc = b.st[0], nx = b.st[1];
        if (nloc == 0u) { xcd_barrier_complete(bar, b.x, nloc, nx); b.st[0] = nloc; b.st[1] = nx; }
        const unsigned old = xb_add(&bar[XB_XSUB(b.x)], 1u);
        const unsigned gen = old / nloc;
        if (old + 1u == (gen + 1u) * nloc) {
            __builtin_amdgcn_fence(__ATOMIC_RELEASE, "agent");
            asm volatile("s_waitcnt vmcnt(0)" ::: "memory");
            const unsigned og = xb_add(&bar[XB_TOP], 1u);
            const unsigned tg = og / nx;
            if (og + 1u == (tg + 1u) * nx) xb_add(&bar[XB_TOPGEN], 1u);
            else XB_SPIN(xb_ld(&bar[XB_TOPGEN]) == tg, bar);
            __builtin_amdgcn_fence(__ATOMIC_ACQUIRE, "agent");
            xb_add(&bar[XB_XGEN(b.x)], 1u);
            asm volatile("s_waitcnt vmcnt(0)" ::: "memory");
            fl[0] = 1u; fl[1] = 0xFFFFFFFFu;
        } else { fl[0] = 0u; fl[1] = gen; }
    }
    __syncthreads();
    bool released = fl[0] != 0u;
    const bool waited = !released;
    __syncthreads();
    while (!released) {
        bool more = false;
        if (qactive) { more = steal_convert(F, mgate, mup, mdown); if (!more) qactive = false; }
        if (leader) {
            unsigned* bar = b.bar; const unsigned gen = fl[1];
            if (more) { if (xb_ld(&bar[XB_XGEN(b.x)]) != gen || xb_ld(&bar[XB_TMO]) != 0u) fl[0] = 1u; }
            else { XB_SPIN(xb_ld(&bar[XB_XGEN(b.x)]) == gen, bar); fl[0] = 1u; }
        }
        __syncthreads();
        released = fl[0] != 0u;
        __syncthreads();
    }
    if (leader && waited) { asm volatile("s_waitcnt vmcnt(0)" ::: "memory"); __builtin_amdgcn_fence(__ATOMIC_ACQUIRE, "agent"); asm volatile("s_waitcnt vmcnt(0)" ::: "memory"); }
    __syncthreads();
}

template <bool ROUTER> DI void phase_norm(Frame& F, const float* x, const float* w, bf16_t* hb, const float* router) {
    LAS float* rl = (LAS float*)(F.lds + LDS_SCR);
    if (ROUTER) { for (int i = F.tid; i < DM * NEXP / 4; i += 512) ((LAS f32x4*)rl)[i ^ ((i >> 4) & 7)] = ((const f32x4*)router)[i]; __syncthreads(); }
    int* topi = (int*)(F.ws + WS_RT + RT_TOPI); float* topg = (float*)(F.ws + WS_RT + RT_TOPG);
    const int gw = F.bid * 8 + F.wave, NGW = F.G * 8;
    f32x4 vn[8];
    if (gw < NTOK) { const f32x4* xr = (const f32x4*)(x + (size_t)gw * DM) + F.lane;
#pragma unroll
        for (int j = 0; j < 8; ++j) vn[j] = xr[64 * j]; }
    for (int m = gw; m < NTOK; m += NGW) {
        f32x4 v[8]; float s = 0.f;
#pragma unroll
        for (int j = 0; j < 8; ++j) v[j] = vn[j];
        if (m + NGW < NTOK) { const f32x4* xr = (const f32x4*)(x + (size_t)(m + NGW) * DM) + F.lane;
#pragma unroll
            for (int j = 0; j < 8; ++j) vn[j] = xr[64 * j]; }
#pragma unroll
        for (int j = 0; j < 8; ++j) s += (v[j].x * v[j].x + v[j].y * v[j].y) + (v[j].z * v[j].z + v[j].w * v[j].w);
        const float rs = rsqrtf(wave_sum(s) * (1.f / DM) + EPS);
        float lg[NEXP];
        if (ROUTER) {
#pragma unroll
            for (int e = 0; e < NEXP; ++e) lg[e] = 0.f; }
        u32x2* o8 = (u32x2*)(hb + (size_t)m * DM) + F.lane;
#pragma unroll
        for (int j = 0; j < 8; ++j) { const f32x4 w4 = ((const f32x4*)w)[F.lane + 64 * j]; const f32x4 y = v[j] * rs * w4;
            u32x2 o; o.x = pk2(y.x, y.y); o.y = pk2(y.z, y.w); o8[64 * j] = o;
            if (ROUTER) {
#pragma unroll
                for (int i = 0; i < 4; ++i) { const int k = 4 * (F.lane + 64 * j) + i; const int sw = (k >> 3) & 7; const f32x4 r0 = ((const LAS f32x4*)rl)[(2 * k) ^ sw], r1 = ((const LAS f32x4*)rl)[(2 * k + 1) ^ sw]; const float yy = y[i];
                    lg[0] += yy * r0.x; lg[1] += yy * r0.y; lg[2] += yy * r0.z; lg[3] += yy * r0.w; lg[4] += yy * r1.x; lg[5] += yy * r1.y; lg[6] += yy * r1.z; lg[7] += yy * r1.w; }
                asm volatile("" ::: "memory"); } }
        if (ROUTER) {
#pragma unroll
            for (int e = 0; e < NEXP; ++e) lg[e] = wave_sum(lg[e]);
            int i1 = 0; float l1 = lg[0];
#pragma unroll
            for (int e = 1; e < NEXP; ++e) if (lg[e] > l1) { l1 = lg[e]; i1 = e; }
            int i2 = -1; float l2 = -3.0e38f;
#pragma unroll
            for (int e = 0; e < NEXP; ++e) if (e != i1 && lg[e] > l2) { l2 = lg[e]; i2 = e; }
            const float g1 = 1.f / (1.f + __expf(l2 - l1)), g2 = 1.f - g1;
            if (F.lane == 0) { topi[2 * m] = i1; topi[2 * m + 1] = i2; topg[2 * m] = g1; topg[2 * m + 1] = g2; }
        }
    }
    if (ROUTER) __syncthreads();
}

typedef float f32x16 __attribute__((ext_vector_type(16)));
typedef short s16x4 __attribute__((ext_vector_type(4)));
#define MFMA32(a, b, c) __builtin_amdgcn_mfma_f32_32x32x16_bf16((a), (b), (c), 0, 0, 0)
constexpr float LOG2E = 1.4426950408889634f;
DI unsigned off_b(unsigned row, unsigned ch) { return 256u * row + 16u * (ch ^ (((row & 3) << 2) | ((row >> 2) & 3))); }
DI float xhalf_other(float x) { const int l = __builtin_amdgcn_mbcnt_hi(-1, __builtin_amdgcn_mbcnt_lo(-1, 0)); return __builtin_bit_cast(float, __builtin_amdgcn_ds_bpermute((l ^ 32) << 2, __builtin_bit_cast(int, x))); }
DI float xhalf_max(float x) { return fmaxf(x, xhalf_other(x)); }
DI float xhalf_sum(float x) { return x + xhalf_other(x); }
struct FaState { f32x16 acc[4]; float m, l; };
DI void fa_reset(FaState& st) {
#pragma unroll
    for (int d = 0; d < 4; ++d)
#pragma unroll
        for (int i = 0; i < 16; ++i) st.acc[d][i] = 0.f;
    st.m = -1e30f; st.l = 0.f; }
DI void fa_issue(const bf16_t* K, const bf16_t* V, size_t stride, int k0, LAS unsigned char* kb, LAS unsigned char* vb, int wave, int lane) {
#pragma unroll
    for (int i = 0; i < 2; ++i) { const int pos = (wave + 8 * i) * 64 + lane, row = pos >> 4, ch = (pos & 15) ^ (((row & 3) << 2) | ((row >> 2) & 3));
        const size_t o = (size_t)(k0 + row) * stride + ch * 8;
        dma16(K + o, kb + (wave + 8 * i) * 1024);
        dma16(V + o, vb + (wave + 8 * i) * 1024); } }
#define FA_LANDED() do { asm volatile("s_waitcnt vmcnt(0)" ::: "memory"); __syncthreads(); } while (0)
template <int MODE> DI void fa_tile(FaState& st, const LAS unsigned char* qf  , const LAS unsigned char* kb, const LAS unsigned char* vbuf, int kbase, int vb4, int h,
                                    int k0, int ka, int kc, int qp, int window, float sc2, float sl2, bool lanevalid) {
    f32x16 s0, s1;
#pragma unroll
    for (int i = 0; i < 16; ++i) { s0[i] = 0.f; s1[i] = 0.f; }
#pragma unroll
    for (int s = 0; s < 8; ++s) { const bf16x8 a0 = *(const LAS bf16x8*)(kb + (kbase ^ (32 * s))), a1 = *(const LAS bf16x8*)(kb + (kbase ^ (32 * s)) + 8192);
        const bf16x8 qv = *(const LAS bf16x8*)(qf + 1024 * s);
        s0 = MFMA32(a0, qv, s0); s1 = MFMA32(a1, qv, s1);
        }
    float x[32]; float mx = -1e30f;
    const int kp0 = ka * (k0 + 4 * h) + kc;
    const int qw = __builtin_amdgcn_readfirstlane(qp & ~31);
    if (qw >= ka * (k0 + 63) + kc && qw + 31 - (ka * k0 + kc) < window) {
        const float base = lanevalid ? -sl2 * (float)(qp - kp0) : -1e30f, tk = sl2 * (float)ka;
#pragma unroll
        for (int mt = 0; mt < 2; ++mt)
#pragma unroll
            for (int i = 0; i < 16; ++i) { const float sv = mt ? s1[i] : s0[i]; const float xv = __builtin_fmaf((float)(32 * mt + (i & 3) + 8 * (i >> 2)), tk, __builtin_fmaf(sv, sc2, base)); x[mt * 16 + i] = xv; mx = fmaxf(mx, xv); }
    } else {
#pragma unroll
        for (int mt = 0; mt < 2; ++mt)
#pragma unroll
            for (int i = 0; i < 16; ++i) { const int dist = qp - (kp0 + ka * (32 * mt + (i & 3) + 8 * (i >> 2))); const bool ok = lanevalid && dist >= 0 && dist < window;
                const float sv = mt ? s1[i] : s0[i]; const float xv = ok ? sv * sc2 - sl2 * (float)dist : -1e30f; x[mt * 16 + i] = xv; mx = fmaxf(mx, xv); }
    }
    if (MODE == 1) {
#pragma unroll
        for (int mt = 0; mt < 2; ++mt)
#pragma unroll
            for (int g4 = 0; g4 < 4; ++g4) { float pp[4];
#pragma unroll
                for (int e = 0; e < 4; ++e) { const float xv = x[mt * 16 + 4 * g4 + e]; pp[e] = xv > -1e29f ? exp2f(xv - st.m) * st.l : 0.f; }
                const float av = (pp[0] + pp[1]) + (pp[2] + 0.5f * pp[3]), bv = 0.5f * pp[3];
                if (k0 == 0) { st.acc[0][2 * (mt * 4 + g4)] = av; st.acc[0][2 * (mt * 4 + g4) + 1] = bv; } else { st.acc[1][2 * (mt * 4 + g4)] = av; st.acc[1][2 * (mt * 4 + g4) + 1] = bv; } }
        return;
    }
    mx = xhalf_max(mx);
    const float mn = fmaxf(st.m, mx), alpha = __builtin_amdgcn_exp2f(st.m - mn), mne = fmaxf(mn, -1e28f);
    float ls = 0.f;
#pragma unroll
    for (int i = 0; i < 32; ++i) { const float pv = __builtin_amdgcn_exp2f(x[i] - mne); x[i] = pv; ls += pv; }
    const bool moved = __builtin_amdgcn_ballot_w64(mn > st.m) != 0ull;
    st.l = st.l * alpha + ls; st.m = mn;
    if (moved) {
#pragma unroll
        for (int d = 0; d < 4; ++d)
#pragma unroll
            for (int i = 0; i < 16; ++i) st.acc[d][i] *= alpha;
    }
#pragma unroll
    for (int mt = 0; mt < 2; ++mt)
#pragma unroll
        for (int s2 = 0; s2 < 2; ++s2) {
            u32x4 pw; const int o = mt * 16 + 8 * s2;
            pw.x = cvt_pk_bf16(x[o + 0], x[o + 1]); pw.y = cvt_pk_bf16(x[o + 2], x[o + 3]); pw.z = cvt_pk_bf16(x[o + 4], x[o + 5]); pw.w = cvt_pk_bf16(x[o + 6], x[o + 7]);
            const bf16x8 pf = __builtin_bit_cast(bf16x8, pw);
#pragma unroll
            for (int dt = 0; dt < 4; ++dt) {
                const s16x4 t0 = __builtin_amdgcn_ds_read_tr16_b64_v4i16((LAS s16x4*)(vbuf + ((vb4 ^ (64 * dt)) + 8192 * mt + 4096 * s2)));
                const s16x4 t1 = __builtin_amdgcn_ds_read_tr16_b64_v4i16((LAS s16x4*)(vbuf + ((vb4 ^ (64 * dt + 32)) + 8192 * mt + 4096 * s2 + 2048)));
                const bf16x8 vf = {t0[0], t0[1], t0[2], t0[3], t1[0], t1[1], t1[2], t1[3]};
                st.acc[dt] = MFMA32(vf, pf, st.acc[dt]); }
        }
}
struct FaLane { int r, h, kbase, vb4; };
DI FaLane fa_lane(int lane) { FaLane L; L.r = lane & 31; L.h = lane >> 5;
    L.kbase = 256 * L.r + 16 * (L.h ^ (((L.r & 3) << 2) | ((L.r >> 2) & 3)));
    const int q = (lane & 15) >> 2, p = lane & 3, blk = (lane >> 4) & 1, lowx = (2 * blk + (p >> 1)) ^ L.h;
    L.vb4 = 1024 * L.h + 256 * q + 64 * q + 16 * lowx + 8 * (p & 1); return L; }

DI void swa_unit(Frame& F, const float* sinks, int u) {
    const int qt = u & 15, g = (u >> 4) & 1, b = u >> 5;
    int tid = F.tid; asm volatile("" : "+v"(tid)); const int lane = tid & 63, wave = __builtin_amdgcn_readfirstlane(tid >> 6);
    const FaLane L = fa_lane(lane);
    const bf16_t* proj = (const bf16_t*)(F.ws + WS_PROJ) + (size_t)b * SEQ * DINP;
    const int head = g * 2 + (wave >> 2), qp = 128 * qt + 32 * (wave & 3) + L.r;
    LAS unsigned char* buf = F.lds + LDS_SCR;
    LAS unsigned char* qf = F.lds + LDS_SCR + 65536 + wave * 8192 + lane * 16;
    { const bf16_t* qrow = proj + (size_t)qp * DINP + C_SQ + head * HD + 8 * L.h;
#pragma unroll
      for (int s = 0; s < 8; ++s) *(LAS bf16x8*)(qf + 1024 * s) = *(const bf16x8*)(qrow + 16 * s); }
    const float sl2 = exp2f(-(float)(head + 1)) * LOG2E, sc2 = QSCALE * LOG2E;
    const bf16_t* K = proj + C_SK + g * HD; const bf16_t* V = proj + C_SV + g * HD;
    FaState st; fa_reset(st);
    const int t_lo = 2 * qt - 2 > 0 ? 2 * qt - 2 : 0, t_hi = 2 * qt + 1;
    int cur = 0;
    fa_issue(K, V, DINP, 64 * t_hi, buf, buf + 16384, wave, lane);
    for (int t = t_hi; t >= t_lo; --t) {
        FA_LANDED();
        if (t > t_lo) fa_issue(K, V, DINP, 64 * (t - 1), buf + (cur ^ 1) * 32768, buf + (cur ^ 1) * 32768 + 16384, wave, lane);
        fa_tile<0>(st, qf, buf + cur * 32768, buf + cur * 32768 + 16384, L.kbase, L.vb4, L.h, 64 * t, 1, 0, qp, 128, sc2, sl2, true);
        cur ^= 1;
    }
    const float ltot = xhalf_sum(st.l) + exp2f(sinks[head] * LOG2E - st.m); const float inv = 1.f / ltot;
    bf16_t* orow = (bf16_t*)(F.ws + WS_MIX) + (size_t)(b * SEQ + qp) * DM + 1536 + head * HD + 4 * L.h;
#pragma unroll
    for (int dt = 0; dt < 4; ++dt)
#pragma unroll
        for (int g4 = 0; g4 < 4; ++g4) { u32x2 w; w.x = cvt_pk_bf16(st.acc[dt][4 * g4] * inv, st.acc[dt][4 * g4 + 1] * inv); w.y = cvt_pk_bf16(st.acc[dt][4 * g4 + 2] * inv, st.acc[dt][4 * g4 + 3] * inv);
            *(u32x2*)(orow + 32 * dt + 8 * g4) = w; }
    __syncthreads();
}

DI void nsa_unit(Frame& F, int u) {
    const int qt = 31 - (u & 31), b = u >> 5;
    int tid = F.tid; asm volatile("" : "+v"(tid)); const int lane = tid & 63, wave = __builtin_amdgcn_readfirstlane(tid >> 6);
    const FaLane L = fa_lane(lane);
    const bf16_t* proj = (const bf16_t*)(F.ws + WS_PROJ) + (size_t)b * SEQ * DINP;
    const int head = wave >> 1, ql = 32 * (wave & 1) + L.r, qp = 64 * qt + ql;
    LAS unsigned char* buf = F.lds + LDS_SCR;
    LAS unsigned char* qf = F.lds + LDS_SCR + 65536 + wave * 8192 + lane * 16;
    LAS float* imp = (LAS float*)(F.lds + LDS_SCR + 131072);
    LAS unsigned* selm = (LAS unsigned*)(F.lds + LDS_SCR + 131072 + 2 * 64 * 33 * 4);
    if (tid == 0) selm[64] = 0u;
    { const bf16_t* qrow = proj + (size_t)qp * DINP + C_NQ + head * HD + 8 * L.h;
#pragma unroll
      for (int s = 0; s < 8; ++s) *(LAS bf16x8*)(qf + 1024 * s) = *(const bf16x8*)(qrow + 16 * s); }
    const float sl2 = exp2f(-(float)(5 + head)) * LOG2E, sc2 = QSCALE * LOG2E;
    float* orow = (float*)(F.ws + WS_NSAO) + (size_t)(b * SEQ + qp) * 512 + head * HD + 4 * L.h;
    LAS float* impA = imp + (head * 64 + ql) * 33; LAS float* impB = impA + 4 * 64 * 33;
    FaState st; fa_reset(st);
    unsigned mysel = 0u; int cur = 0;
    const bf16_t gr0 = proj[(size_t)qp * DINP + C_NG + head], gr1 = proj[(size_t)qp * DINP + C_NG + 4 + head], gr2 = proj[(size_t)qp * DINP + C_NG + 8 + head];
    __syncthreads();
#pragma unroll 1
    for (int br = 0; br < 4; ++br) {
        const bool cmpb = br < 2;
        const bf16_t* K = cmpb ? (const bf16_t*)(F.ws + WS_KC) + (size_t)b * 128 * HD : proj + (br == 2 ? C_KSL : C_KW);
        const bf16_t* V = cmpb ? (const bf16_t*)(F.ws + WS_KC) + (size_t)(NB + b) * 128 * HD : proj + (br == 2 ? C_VSL : C_VW);
        const size_t stride = cmpb ? HD : DINP;
        const int ka = cmpb ? 16 : 1, kc = cmpb ? 31 : 0, window = br == 3 ? 512 : (1 << 30);
        unsigned tmask;
        if (cmpb) tmask = (4 * qt + 3 > 64) ? 3u : 1u;
        else if (br == 2) tmask = selm[64];
        else { const int lo = qt - 8 > 0 ? qt - 8 : 0; tmask = (qt == 31 ? 0xFFFFFFFFu : ((1u << (qt + 1)) - 1u)) & ~((1u << lo) - 1u); }
        tmask = __builtin_amdgcn_readfirstlane(tmask);
        if (tmask) fa_issue(K, V, stride, 64 * (31 - __builtin_clz(tmask)), buf + cur * 32768, buf + cur * 32768 + 16384, wave, lane);
        while (tmask) {
            const int j = 31 - __builtin_clz(tmask); tmask &= ~(1u << j);
            FA_LANDED();
            if (tmask) fa_issue(K, V, stride, 64 * (31 - __builtin_clz(tmask)), buf + (cur ^ 1) * 32768, buf + (cur ^ 1) * 32768 + 16384, wave, lane);
            const bool lv = br == 2 ? ((mysel >> j) & 1u) != 0u : true;
            if (br == 1) fa_tile<1>(st, qf, buf + cur * 32768, buf + cur * 32768 + 16384, L.kbase, L.vb4, L.h, 64 * j, ka, kc, qp, window, sc2, sl2, lv);
            else fa_tile<0>(st, qf, buf + cur * 32768, buf + cur * 32768 + 16384, L.kbase, L.vb4, L.h, 64 * j, ka, kc, qp, window, sc2, sl2, lv);
            cur ^= 1;
        }
        if (br == 1) {
#pragma unroll 1
            for (int hd = 0; hd < 4; ++hd) {
                if (head == hd) { LAS float* ia = imp + ql * 33; LAS float* ib = ia + 64 * 33;
#pragma unroll
                    for (int tl = 0; tl < 2; ++tl)
#pragma unroll
                        for (int g = 0; g < 8; ++g) { const int j = 16 * tl + 2 * g + L.h; const float av = st.acc[tl][2 * g], bv = st.acc[tl][2 * g + 1];
                            if (hd == 0) { ia[j] = av; ib[j + 1] = bv; } else { ia[j] += av; ib[j + 1] += bv; } }
                    if (hd == 0 && L.h == 0) ib[0] = 0.f; }
                __syncthreads();
            }
            if (tid < 64) {
                float sc[32];
                int qv = qt; asm volatile("" : "+v"(qv));
#pragma unroll
                for (int j = 0; j < 32; ++j) { float a = 0.f;
                    a = imp[tid * 33 + j] + imp[64 * 33 + tid * 33 + j];
                    const bool forced = (j == 0) || (j == qv) || (j == qv - 1);
                    sc[j] = (j <= qv) ? a + (forced ? 1000.f : 0.f) : -1.f; }
                unsigned m = 0u;
#pragma unroll 1
                for (int r = 0; r < 8; ++r) { float best = sc[0]; int bi = 0;
#pragma unroll
                    for (int j = 1; j < 32; ++j) if (sc[j] > best) { best = sc[j]; bi = j; }
                    if (best >= 0.f) m |= 1u << bi;
#pragma unroll
                    for (int j = 0; j < 32; ++j) sc[j] = (j == bi) ? -3.f : sc[j]; }
                selm[tid] = m; atomicOr((unsigned*)(selm + 64), m);
            }
            __syncthreads();
            mysel = selm[ql];
            fa_reset(st);
            continue;
        }
        const float ltot = xhalf_sum(st.l); const float inv = ltot > 0.f ? 1.f / ltot : 0.f;
        const int gi = br == 0 ? 0 : br - 1;
        const float gate = sigmoidf_(bf2f(gi == 0 ? gr0 : gi == 1 ? gr1 : gr2)) * inv;
        if (br == 0) {
#pragma unroll
            for (int dt = 0; dt < 4; ++dt)
#pragma unroll
                for (int g4 = 0; g4 < 4; ++g4) { f32x4 o; o.x = st.acc[dt][4 * g4] * gate; o.y = st.acc[dt][4 * g4 + 1] * gate; o.z = st.acc[dt][4 * g4 + 2] * gate; o.w = st.acc[dt][4 * g4 + 3] * gate;
                    *(f32x4*)(orow + 32 * dt + 8 * g4) = o; }
            st.l = inv;
#pragma unroll
            for (int d = 0; d < 4; ++d)
#pragma unroll
                for (int i = 0; i < 16; ++i) st.acc[d][i] = 0.f;
        } else if (br == 2) {
#pragma unroll
            for (int dt = 0; dt < 4; ++dt)
#pragma unroll
                for (int g4 = 0; g4 < 4; ++g4) { f32x4 o = *(const f32x4*)(orow + 32 * dt + 8 * g4); o.x += st.acc[dt][4 * g4] * gate; o.y += st.acc[dt][4 * g4 + 1] * gate; o.z += st.acc[dt][4 * g4 + 2] * gate; o.w += st.acc[dt][4 * g4 + 3] * gate;
                    *(f32x4*)(orow + 32 * dt + 8 * g4) = o; }
            fa_reset(st);
        } else {
            bf16_t* mrow = (bf16_t*)(F.ws + WS_MIX) + (size_t)(b * SEQ + qp) * DM + head * HD + 4 * L.h;
#pragma unroll
            for (int dt = 0; dt < 4; ++dt)
#pragma unroll
                for (int g4 = 0; g4 < 4; ++g4) { const f32x4 o = *(const f32x4*)(orow + 32 * dt + 8 * g4);
                    u32x2 w; w.x = cvt_pk_bf16(o.x + st.acc[dt][4 * g4] * gate, o.y + st.acc[dt][4 * g4 + 1] * gate); w.y = cvt_pk_bf16(o.z + st.acc[dt][4 * g4 + 2] * gate, o.w + st.acc[dt][4 * g4 + 3] * gate);
                    *(u32x2*)(mrow + 32 * dt + 8 * g4) = w; }
        }
    }
    __syncthreads();
}

DI void cmp_unit_mfma(Frame& F, int u, int layer, const float* posk, const float* posv) {
    const int mt = u & 3, b = (u >> 2) & 3, kv = u >> 4;
    int tid = F.tid; asm volatile("" : "+v"(tid)); const int lane = tid & 63, wave = __builtin_amdgcn_readfirstlane(tid >> 6), r = lane & 31, hh = lane >> 5;
    const bf16_t* proj = (const bf16_t*)(F.ws + WS_PROJ) + (size_t)b * SEQ * DINP + (kv ? C_VC : C_KC);
    const bf16_t* w1t = (const bf16_t*)(F.ws + WS_CW1) + (size_t)(layer * 2 + kv) * 256 * 4096;
    const bf16_t* w2t = (const bf16_t*)(F.ws + WS_CW2) + (size_t)(layer * 2 + kv) * HD * 256;
    const float* pos = kv ? posv : posk;
    LAS unsigned char* bufs = F.lds + LDS_SCR;
    const int srow = tid >> 4, sch = tid & 15;
    const int tokb = 16 * (32 * mt + srow);
    const unsigned sslot = (unsigned)srow * 256u + (unsigned)((sch ^ (srow & 15)) * 16);
    u32x4 pa;
#define CMP_LOADA(j) do { const int tk_ = tokb + (j) < SEQ ? tokb + (j) : SEQ - 1; pa = *(const u32x4*)(proj + (size_t)tk_ * DINP + 8 * sch); } while (0)
#define CMP_ISSUEB(j, bb_) do { _Pragma("unroll") for (int i_ = 0; i_ < 8; ++i_) { const int pc_ = wave + 8 * i_, row_ = 4 * pc_ + (lane >> 4), ch_ = (lane & 15) ^ (row_ & 15); \
        dma16(w1t + (size_t)row_ * 4096 + (j) * 128 + 8 * ch_, (bb_) + pc_ * 1024); } } while (0)
    CMP_LOADA(0); CMP_ISSUEB(0, bufs + 8192);
    f32x16 acc;
#pragma unroll
    for (int i = 0; i < 16; ++i) acc[i] = 0.f;
#pragma unroll 1
    for (int j = 0; j < 32; ++j) {
        LAS unsigned char* ab = bufs + (j & 1) * 73728; LAS unsigned char* bb = ab + 8192;
        { const f32x4 p0 = *(const f32x4*)(pos + j * 128 + 8 * sch), p1 = *(const f32x4*)(pos + j * 128 + 8 * sch + 4);
          u32x4 aw; aw.x = cvt_pk_bf16(bflo(pa.x) + p0.x, bfhi(pa.x) + p0.y); aw.y = cvt_pk_bf16(bflo(pa.y) + p0.z, bfhi(pa.y) + p0.w);
          aw.z = cvt_pk_bf16(bflo(pa.z) + p1.x, bfhi(pa.z) + p1.y); aw.w = cvt_pk_bf16(bflo(pa.w) + p1.z, bfhi(pa.w) + p1.w);
          *(LAS u32x4*)(ab + sslot) = aw; }
        FA_LANDED();
        if (j < 31) { CMP_LOADA(j + 1); CMP_ISSUEB(j + 1, bufs + ((j + 1) & 1) * 73728 + 8192); }
#pragma unroll
        for (int s = 0; s < 8; ++s) { const bf16x8 a = *(const LAS bf16x8*)(ab + r * 256 + (((2 * s + hh) ^ (r & 15)) * 16)); const bf16x8 bw = *(const LAS bf16x8*)(bb + (32 * wave + r) * 256 + (((2 * s + hh) ^ (r & 15)) * 16));
            acc = MFMA32(a, bw, acc); }
    }
#undef CMP_LOADA
#undef CMP_ISSUEB
    __syncthreads();
    LAS unsigned char* h1 = bufs;
    { const int o = 32 * wave + r;
#pragma unroll
      for (int i = 0; i < 16; ++i) { const int nl = (i & 3) + 8 * (i >> 2) + 4 * hh; *(LAS bf16_t*)(h1 + nl * 512 + (((o >> 3) ^ (nl & 15)) * 16) + (o & 7) * 2) = (bf16_t)f2bf(siluf_(acc[i])); } }
    __syncthreads();
    if (wave < 4) {
        f32x16 a2;
#pragma unroll
        for (int i = 0; i < 16; ++i) a2[i] = 0.f;
        const bf16_t* b2 = w2t + (size_t)(32 * wave + r) * 256 + 8 * hh;
#pragma unroll
        for (int s = 0; s < 16; ++s) { const bf16x8 a = *(const LAS bf16x8*)(h1 + r * 512 + (((2 * s + hh) ^ (r & 15)) * 16)); const bf16x8 bb2 = *(const bf16x8*)(b2 + 16 * s); a2 = MFMA32(a, bb2, a2); }
        bf16_t* outb = (bf16_t*)(F.ws + WS_KC) + ((size_t)(kv * NB + b) * 128) * HD + 32 * wave + r;
#pragma unroll
        for (int i = 0; i < 16; ++i) { const int n = 32 * mt + (i & 3) + 8 * (i >> 2) + 4 * hh; outb[(size_t)n * HD] = (bf16_t)(n < 127 ? f2bf(a2[i]) : 0u); }
    }
    __syncthreads();
}

#define MFMA16(a, b, c) __builtin_amdgcn_mfma_f32_16x16x32_bf16((a), (b), (c), 0, 0, 0)
DI float row16_sum(float v) { v += DPPF(v, 0xB1); v += DPPF(v, 0x4E); v += DPPF(v, 0x141); v += DPPF(v, 0x140); return v; }
DI void gdn_chunk_mfma(Frame& F, int u, const float* cw, const float* alog, const float* dtb) {
    const int n = u & 31, h = (u >> 5) & 7, b = u >> 8, bh = b * NGH + h, t0 = n * 64;
    int tid = F.tid; asm volatile("" : "+v"(tid)); const int lane = tid & 63, wave = __builtin_amdgcn_readfirstlane(tid >> 6);
    const bf16_t* proj = (const bf16_t*)(F.ws + WS_PROJ) + (size_t)b * SEQ * DINP;
    LAS float* kf = (LAS float*)(F.lds + LDS_SCR);
    LAS float* vf = kf + 64 * 132;
    LAS float* Ls = vf + 64 * 132;
    LAS unsigned char* qb = (LAS unsigned char*)(Ls + 64 * 68);
    LAS unsigned char* kb = qb + 16384;
    LAS float* gcs = (LAS float*)(kb + 16384);
    LAS float* bts = gcs + 64;
    LAS float* egs = bts + 64;
    LAS float* sc1 = egs + 64;
    const size_t cidx = (size_t)bh * 32 + n;
    unsigned char* gW = F.ws + WS_GW + cidx * 57344; unsigned char* gQ = gW + 16384; unsigned char* gK = gW + 32768; unsigned char* gA = gW + 49152;
    float* gU = (float*)(F.ws + WS_GU_) + cidx * 8192;
    const int ch = tid & 15, sg = (tid >> 4) & 7, mat = tid >> 7;
    float w[4][8]; u32x4 rows[8], rp[3] = {{0u, 0u, 0u, 0u}, {0u, 0u, 0u, 0u}, {0u, 0u, 0u, 0u}};
    if (tid < 384) {
        const int col = (mat == 0 ? C_GQ : mat == 1 ? C_GK : C_GV) + h * HD + 8 * ch;
#pragma unroll
        for (int j = 0; j < 4; ++j) { const f32x4 a = *(const f32x4*)(cw + j * 3072 + mat * 1024 + h * HD + 8 * ch), c = *(const f32x4*)(cw + j * 3072 + mat * 1024 + h * HD + 8 * ch + 4);
            w[j][0] = a.x; w[j][1] = a.y; w[j][2] = a.z; w[j][3] = a.w; w[j][4] = c.x; w[j][5] = c.y; w[j][6] = c.z; w[j][7] = c.w; }
        const int tb = t0 + 8 * sg;
        if (tb - 3 >= 0) rp[0] = *(const u32x4*)(proj + (size_t)(tb - 3) * DINP + col);
        if (tb - 2 >= 0) rp[1] = *(const u32x4*)(proj + (size_t)(tb - 2) * DINP + col);
        if (tb - 1 >= 0) rp[2] = *(const u32x4*)(proj + (size_t)(tb - 1) * DINP + col);
#pragma unroll
        for (int ii = 0; ii < 8; ++ii) rows[ii] = *(const u32x4*)(proj + (size_t)(tb + ii) * DINP + col);
    }
    if (tid < 64) {
        const bf16_t* pr = proj + (size_t)(t0 + tid) * DINP;
        const float a = bf2f(pr[C_GA + h]), bb = bf2f(pr[C_GB + h]);
        float g = -__expf(alog[h]) * softplusf_(a + dtb[h]);
        g += DPPF(g, 0x111); g += DPPF(g, 0x112); g += DPPF(g, 0x114); g += DPPF(g, 0x118);
        { const float r0 = __builtin_bit_cast(float, __builtin_amdgcn_readlane(__builtin_bit_cast(int, g), 15)), r1 = __builtin_bit_cast(float, __builtin_amdgcn_readlane(__builtin_bit_cast(int, g), 31)),
                      r2 = __builtin_bit_cast(float, __builtin_amdgcn_readlane(__builtin_bit_cast(int, g), 47));
          g += (lane >= 48) ? (r0 + r1) + r2 : (lane >= 32) ? r0 + r1 : (lane >= 16) ? r0 : 0.f; }
        const float be = sigmoidf_(bb), eg = __expf(g);
        gcs[tid] = g; bts[tid] = be; egs[tid] = eg; sc1[tid] = be * eg;
    }
    __syncthreads();
    const float gl = gcs[63];
    if (tid < 384) {
        float x0[8] = {bflo(rp[0].x), bfhi(rp[0].x), bflo(rp[0].y), bfhi(rp[0].y), bflo(rp[0].z), bfhi(rp[0].z), bflo(rp[0].w), bfhi(rp[0].w)};
        float x1[8] = {bflo(rp[1].x), bfhi(rp[1].x), bflo(rp[1].y), bfhi(rp[1].y), bflo(rp[1].z), bfhi(rp[1].z), bflo(rp[1].w), bfhi(rp[1].w)};
        float x2[8] = {bflo(rp[2].x), bfhi(rp[2].x), bflo(rp[2].y), bfhi(rp[2].y), bflo(rp[2].z), bfhi(rp[2].z), bflo(rp[2].w), bfhi(rp[2].w)};
#pragma unroll
        for (int ii = 0; ii < 8; ++ii) {
            const int i = 8 * sg + ii;
            const u32x4 r = rows[ii];
            float x3[8] = {bflo(r.x), bfhi(r.x), bflo(r.y), bfhi(r.y), bflo(r.z), bfhi(r.z), bflo(r.w), bfhi(r.w)};
            float y[8]; float ss = 0.f;
#pragma unroll
            for (int e = 0; e < 8; ++e) { y[e] = siluf_(x0[e] * w[0][e] + x1[e] * w[1][e] + x2[e] * w[2][e] + x3[e] * w[3][e]); ss += y[e] * y[e]; x0[e] = x1[e]; x1[e] = x2[e]; x2[e] = x3[e]; }
            ss = row16_sum(ss);
            const unsigned slot = (unsigned)i * 256u + (unsigned)((ch ^ (i & 15)) * 16);
            if (mat == 0) { const float sc = rsqrtf(ss + EPS) * QSCALE, eg = egs[i];
                u32x4 o, od; o.x = cvt_pk_bf16(y[0] * sc, y[1] * sc); o.y = cvt_pk_bf16(y[2] * sc, y[3] * sc); o.z = cvt_pk_bf16(y[4] * sc, y[5] * sc); o.w = cvt_pk_bf16(y[6] * sc, y[7] * sc);
                const float s2 = sc * eg; od.x = cvt_pk_bf16(y[0] * s2, y[1] * s2); od.y = cvt_pk_bf16(y[2] * s2, y[3] * s2); od.z = cvt_pk_bf16(y[4] * s2, y[5] * s2); od.w = cvt_pk_bf16(y[6] * s2, y[7] * s2);
                *(LAS u32x4*)(qb + slot) = o;
                { const int dc = 4 * (ch >> 2) + 2 * (ch & 1), hb = 8 * ((ch & 3) >> 1);
                  *(u32x2*)(gQ + (unsigned)i * 256u + (unsigned)(((dc) ^ (i & 15)) * 16 + hb)) = (u32x2){od.x, od.y}; *(u32x2*)(gQ + (unsigned)i * 256u + (unsigned)(((dc + 1) ^ (i & 15)) * 16 + hb)) = (u32x2){od.z, od.w}; }
            } else if (mat == 1) { const float sc = rsqrtf(ss + EPS);
                u32x4 o; o.x = cvt_pk_bf16(y[0] * sc, y[1] * sc); o.y = cvt_pk_bf16(y[2] * sc, y[3] * sc); o.z = cvt_pk_bf16(y[4] * sc, y[5] * sc); o.w = cvt_pk_bf16(y[6] * sc, y[7] * sc);
                *(LAS u32x4*)(kb + slot) = o;
                *(LAS f32x4*)(kf + i * 132 + 8 * ch) = (f32x4){y[0] * sc, y[1] * sc, y[2] * sc, y[3] * sc}; *(LAS f32x4*)(kf + i * 132 + 8 * ch + 4) = (f32x4){y[4] * sc, y[5] * sc, y[6] * sc, y[7] * sc};
            } else {
                *(LAS f32x4*)(vf + i * 132 + 8 * ch) = (f32x4){y[0], y[1], y[2], y[3]}; *(LAS f32x4*)(vf + i * 132 + 8 * ch + 4) = (f32x4){y[4], y[5], y[6], y[7]}; }
        }
    }
    __syncthreads();
    {
        const int ti = (wave >> 1) & 1, tj = wave & 1, r = lane & 31, hh = lane >> 5;
        const LAS unsigned char* ab = (wave < 4) ? kb : qb;
        f32x16 c;
#pragma unroll
        for (int i = 0; i < 16; ++i) c[i] = 0.f;
        const int ra = 32 * ti + r, rb = 32 * tj + r;
#pragma unroll
        for (int s = 0; s < 8; ++s) { const bf16x8 a = *(const LAS bf16x8*)(ab + ra * 256 + (((2 * s + hh) ^ (ra & 15)) * 16)), bb = *(const LAS bf16x8*)(kb + rb * 256 + (((2 * s + hh) ^ (rb & 15)) * 16));
            c = MFMA32(a, bb, c); }
        const int j = 32 * tj + r; const float gcj = gcs[j];
#pragma unroll
        for (int rg = 0; rg < 16; ++rg) { const int i = 32 * ti + (rg & 3) + 8 * (rg >> 2) + 4 * hh; const float dec = __expf(fminf(gcs[i] - gcj, 0.f));
            if (wave < 4) Ls[i * 68 + j] = (j < i) ? bts[i] * c[rg] * dec : 0.f;
            else { const float av = (j <= i) ? c[rg] * dec : 0.f; const int jp = (j & 32) + 8 * ((j >> 2) & 3) + 4 * ((j >> 4) & 1) + (j & 3);
                *(bf16_t*)(gA + (size_t)(i * 8 + ((jp >> 3) ^ ((i >> 1) & 7))) * 16 + (jp & 7) * 2) = (bf16_t)f2bf(av); } }
    }
    for (int x = tid; x < 1024; x += 512) { const int k = x >> 3, ch = x & 7; float v8[8];
#pragma unroll
        for (int e = 0; e < 8; ++e) { const int c = 8 * ch + e; v8[e] = kf[c * 132 + k] * __expf(gl - gcs[c]); }
        u32x4 o; o.x = cvt_pk_bf16(v8[0], v8[1]); o.y = cvt_pk_bf16(v8[2], v8[3]); o.z = cvt_pk_bf16(v8[4], v8[5]); o.w = cvt_pk_bf16(v8[6], v8[7]);
        { const int dc = 4 * (ch >> 2) + 2 * (ch & 1), hb = 8 * ((ch & 3) >> 1);
          *(u32x2*)(gK + (unsigned)k * 128u + (unsigned)(((dc) ^ ((k >> 1) & 7)) * 16 + hb)) = (u32x2){o.x, o.y}; *(u32x2*)(gK + (unsigned)k * 128u + (unsigned)(((dc + 1) ^ ((k >> 1) & 7)) * 16 + hb)) = (u32x2){o.z, o.w}; } }
    if (tid == 0) ((float*)(F.ws + WS_GGL))[cidx] = __expf(gl);
    __syncthreads();
    LAS unsigned char* loff = (LAS unsigned char*)(sc1 + 64);
    LAS unsigned char* dinv = loff + 8192;
    { const int r = tid >> 3, cq = tid & 7, s2 = cq >> 2, qq = cq & 3;
      const f32x4 a = *(const LAS f32x4*)(Ls + r * 68 + 32 * s2 + 4 * qq), bq = *(const LAS f32x4*)(Ls + r * 68 + 32 * s2 + 16 + 4 * qq);
      const bool k0 = (2 * s2) < (r >> 4), k1 = (2 * s2 + 1) < (r >> 4);
      u32x4 o; o.x = k0 ? cvt_pk_bf16(-a.x, -a.y) : 0u; o.y = k0 ? cvt_pk_bf16(-a.z, -a.w) : 0u; o.z = k1 ? cvt_pk_bf16(-bq.x, -bq.y) : 0u; o.w = k1 ? cvt_pk_bf16(-bq.z, -bq.w) : 0u;
      *(LAS u32x4*)(loff + r * 128 + ((cq ^ ((r >> 1) & 7)) * 16)) = o;
      if (tid < 256) ((LAS u32x4*)dinv)[tid] = (u32x4){0u, 0u, 0u, 0u}; }
    __syncthreads();
    if (tid < 64) {
        const int bk = tid >> 4, j = tid & 15; float t[16];
#pragma unroll
        for (int i = 0; i < 16; ++i) { float a = (i == j) ? 1.f : 0.f;
#pragma unroll
            for (int k = 0; k < i; ++k) a -= Ls[(16 * bk + i) * 68 + 16 * bk + k] * t[k];
            t[i] = (i < j) ? 0.f : a; }
#pragma unroll
        for (int i = 0; i < 16; ++i) *(LAS bf16_t*)(dinv + (16 * bk + i) * 64 + 16 * (j >> 2) + 2 * (j & 3)) = (bf16_t)f2bf(t[i]);
    }
    __syncthreads();
    {
        const int nn = lane & 15, q = lane >> 4;
        const LAS float* srcm = (wave < 4) ? vf : kf; const LAS float* scl = (wave < 4) ? bts : sc1; const int cb = 32 * (wave & 3);
        f32x4 X[4][2];
#pragma unroll
        for (int bk = 0; bk < 4; ++bk)
#pragma unroll
            for (int nt = 0; nt < 2; ++nt)
#pragma unroll
                for (int i = 0; i < 4; ++i) { const int row = 16 * bk + 4 * q + i; X[bk][nt][i] = scl[row] * srcm[row * 132 + cb + 16 * nt + nn]; }
        const f32x4 z4 = {0.f, 0.f, 0.f, 0.f};
#pragma unroll
        for (int bk = 0; bk < 4; ++bk) {
#pragma unroll
            for (int nt = 0; nt < 2; ++nt) {
                f32x4 r = X[bk][nt];
#pragma unroll
                for (int s2 = 0; s2 < 2; ++s2) if (2 * s2 < bk) {
                    const int row = 16 * bk + nn; const bf16x8 lf = *(const LAS bf16x8*)(loff + row * 128 + (((4 * s2 + q) ^ ((row >> 1) & 7)) * 16));
                    const f32x4 xa = X[2 * s2][nt], xb = X[2 * s2 + 1][nt];
                    u32x4 pw; pw.x = cvt_pk_bf16(xa[0], xa[1]); pw.y = cvt_pk_bf16(xa[2], xa[3]); pw.z = cvt_pk_bf16(xb[0], xb[1]); pw.w = cvt_pk_bf16(xb[2], xb[3]);
                    r = MFMA16(lf, __builtin_bit_cast(bf16x8, pw), r); }
                const bf16x8 df = *(const LAS bf16x8*)(dinv + (16 * bk + nn) * 64 + q * 16);
                u32x4 pr; pr.x = cvt_pk_bf16(r[0], r[1]); pr.y = cvt_pk_bf16(r[2], r[3]); pr.z = 0u; pr.w = 0u;
                X[bk][nt] = MFMA16(df, __builtin_bit_cast(bf16x8, pr), z4);
            }
        }
        if (wave < 4) {
#pragma unroll
            for (int bk = 0; bk < 4; ++bk)
#pragma unroll
                for (int nt = 0; nt < 2; ++nt) *(f32x4*)(gU + ((size_t)(((2 * wave + nt) * 4 + bk) * 64 + lane)) * 4) = X[bk][nt];
        } else {
#pragma unroll
            for (int bk = 0; bk < 4; ++bk)
#pragma unroll
                for (int nt = 0; nt < 2; ++nt)
#pragma unroll
                    for (int i = 0; i < 4; ++i) kf[(16 * bk + 4 * q + i) * 132 + cb + 16 * nt + nn] = X[bk][nt][i];
        }
    }
    __syncthreads();
    for (int x = tid; x < 1024; x += 512) { const int c = x >> 4, ch = x & 15; const f32x4 a = *(const LAS f32x4*)(kf + c * 132 + 8 * ch), bq = *(const LAS f32x4*)(kf + c * 132 + 8 * ch + 4);
        u32x4 o; o.x = cvt_pk_bf16(a.x, a.y); o.y = cvt_pk_bf16(a.z, a.w); o.z = cvt_pk_bf16(bq.x, bq.y); o.w = cvt_pk_bf16(bq.z, bq.w);
        { const int dc = 4 * (ch >> 2) + 2 * (ch & 1), hb = 8 * ((ch & 3) >> 1);
          *(u32x2*)(gW + (unsigned)c * 256u + (unsigned)(((dc) ^ (c & 15)) * 16 + hb)) = (u32x2){o.x, o.y}; *(u32x2*)(gW + (unsigned)c * 256u + (unsigned)(((dc + 1) ^ (c & 15)) * 16 + hb)) = (u32x2){o.z, o.w}; } }
    __syncthreads();
}

DI void gdn_scan_mfma(Frame& F, int su) {
    const int bh = su >> 1, vh = su & 1, b = bh >> 3, h = bh & 7;
    int tid = F.tid; asm volatile("" : "+v"(tid)); const int lane = tid & 63, wave = __builtin_amdgcn_readfirstlane(tid >> 6);
    const int nn = lane & 15, q = lane >> 4;
    LAS unsigned char* buf = F.lds + LDS_SCR;
    const unsigned char* gC = F.ws + WS_GW + (size_t)bh * 32 * 57344;
    const float* gU = (const float*)(F.ws + WS_GU_) + (size_t)bh * 32 * 8192; const float* GL = (const float*)(F.ws + WS_GGL) + bh * 32;
    const int w8 = 4 * vh + (wave & 3);
    const bool active = wave < 4;
    float* Og = (float*)(F.ws + WS_GO) + (size_t)b * SEQ * 1024 + h * HD + 16 * w8 + 4 * q;
#define GDN_ISSUE(nchunk, bufp) do { if (!active) { const unsigned char* sb_ = gC + (size_t)(nchunk) * 57344 + (wave - 4) * 14336; LAS unsigned char* lb_ = (bufp) + (wave - 4) * 14336; \
        _Pragma("unroll") for (int pi = 0; pi < 14; ++pi) dma16s(sb_ + pi * 1024, (unsigned)lane * 16u, lb_ + pi * 1024); \
        const unsigned char* su_ = (const unsigned char*)(gU + (size_t)(nchunk) * 8192 + vh * 4096) + (wave - 4) * 4096; LAS unsigned char* lu_ = (bufp) + 57344 + (wave - 4) * 4096; \
        _Pragma("unroll") for (int pi = 0; pi < 4; ++pi) dma16s(su_ + pi * 1024, (unsigned)lane * 16u, lu_ + pi * 1024); } } while (0)
    f32x4 S[8];
#pragma unroll
    for (int a = 0; a < 8; ++a) S[a] = (f32x4){0.f, 0.f, 0.f, 0.f};
    const int m = nn;
    GDN_ISSUE(0, buf);
    f32x4 Oprev[4]; const float glv = GL[lane & 31];
#pragma unroll
    for (int t = 0; t < 4; ++t) Oprev[t] = (f32x4){0.f, 0.f, 0.f, 0.f};
    int cur = 0;
#pragma unroll 1
    for (int n = 0; n < 32; ++n) {
        FA_LANDED();
        if (n < 31) GDN_ISSUE(n + 1, buf + (cur ^ 1) * 73728);
        const LAS unsigned char* lw = buf + cur * 73728; const LAS unsigned char* lq = lw + 16384; const LAS unsigned char* lk = lw + 32768; const LAS unsigned char* la = lw + 49152;
        if (active) {
        if (n > 0) {
#pragma unroll
            for (int t = 0; t < 4; ++t) *(f32x4*)(Og + (size_t)(64 * (n - 1) + 16 * t + nn) * 1024) = Oprev[t]; }
        f32x4 U[4];
#pragma unroll
        for (int t = 0; t < 4; ++t) U[t] = *(const LAS f32x4*)(lw + 57344 + ((wave & 3) * 4 + t) * 1024 + lane * 16);
        const float gl = __builtin_bit_cast(float, __builtin_amdgcn_readlane(__builtin_bit_cast(int, glv), n));
        bf16x8 Sb[4];
#pragma unroll
        for (int s = 0; s < 4; ++s) { u32x4 pw; pw.x = cvt_pk_bf16(S[2 * s][0], S[2 * s][1]); pw.y = cvt_pk_bf16(S[2 * s][2], S[2 * s][3]); pw.z = cvt_pk_bf16(S[2 * s + 1][0], S[2 * s + 1][1]); pw.w = cvt_pk_bf16(S[2 * s + 1][2], S[2 * s + 1][3]);
            Sb[s] = __builtin_bit_cast(bf16x8, pw); }
#define GF256(base, row, s_) (*(const LAS bf16x8*)((base) + (unsigned)(row) * 256u + (unsigned)(((4 * (s_) + q) ^ ((row) & 15)) * 16)))
#define GF128(base, row, s_) (*(const LAS bf16x8*)((base) + (unsigned)(row) * 128u + (unsigned)(((4 * (s_) + q) ^ (((row) >> 1) & 7)) * 16)))
#define GSB() __builtin_amdgcn_sched_barrier(0)
        bf16x8 F0[8], F1[8];
        f32x4 T1[4], T2[4];
#pragma unroll
        for (int t = 0; t < 4; ++t) { T1[t] = (f32x4){0.f, 0.f, 0.f, 0.f}; T2[t] = (f32x4){0.f, 0.f, 0.f, 0.f}; }
#pragma unroll
        for (int i = 0; i < 8; ++i) F0[i] = GF256(lw, 16 * (i >> 2) + m, i & 3);
        GSB();
#pragma unroll
        for (int i = 0; i < 8; ++i) F1[i] = GF256(lw, 16 * (2 + (i >> 2)) + m, i & 3);
        GSB();
#pragma unroll
        for (int i = 0; i < 8; ++i) T1[i >> 2] = MFMA16(F0[i], Sb[i & 3], T1[i >> 2]);
        GSB();
#pragma unroll
        for (int i = 0; i < 8; ++i) F0[i] = GF128(lk, 16 * (i >> 1) + m, i & 1);
        GSB();
#pragma unroll
        for (int i = 0; i < 8; ++i) T1[2 + (i >> 2)] = MFMA16(F1[i], Sb[i & 3], T1[2 + (i >> 2)]);
        GSB();
        bf16x8 vb[2];
#pragma unroll
        for (int s2 = 0; s2 < 2; ++s2) { const f32x4 v0 = U[2 * s2] - T1[2 * s2], v1 = U[2 * s2 + 1] - T1[2 * s2 + 1];
            u32x4 pw; pw.x = cvt_pk_bf16(v0[0], v0[1]); pw.y = cvt_pk_bf16(v0[2], v0[3]); pw.z = cvt_pk_bf16(v1[0], v1[1]); pw.w = cvt_pk_bf16(v1[2], v1[3]); vb[s2] = __builtin_bit_cast(bf16x8, pw); }
#pragma unroll
        for (int i = 0; i < 8; ++i) F1[i] = GF128(lk, 16 * (4 + (i >> 1)) + m, i & 1);
        GSB();
#pragma unroll
        for (int a = 0; a < 8; ++a) S[a] = S[a] * gl;
#pragma unroll
        for (int i = 0; i < 8; ++i) S[i >> 1] = MFMA16(F0[i], vb[i & 1], S[i >> 1]);
        GSB();
#pragma unroll
        for (int i = 0; i < 8; ++i) F0[i] = GF256(lq, 16 * (i >> 2) + m, i & 3);
        GSB();
#pragma unroll
        for (int i = 0; i < 8; ++i) S[4 + (i >> 1)] = MFMA16(F1[i], vb[i & 1], S[4 + (i >> 1)]);
        GSB();
#pragma unroll
        for (int i = 0; i < 8; ++i) F1[i] = GF256(lq, 16 * (2 + (i >> 2)) + m, i & 3);
        GSB();
#pragma unroll
        for (int i = 0; i < 8; ++i) T2[i >> 2] = MFMA16(Sb[i & 3], F0[i], T2[i >> 2]);
        GSB();
#pragma unroll
        for (int i = 0; i < 8; ++i) F0[i] = GF128(la, 16 * (i >> 1) + m, i & 1);
        GSB();
#pragma unroll
        for (int i = 0; i < 8; ++i) T2[2 + (i >> 2)] = MFMA16(Sb[i & 3], F1[i], T2[2 + (i >> 2)]);
        GSB();
#pragma unroll
        for (int i = 0; i < 8; ++i) T2[i >> 1] = MFMA16(vb[i & 1], F0[i], T2[i >> 1]);
#undef GF256
#undef GF128
#undef GSB
#pragma unroll
        for (int t = 0; t < 4; ++t) Oprev[t] = T2[t];
        }
        cur ^= 1;
    }
    if (active) {
#pragma unroll
    for (int t = 0; t < 4; ++t) *(f32x4*)(Og + (size_t)(64 * 31 + 16 * t + nn) * 1024) = Oprev[t];
    }
#undef GDN_ISSUE
    __syncthreads();
}

DI void phase_gdn_out(Frame& F, const float* nw) {
    const bf16_t* proj = (const bf16_t*)(F.ws + WS_PROJ); const float* Og = (const float*)(F.ws + WS_GO); bf16_t* mix = (bf16_t*)(F.ws + WS_MIX);
    const int gw = F.bid * 8 + F.wave, NGW = F.G * 8, lane = F.lane, sub = lane >> 4, l16 = lane & 15;
    const f32x4 wa = *(const f32x4*)(nw + 8 * l16), wb = *(const f32x4*)(nw + 8 * l16 + 4);
#pragma unroll 4
    for (int it = gw; it < NTOK * NGH / 4; it += NGW) { const int item = 4 * it + sub, tok = item >> 3, h = item & 7;
        const float* op = Og + (size_t)tok * 1024 + h * HD + 8 * l16;
        const f32x4 a = *(const f32x4*)op, c = *(const f32x4*)(op + 4);
        const u32x4 zz = *(const u32x4*)(proj + (size_t)tok * DINP + C_GZ + h * HD + 8 * l16);
        const float ss = row16_sum(((a.x * a.x + a.y * a.y) + (a.z * a.z + a.w * a.w)) + ((c.x * c.x + c.y * c.y) + (c.z * c.z + c.w * c.w)));
        const float rs = rsqrtf(ss * (1.f / HD) + EPS);
        u32x4 o;
        o.x = pk2(a.x * rs * wa.x * siluf_(bflo(zz.x)), a.y * rs * wa.y * siluf_(bfhi(zz.x))); o.y = pk2(a.z * rs * wa.z * siluf_(bflo(zz.y)), a.w * rs * wa.w * siluf_(bfhi(zz.y)));
        o.z = pk2(c.x * rs * wb.x * siluf_(bflo(zz.z)), c.y * rs * wb.y * siluf_(bfhi(zz.z))); o.w = pk2(c.z * rs * wb.z * siluf_(bflo(zz.w)), c.w * rs * wb.w * siluf_(bfhi(zz.w)));
        *(u32x4*)(mix + (size_t)tok * DM + 512 + h * HD + 8 * l16) = o; }
}

DI void phase_route(Frame& F) {
    const int* topi = (const int*)(F.ws + WS_RT + RT_TOPI); const float* topg = (const float*)(F.ws + WS_RT + RT_TOPG);
    int* pos = (int*)(F.ws + WS_RT + RT_POS); float* rgate = (float*)(F.ws + WS_RT + RT_RGATE); int* texp = (int*)(F.ws + WS_RT + RT_TEXP); int* ntl = (int*)(F.ws + WS_RT + RT_NTILES);
    const bf16_t* hb = (const bf16_t*)(F.ws + WS_HB); bf16_t* hperm = (bf16_t*)(F.ws + WS_HPERM);
    LAS int* tot = (LAS int*)(F.lds + LDS_SCR);
    LAS int* bef = tot + 8;
    LAS int* pst = bef + 8;
    LAS int* dests = pst + 16;
    const int tid = F.tid, lane = F.lane;
    for (int blk = F.bid; blk < NTOK / 32; blk += F.G) {
        if (tid < 16) tot[tid] = 0;
        __syncthreads();
        int ct[NEXP], cb[NEXP];
#pragma unroll
        for (int e = 0; e < NEXP; ++e) { ct[e] = 0; cb[e] = 0; }
        { i32x4 tv[8];
#pragma unroll
          for (int j = 0; j < 8; ++j) tv[j] = ((const i32x4*)topi)[tid + 512 * j];
#pragma unroll
          for (int j = 0; j < 8; ++j)
#pragma unroll
            for (int c = 0; c < 4; ++c) { const int e = tv[j][c]; const bool before = 4 * (tid + 512 * j) + c < 64 * blk;
#pragma unroll
                for (int q = 0; q < NEXP; ++q) { ct[q] += (e == q); cb[q] += (e == q && before); } } }
#pragma unroll
        for (int e = 0; e < NEXP; ++e) { const int v = wave_sum_i(ct[e]), w = wave_sum_i(cb[e]);
            if (lane == 0) { atomicAdd((int*)(tot + e), v); atomicAdd((int*)(bef + e), w); } }
        __syncthreads();
        if (tid == 0) { int s = 0; for (int e = 0; e < NEXP; ++e) { pst[e] = s; s += (tot[e] + 255) / 256 * 256; } pst[NEXP] = s; }
        __syncthreads();
        if (tid < 64) { const int a = 64 * blk + tid, e = topi[a]; int rank = 0;
#pragma unroll
            for (int q = 0; q < NEXP; ++q) { const unsigned long long m = __ballot(e == q); if (e == q) rank = __popcll(m & ((1ull << lane) - 1ull)); }
            const int d = pst[e] + bef[e] + rank; dests[tid] = d; pos[a] = d; rgate[d] = topg[a]; }
        __syncthreads();
#pragma unroll 4
        for (int al = F.wave; al < 64; al += 8) { const int d = dests[al], tok = 32 * blk + (al >> 1);
            const u32x4* s = (const u32x4*)(hb + (size_t)tok * DM) + lane; u32x2* dd = (u32x2*)((unsigned char*)hperm + (size_t)d * DM) + lane;
#pragma unroll
            for (int j = 0; j < 4; ++j) { const u32x4 v = s[64 * j]; int w0 = 0, w1 = 0;
                w0 = __builtin_amdgcn_cvt_pk_fp8_f32(bflo(v.x), bfhi(v.x), w0, false); w0 = __builtin_amdgcn_cvt_pk_fp8_f32(bflo(v.y), bfhi(v.y), w0, true);
                w1 = __builtin_amdgcn_cvt_pk_fp8_f32(bflo(v.z), bfhi(v.z), w1, false); w1 = __builtin_amdgcn_cvt_pk_fp8_f32(bflo(v.w), bfhi(v.w), w1, true);
                dd[64 * j] = (u32x2){(unsigned)w0, (unsigned)w1}; } }
        for (int e = 0; e < NEXP; ++e) { const int lo = pst[e] + tot[e], hi = pst[e + 1];
            for (int r = lo + blk; r < hi; r += NTOK / 32) { ((unsigned*)((unsigned char*)hperm + (size_t)r * DM))[tid] = 0u; if (tid == 0) rgate[r] = 0.f; } }
        if (blk == 0) { const int nt = pst[NEXP] / 256; if (tid == 0) *ntl = nt;
            for (int i = tid; i < 72 * 8; i += 512) ((int*)(F.ws + WS_RT + RT_TAIL))[i] = -1;
            if (tid < nt) { int e = 0;
#pragma unroll
                for (int q = 1; q < NEXP; ++q) if (256 * tid >= pst[q]) e = q;
                texp[tid] = e; } }
        __syncthreads();
    }
}

DI void phase_final(Frame& F, const float* w) {
    const float* x = (const float*)(F.ws + WS_X); const bf16_t* y = (const bf16_t*)(F.ws + WS_Y); const int* pos = (const int*)(F.ws + WS_RT + RT_POS);
    const int gw = F.bid * 8 + F.wave, NGW = F.G * 8;
    for (int m = gw; m < NTOK; m += NGW) {
        const int p0 = pos[2 * m], p1 = pos[2 * m + 1];
        const f32x4* xr = (const f32x4*)(x + (size_t)m * DM) + F.lane; const u32x2* y0 = (const u32x2*)(y + (size_t)p0 * DM) + F.lane; const u32x2* y1 = (const u32x2*)(y + (size_t)p1 * DM) + F.lane;
        f32x4 v[8]; float s = 0.f;
        const int* tix = (const int*)(F.ws + WS_RT + RT_TAIL); const float* slab = (const float*)(F.ws + WS_SLAB); const float* rg = (const float*)(F.ws + WS_RT + RT_RGATE);
        const int tl0 = F.lane < 8 ? tix[(p0 >> 8) * 8 + F.lane] : -1, tl1 = F.lane < 8 ? tix[(p1 >> 8) * 8 + F.lane] : -1;
        const int KSPLIT = __builtin_amdgcn_readfirstlane(((const int*)(F.ws + WS_RT + RT_NTILES))[1]);
        f32x4 ya[8], yb[8];
#pragma unroll
        for (int j = 0; j < 8; ++j) { v[j] = xr[64 * j]; const u32x2 a = y0[64 * j], c = y1[64 * j]; ya[j] = (f32x4){bflo(a.x), bfhi(a.x), bflo(a.y), bfhi(a.y)}; yb[j] = (f32x4){bflo(c.x), bfhi(c.x), bflo(c.y), bfhi(c.y)}; }
        const unsigned m0 = (unsigned)__ballot(tl0 >= 0), m1 = (unsigned)__ballot(tl1 >= 0);
        if ((m0 | m1) != 0u) {
            const float g0 = rg[p0] * 0.015625f, g1 = rg[p1] * 0.015625f;
#pragma unroll
            for (int j = 0; j < 8; ++j) {
                if ((m0 >> j) & 1u) { asm volatile("" ::: "memory"); const int t0 = __builtin_amdgcn_readlane(tl0, j); const f32x4* sp = (const f32x4*)(slab + ((size_t)(t0 * KSPLIT) * 256 + (p0 & 255)) * 256) + F.lane; f32x4 a = sp[0];
#pragma unroll 1
                    for (int ks = 1; ks < KSPLIT; ++ks) a += sp[(size_t)ks * 16384];
                    ya[j] = a * g0; }
                if ((m1 >> j) & 1u) { asm volatile("" ::: "memory"); const int t1 = __builtin_amdgcn_readlane(tl1, j); const f32x4* sp = (const f32x4*)(slab + ((size_t)(t1 * KSPLIT) * 256 + (p1 & 255)) * 256) + F.lane; f32x4 a = sp[0];
#pragma unroll 1
                    for (int ks = 1; ks < KSPLIT; ++ks) a += sp[(size_t)ks * 16384];
                    yb[j] = a * g1; }
            }
        }
#pragma unroll
        for (int j = 0; j < 8; ++j) { v[j] = v[j] + ya[j] + yb[j]; s += (v[j].x * v[j].x + v[j].y * v[j].y) + (v[j].z * v[j].z + v[j].w * v[j].w); }
        const float rs = rsqrtf(wave_sum(s) * (1.f / DM) + EPS);
        f32x4* o = (f32x4*)(F.out + (size_t)m * DM) + F.lane;
#pragma unroll
        for (int j = 0; j < 8; ++j) o[64 * j] = v[j] * rs * ((const f32x4*)w)[F.lane + 64 * j];
    }
}

constexpr int PH_PER_LAYER = 11, N_PHASES = 1 + 2 * PH_PER_LAYER + 1;
#ifndef GDN_NAIVE
#define GDN_NAIVE 0
#endif
#define GDN_CHUNK gdn_chunk_mfma
#ifndef NSA_NAIVE
#define NSA_NAIVE 0
#endif
#ifndef REPMASK
#define REPMASK 0
#endif
#define NREP(k) ((((REPMASK) >> (k)) & 1) + 1)
#ifndef REPG
#define REPG 1
#endif
#ifndef REPX
#define REPX 1
#endif
#ifndef REPS
#define REPS 1
#endif
#ifndef REPN
#define REPN 1
#endif
#ifndef REPA
#define REPA 1
#endif
#ifndef REPB
#define REPB 1
#endif
#ifndef REPC
#define REPC 1
#endif
#ifndef PHMASK
#define PHMASK 0xFFFF
#endif
#define EN(k) (((PHMASK) >> (k)) & 1)
#define IN(k) (lo <= (k) && (k) < hi && (F.refresh(), true))
#define MARK(name) asm volatile("; MARK " name ::: "memory")
#define SEAM(k) do { if (IN((k) + 1)) xcd_barrier(bar, F.tid == 0); } while (0)
#define SEAMW(k) do { if (IN((k) + 1)) xcd_barrier_steal(bar, F.tid == 0, F, qactive, args.in[I_MGATE], args.in[I_MUP], args.in[I_MDOWN]); } while (0)
template <int layer> DI void run_layer(Frame& F, const Args& args, const int lo, const int hi, const XcdBarrier& bar, bool& qactive) {
    LAS unsigned char* scr = F.lds + LDS_SCR;
    bf16_t* HB = (bf16_t*)(F.ws + WS_HB); bf16_t* PROJ = (bf16_t*)(F.ws + WS_PROJ); bf16_t* MIX = (bf16_t*)(F.ws + WS_MIX); float* XB = (float*)(F.ws + WS_X);
    bf16_t* ACT = (bf16_t*)(F.ws + WS_ACT); bf16_t* HPERM = (bf16_t*)(F.ws + WS_HPERM); float* YB = (float*)(F.ws + WS_Y);
        const int pb = 1 + layer * PH_PER_LAYER;
        const float* xin = layer == 0 ? args.in[I_X] : XB;
        if (layer == 0 && EN(1) && IN(pb + 0)) { _Pragma("unroll 1") for (int rep_ = 0; rep_ < NREP(1); ++rep_) { phase_norm<false>(F, xin, args.in[I_ATTN_NORM] + layer * DM, HB, nullptr); } SEAMW(pb + 0); }
        if (EN(2) && IN(pb + 1)) { pg8::StaticOrder S; S.init(HB, DM * 2, F.ws + WS_WIN + layer * SZ_WIN, DM * 2, NTOK, DINP, F.G, F.bid);
            const bool early_cmp = (F.G == 256);
            unsigned* cmprdy = (unsigned*)(F.ws + WS_CTL) + CW_CMPRDY + layer;
            _Pragma("unroll 1") for (int rep_ = 0; rep_ < NREP(2); ++rep_) { pg8::EpiBf16 E{PROJ, DINP, layer == 1 ? (const float*)(F.ws + WS_RT + RT_RSQ) : nullptr, early_cmp ? cmprdy : nullptr, C_KC / 256}; pg8::gemm_phase(scr, DM / 64, DM * 2, DM * 2, S, E, F.tid); }
            if (early_cmp && F.bid >= 224) {
                if (F.tid == 0) { unsigned sp_ = 0; while (xb_ld(cmprdy) < 32u * 8u) { __builtin_amdgcn_s_sleep(4); if (++sp_ > XB_SPIN_CAP) break; }
                    __builtin_amdgcn_fence(__ATOMIC_ACQUIRE, "agent"); asm volatile("s_waitcnt vmcnt(0)" ::: "memory"); }
                __syncthreads();
                cmp_unit_mfma(F, F.bid - 224, layer, args.in[I_POS_K] + layer * 32 * HD, args.in[I_POS_V] + layer * 32 * HD);
            }
            SEAMW(pb + 1); }
        if (EN(3) && IN(pb + 2)) {
            for (int rep = 0; rep < REPA; ++rep, __syncthreads()) {
                const bool deal = (F.G == 256);
                for (int u = F.bid; u < 1024; u += F.G) GDN_CHUNK(F, u, args.in[I_CONV] + layer * 4 * 3072, args.in[I_ALOG] + layer * NGH, args.in[I_DTB] + layer * NGH);
                if (!deal) { for (int u = F.bid; u < 160; u += F.G) { if (u >= 128) cmp_unit_mfma(F, u - 128, layer, args.in[I_POS_K] + layer * 32 * HD, args.in[I_POS_V] + layer * 32 * HD); } }
            }
            SEAMW(pb + 2); }
        if (EN(4) && IN(pb + 3)) {
            for (int rep = 0; rep < REPB; ++rep, __syncthreads())
            for (int u = F.bid; u < 64 + 128 + 128; u += F.G) {
                if (u < 64) { for (int rs_ = 0; rs_ < REPS; ++rs_) gdn_scan_mfma(F, u); }
                else if (u < 192) { for (int rn_ = 0; rn_ < REPN; ++rn_) nsa_unit(F, u - 64); }
                else { const int sw = u - 192; if (F.G == 256 && sw >= 64) continue; swa_unit(F, args.in[I_SINKS] + layer * 4, sw); if (F.G == 256) swa_unit(F, args.in[I_SINKS] + layer * 4, sw + 64); }
            }
            SEAMW(pb + 3); }
        if (EN(5) && IN(pb + 4)) { _Pragma("unroll 1") for (int rep_ = 0; rep_ < NREP(5); ++rep_) { phase_gdn_out(F, args.in[I_GNORM] + layer * HD); } SEAMW(pb + 4); }
        if (EN(6) && IN(pb + 5)) { pg8::StaticOrder S; S.init(MIX, DM * 2, F.ws + WS_WOUT + layer * SZ_WOUT, DM * 2, NTOK, DM, F.G, F.bid);
            if (layer == 0) { pg8::EpiResidN E{xin, XB, HB, (float*)(F.ws + WS_RT + RT_RSQ), DM, (LAS float*)(F.lds + LDS_SCR + 131072), F.tid}; pg8::gemm_phase(scr, DM / 64, DM * 2, DM * 2, S, E, F.tid); }
            else { pg8::EpiResid E{xin, XB, DM}; pg8::gemm_phase(scr, DM / 64, DM * 2, DM * 2, S, E, F.tid); }
            SEAMW(pb + 5); }
        if (layer == 0) {
            if (EN(9) && IN(pb + 8)) { pg8::StaticOrder S; S.init(HB, DM * 2, F.ws + WS_DGU, DM * 2, NTOK, GU, F.G, F.bid);
                _Pragma("unroll 1") for (int rep_ = 0; rep_ < NREP(9); ++rep_) { pg8::EpiSwiGLU E{ACT, DFF, (const float*)(F.ws + WS_RT + RT_RSQ)}; pg8::gemm_phase(scr, DM / 64, DM * 2, DM * 2, S, E, F.tid); } SEAMW(pb + 8); }
            if (EN(10) && IN(pb + 9)) { pg8::StaticOrder S; S.init(ACT, DFF * 2, F.ws + WS_DDN, DFF * 2, NTOK, DM, F.G, F.bid);
                pg8::EpiResidN E{XB, XB, HB, (float*)(F.ws + WS_RT + RT_RSQ), DM, (LAS float*)(F.lds + LDS_SCR + 131072), F.tid}; pg8::gemm_phase(scr, DFF / 64, DFF * 2, DFF * 2, S, E, F.tid); SEAMW(pb + 9); }
        } else {
            if (EN(7) && IN(pb + 6)) { _Pragma("unroll 1") for (int rep_ = 0; rep_ < NREP(7); ++rep_) { phase_norm<true>(F, XB, args.in[I_FFN_NORM] + DM, HB, args.in[I_ROUTER]); } SEAMW(pb + 6); }
            if (EN(8) && IN(pb + 7)) { phase_route(F); if (hi - lo > 1) { while (qactive) { if (!steal_convert(F, args.in[I_MGATE], args.in[I_MUP], args.in[I_MDOWN])) qactive = false; } } SEAM(pb + 7); }
            const int* texp = (const int*)(F.ws + WS_RT + RT_TEXP);
            if (EN(9) && IN(pb + 8)) { const int ntiles = __builtin_amdgcn_readfirstlane(*(const int*)(F.ws + WS_RT + RT_NTILES));
                pg8::MoeOrder S; S.init(HPERM, DM, F.ws + WS_MGU, DM, (size_t)GU * DM, texp, ntiles, GU, F.G, F.bid);
                _Pragma("unroll 1") for (int rep_ = 0; rep_ < NREP(9); ++rep_) { pg8::EpiSwiGLUT<true> E{ACT, DFF, nullptr}; pg8::gemm_phase<pg8::EpiSwiGLUT<true>, pg8::MoeOrder, true>(scr, DM / 128, DM, DM, S, E, F.tid); } SEAM(pb + 8); }
            if (EN(10) && IN(pb + 9)) { const int ntiles = __builtin_amdgcn_readfirstlane(*(const int*)(F.ws + WS_RT + RT_NTILES));
                pg8::MoeOrder S; S.init(ACT, DFF, F.ws + WS_MDN, DFF, (size_t)DM * DFF, texp, ntiles, DM, F.G, F.bid);
                const int nun = ntiles * (DM / 256), nfull = nun / F.G, R = nun - nfull * F.G;
                const int ks = R * 14 <= F.G ? 14 : R * 7 <= F.G ? 7 : R * 4 <= F.G ? 4 : R * 2 <= F.G ? 2 : 1;
                const bool split = (hi - lo > 1) && R > 0 && R <= MAX_TAIL && ks > 1;
                if (F.bid == 0 && F.tid == 0) ((int*)(F.ws + WS_RT + RT_NTILES))[1] = split ? ks : 0;
                if (split) S.nrounds = nfull;
                { pg8::EpiRowScaleBf E{(const float*)(F.ws + WS_RT + RT_RGATE), (bf16_t*)YB, DM, 0.015625f}; pg8::gemm_phase<pg8::EpiRowScaleBf, pg8::MoeOrder, true>(scr, DFF / 128, DFF, DFF, S, E, F.tid); }
                if (split) { pg8::MoeTailOrder T; T.M = S; T.M.nrounds = 1 << 30; T.L0 = nfull * F.G; T.R = R; T.kbytes = DFF / ks; T.ks = ks;
                    pg8::EpiSlab E2{(float*)(F.ws + WS_SLAB), (int*)(F.ws + WS_RT + RT_TAIL), ks}; pg8::gemm_phase<pg8::EpiSlab, pg8::MoeTailOrder, true>(scr, DFF / ks / 128, DFF, DFF, T, E2, F.tid); }
                SEAM(pb + 9); }
        }
    }
__global__ void __launch_bounds__(512, 2) trunk_fwd(Args args) {
    extern __shared__ __attribute__((aligned(16))) unsigned char lds_raw[];
    Frame F;
    F.lds = (LAS unsigned char*)lds_raw;
    F.tid = threadIdx.x; F.lane = F.tid & 63; F.wave = __builtin_amdgcn_readfirstlane(F.tid >> 6); F.wave0 = F.wave; F.G = gridDim.x; F.bid = blockIdx.x;
    F.out = args.out; F.ws = args.ws;
    volatile LAS unsigned* MISC = (volatile LAS unsigned*)(F.lds + LDS_MISC);
    if (F.tid < 64) MISC[F.tid] = 0u;
    __syncthreads();
    unsigned* ctl = (unsigned*)(F.ws + WS_CTL);
    XcdBarrier bar; bar.bar = ctl + CW_BAR; bar.x = 0; bar.st = nullptr;
    const int lo = args.ph_lo, hi = args.ph_hi;
    if (hi - lo > 1) bar = xcd_barrier_post(ctl + CW_BAR, MISC + 8);
    LAS unsigned char* scr = F.lds + LDS_SCR;
    bf16_t* HB = (bf16_t*)(F.ws + WS_HB); bf16_t* PROJ = (bf16_t*)(F.ws + WS_PROJ); bf16_t* MIX = (bf16_t*)(F.ws + WS_MIX); float* XB = (float*)(F.ws + WS_X);
    bf16_t* ACT = (bf16_t*)(F.ws + WS_ACT); bf16_t* HPERM = (bf16_t*)(F.ws + WS_HPERM); float* YB = (float*)(F.ws + WS_Y);

    bool qactive = (hi - lo > 1);
    if (EN(0) && IN(0)) { phase_convert(F, args.in[I_W_IN], args.in[I_W_OUT], args.in[I_DGATE], args.in[I_DUP], args.in[I_DDOWN], args.in[I_W1K], args.in[I_W1V], args.in[I_W2K], args.in[I_W2V], args.in[I_ATTN_NORM] + DM, args.in[I_FFN_NORM]);
        if (hi - lo <= 1) { LAS float* scr0 = (LAS float*)(F.lds + LDS_SCR + F.wave * 16384); for (int q = F.bid * 8 + F.wave; q < Q_TOTAL; q += F.G * 8) moe_item(F.ws, args.in[I_MGATE], args.in[I_MUP], args.in[I_MDOWN], q, scr0, F.lane); }
        SEAMW(0); }
    run_layer<0>(F, args, lo, hi, bar, qactive);
    run_layer<1>(F, args, lo, hi, bar, qactive);
    if (EN(11) && IN(N_PHASES - 1)) phase_final(F, args.in[I_FINAL]);
}

extern "C" void kernel_launch(void* const* d_in, const int* in_sizes, int n_in, void* d_out, int out_size, void* d_ws, size_t ws_size, hipStream_t stream) {
    static int grid = 0;
    if (grid == 0) {
        if (n_in != 24 || in_sizes[0] != NTOK * DM || out_size != NTOK * DM || ws_size < WS_END) {
            fprintf(stderr, "kernel_launch: unexpected shapes (n_in %d, in0 %d, out %d, ws %zu < %zu)\n", n_in, n_in > 0 ? in_sizes[0] : -1, out_size, ws_size, (size_t)WS_END); grid = -1; return; }
        int dev = 0, cus = 0, per_cu = 0;
        if (hipGetDevice(&dev) != hipSuccess || hipDeviceGetAttribute(&cus, hipDeviceAttributeMultiprocessorCount, dev) != hipSuccess) { grid = -1; return; }
        if (hipFuncSetAttribute((const void*)trunk_fwd, hipFuncAttributeMaxDynamicSharedMemorySize, LDS_BYTES) != hipSuccess) { fprintf(stderr, "kernel_launch: hipFuncSetAttribute failed\n"); grid = -1; return; }
        if (hipOccupancyMaxActiveBlocksPerMultiprocessor(&per_cu, (const void*)trunk_fwd, 512, LDS_BYTES) != hipSuccess || per_cu < 1) { fprintf(stderr, "kernel_launch: occupancy query says %d\n", per_cu); }
        (void)hipGetLastError();
        grid = cus;
    }
    if (grid < 0) return;
    (void)hipMemsetAsync((char*)d_ws + WS_CTL, 0, CTL_BYTES, stream);
    Args a{};
    for (int i = 0; i < 24; ++i) a.in[i] = (const float*)d_in[i];
    a.out = (float*)d_out; a.ws = (unsigned char*)d_ws;
#if MK_PER_PHASE
    for (int p = 0; p < N_PHASES; ++p) { a.ph_lo = p; a.ph_hi = p + 1; hipLaunchKernelGGL(trunk_fwd, dim3(grid), dim3(512), LDS_BYTES, stream, a); }
#else
    a.ph_lo = 0; a.ph_hi = N_PHASES;
    hipLaunchKernelGGL(trunk_fwd, dim3(grid), dim3(512), LDS_BYTES, stream, a);
#endif
}
```
